# Optimizing an MI355X kernel written in HIP

```python
import jax, jax.numpy as jnp
from jax import lax
import numpy as np

D_MODEL = 1024
BATCH = 32
SEQ = 256
DEPTH = 2
DEC_BATCH = 8
DEC_SEQ = 1024
PAST_LEN = 256

GRID_W = 64
N_DIR = 2
H_GLA = 4
DK_GLA = 128
DV_GLA = 256
GLA_RANK = 16
GLA_TAU = 16.0
GLA_CHUNK = 16
H_MLSTM = 4
DH_MLSTM = 256
MLSTM_CHUNK = 64
CONV_W = 3
D_FF = 2816
N_MOD = 9
LN_EPS = 1e-5
NORM_EPS = 1e-6
QK_GLA = H_GLA * DK_GLA
V_GLA = H_GLA * DV_GLA
W_MLSTM = H_MLSTM * DH_MLSTM
IN_SIZES = (QK_GLA, QK_GLA, V_GLA, V_GLA, GLA_RANK, GLA_RANK,
            2 * W_MLSTM, W_MLSTM, W_MLSTM, H_MLSTM, H_MLSTM, H_MLSTM, H_MLSTM,
            D_MODEL, D_MODEL)
D_IN = sum(IN_SIZES)

kernel_name = 'hybrid_gla_mlstm_diffusion_step'


def _layer_norm(x, g, b):
    xf = x.astype(jnp.float32)
    mu = xf.mean(-1, keepdims=True)
    var = jnp.square(xf - mu).mean(-1, keepdims=True)
    return ((xf - mu) * lax.rsqrt(var + LN_EPS) * g + b).astype(x.dtype)


def _head_rms(x, g):
    xf = x.astype(jnp.float32)
    return xf * lax.rsqrt(jnp.mean(jnp.square(xf), -1, keepdims=True) + NORM_EPS) * g


def _heads(t, n_heads):
    b, t_len, ch = t.shape
    return t.reshape(b, t_len, n_heads, ch // n_heads).transpose(0, 2, 1, 3)


def _merge_heads(t):
    b, h, t_len, d = t.shape
    return t.transpose(0, 2, 1, 3).reshape(b, t_len, h * d)


def _to_chunks(t, chunk):
    b, h, t_len = t.shape[:3]
    t = t.reshape((b, h, t_len // chunk, chunk) + t.shape[3:])
    return jnp.moveaxis(t, 2, 0)


def _from_chunks(t):
    t = jnp.moveaxis(t, 0, 2)
    b, h, n, c = t.shape[:4]
    return t.reshape((b, h, n * c) + t.shape[4:])


def _gla_scan(q, k, v, log_a, s0):
    f32 = jnp.float32
    mask = jnp.tril(jnp.ones((GLA_CHUNK, GLA_CHUNK), bool))

    def step(s, inp):
        qc, kc, vc, ac = inp
        cum = jnp.cumsum(ac, axis=-2)
        qd = qc * jnp.exp(cum)
        kd = kc * jnp.exp(-cum)
        att = jnp.where(mask, jnp.einsum('bhtd,bhsd->bhts', qd, kd), 0.0)
        o = jnp.einsum('bhts,bhsv->bhtv', att, vc) + jnp.einsum('bhtd,bhdv->bhtv', qd, s)
        cum_end = cum[..., -1:, :]
        s_new = jnp.exp(cum_end[..., 0, :])[..., None] * s + jnp.einsum('bhsd,bhsv->bhdv', kc * jnp.exp(cum_end - cum), vc)
        return s_new, o

    xs = tuple(_to_chunks(t.astype(f32), GLA_CHUNK) for t in (q, k, v, log_a))
    s_fin, o = lax.scan(step, s0.astype(f32), xs)
    return _from_chunks(o), s_fin


def _mlstm_scan(q, k, v, i_pre, log_f, c0, n0, m0):
    f32 = jnp.float32
    mask = jnp.tril(jnp.ones((MLSTM_CHUNK, MLSTM_CHUNK), bool))

    def step(carry, inp):
        c, n, m = carry
        qc, kc, vc, ic, fc = inp
        cum = jnp.cumsum(fc, axis=-1)
        log_d = jnp.where(mask, cum[..., :, None] - cum[..., None, :] + ic[..., None, :], -jnp.inf)
        log_inter = cum + m[..., None]
        m_t = jnp.maximum(log_inter, log_d.max(-1))
        d = jnp.exp(log_d - m_t[..., None])
        inter = jnp.exp(log_inter - m_t)
        s = jnp.einsum('bhtd,bhsd->bhts', qc, kc) * d
        num = jnp.einsum('bhts,bhsv->bhtv', s, vc) + inter[..., None] * jnp.einsum('bhtd,bhdv->bhtv', qc, c)
        den = s.sum(-1) + inter * jnp.einsum('bhtd,bhd->bht', qc, n)
        h = num / jnp.maximum(jnp.abs(den), jnp.exp(-m_t))[..., None]
        cum_end = cum[..., -1]
        log_w = cum_end[..., None] - cum + ic
        m_new = jnp.maximum(cum_end + m, log_w.max(-1))
        w = jnp.exp(log_w - m_new[..., None])
        decay = jnp.exp(cum_end + m - m_new)
        c_new = decay[..., None, None] * c + jnp.einsum('bhsd,bhsv->bhdv', kc * w[..., None], vc)
        n_new = decay[..., None] * n + jnp.einsum('bhs,bhsd->bhd', w, kc)
        return (c_new, n_new, m_new), h

    xs = tuple(_to_chunks(t.astype(f32), MLSTM_CHUNK) for t in (q, k, v, i_pre, log_f))
    carry, h = lax.scan(step, (c0.astype(f32), n0.astype(f32), m0.astype(f32)), xs)
    return _from_chunks(h), carry


def _centred_conv(x, w, b):
    t_len = x.shape[1]
    pad = CONV_W // 2
    xp = jnp.pad(x, ((0, 0), (pad, pad), (0, 0)))
    return sum(xp[:, j:j + t_len] * w[j] for j in range(CONV_W)) + b


def _swiglu(h, w_gate, w_up, w_down):
    return (jax.nn.silu(h @ w_gate) * (h @ w_up)) @ w_down


def _grid_pos_embed(t_len, dtype):
    rows = t_len // GRID_W
    r = jnp.repeat(jnp.arange(rows), GRID_W).astype(jnp.float32)
    col = jnp.tile(jnp.arange(GRID_W), rows).astype(jnp.float32)
    nf = D_MODEL // 4
    omega = 1.0 / (10000.0 ** (jnp.arange(nf, dtype=jnp.float32) / nf))
    er = r[:, None] * omega
    ec = col[:, None] * omega
    return jnp.concatenate([jnp.sin(er), jnp.cos(er), jnp.sin(ec), jnp.cos(ec)], axis=-1).astype(dtype)


def _mixer(h, st, l, p):
    s_gla, c_m, n_m, m_m = st
    z = h @ p['w_in'][l]
    points = [int(v) for v in np.cumsum(IN_SIZES)[:-1]]
    (q_g, k_g, v_g, r_g, a_f, a_b, qk_m, v_m, o_m,
     i_f, f_f, i_b, f_b, g_gla, g_mlstm) = jnp.split(z, points, axis=-1)
    flip = lambda t: jnp.flip(t, axis=2)
    to_bht = lambda t: jnp.moveaxis(t, -1, 1)

    q_g = _heads(q_g, H_GLA) * DK_GLA ** -0.5
    k_g = _heads(k_g, H_GLA)
    v_g = _heads(v_g, H_GLA)
    la_f = _heads(jax.nn.log_sigmoid(a_f @ p['w_decay'][l, 0] + p['b_decay'][l, 0]) / GLA_TAU, H_GLA)
    la_b = _heads(jax.nn.log_sigmoid(a_b @ p['w_decay'][l, 1] + p['b_decay'][l, 1]) / GLA_TAU, H_GLA)
    o_f, s_f = _gla_scan(q_g, k_g, v_g, la_f, s_gla[:, 0])
    o_b, s_b = _gla_scan(flip(q_g), flip(k_g), flip(v_g), flip(la_b), s_gla[:, 1])
    o_g = _merge_heads(_head_rms(o_f + flip(o_b), p['gla_norm_g'][l])).astype(h.dtype)
    y_g = (o_g * jax.nn.silu(r_g)) @ p['w_br_gla'][l]

    qk_m = jax.nn.silu(_centred_conv(qk_m, p['w_conv'][l], p['b_conv'][l]))
    q_m, k_m = jnp.split(qk_m, 2, axis=-1)
    q_m = _heads(q_m, H_MLSTM) * DH_MLSTM ** -0.5
    k_m = _heads(k_m, H_MLSTM)
    v_m = _heads(v_m, H_MLSTM)
    lf_f = to_bht(jax.nn.log_sigmoid(f_f + p['f_bias'][l, 0]))
    lf_b = to_bht(jax.nn.log_sigmoid(f_b + p['f_bias'][l, 1]))
    h_f, (c_f, n_f, m_f) = _mlstm_scan(q_m, k_m, v_m, to_bht(i_f), lf_f, c_m[:, 0], n_m[:, 0], m_m[:, 0])
    h_b, (c_b, n_b, m_b) = _mlstm_scan(flip(q_m), flip(k_m), flip(v_m), flip(to_bht(i_b)), flip(lf_b),
                                       c_m[:, 1], n_m[:, 1], m_m[:, 1])
    h_m = _merge_heads(_head_rms(h_f + flip(h_b), p['mlstm_norm_g'][l])).astype(h.dtype)
    y_m = (jax.nn.sigmoid(o_m) * h_m) @ p['w_br_mlstm'][l]

    y = (jax.nn.sigmoid(g_gla) * y_g + jax.nn.sigmoid(g_mlstm) * y_m) @ p['w_out'][l]
    new_st = (jnp.stack([s_f, s_b], axis=1), jnp.stack([c_f, c_b], axis=1),
              jnp.stack([n_f, n_b], axis=1), jnp.stack([m_f, m_b], axis=1))
    return y, new_st


def _layer(x, cond, st, l, p, alpha):
    ada = (jax.nn.silu(cond) @ p['w_ada'][l] + p['b_ada'][l]).reshape(cond.shape[0], N_MOD, 1, D_MODEL)
    sh1, sc1, g1, sh2, sc2, g2, sh3, sc3, g3 = [ada[:, j] for j in range(N_MOD)]
    f1 = _swiglu(x * (1.0 + sc1) + sh1, p['ffn1_w_gate'][l], p['ffn1_w_up'][l], p['ffn1_w_down'][l])
    x = _layer_norm(alpha * x + 0.5 * g1 * f1, p['ln_g'][l, 0], p['ln_b'][l, 0])
    y, new_st = _mixer(x * (1.0 + sc2) + sh2, st, l, p)
    x = _layer_norm(alpha * x + g2 * y, p['ln_g'][l, 1], p['ln_b'][l, 1])
    f2 = _swiglu(x * (1.0 + sc3) + sh3, p['ffn2_w_gate'][l], p['ffn2_w_up'][l], p['ffn2_w_down'][l])
    x = _layer_norm(alpha * x + 0.5 * g3 * f2, p['ln_g'][l, 2], p['ln_b'][l, 2])
    return x, new_st


def setup_inputs(seed: int = 0) -> dict:
    keys = iter(jax.random.split(jax.random.key(seed), 40))

    def nrm(shape, scale):
        return jax.random.normal(next(keys), shape, jnp.float32) * scale

    beta = (8.0 * DEPTH) ** -0.25
    d_in_scale = D_MODEL ** -0.5
    return {
        'x_prompt': nrm((BATCH, SEQ, D_MODEL), 1.0),
        'x_sample': nrm((DEC_BATCH, DEC_SEQ, D_MODEL), 1.0),
        'c': nrm((DEC_BATCH, D_MODEL), 1.0),
        'state_gla_s': nrm((DEC_BATCH, DEPTH, N_DIR, H_GLA, DK_GLA, DV_GLA), 0.5),
        'state_mlstm_c': nrm((DEC_BATCH, DEPTH, N_DIR, H_MLSTM, DH_MLSTM, DH_MLSTM), 0.1),
        'state_mlstm_n': nrm((DEC_BATCH, DEPTH, N_DIR, H_MLSTM, DH_MLSTM), 0.1),
        'state_mlstm_m': nrm((DEC_BATCH, DEPTH, N_DIR, H_MLSTM), 1.0),
        'c_ctx': nrm((D_MODEL,), 1.0),
        'w_ada': nrm((DEPTH, D_MODEL, N_MOD * D_MODEL), 0.5 * d_in_scale),
        'b_ada': nrm((DEPTH, N_MOD * D_MODEL), 0.02),
        'ffn1_w_gate': nrm((DEPTH, D_MODEL, D_FF), d_in_scale),
        'ffn1_w_up': nrm((DEPTH, D_MODEL, D_FF), d_in_scale),
        'ffn1_w_down': nrm((DEPTH, D_FF, D_MODEL), beta * D_FF ** -0.5),
        'w_in': nrm((DEPTH, D_MODEL, D_IN), d_in_scale),
        'w_decay': nrm((DEPTH, N_DIR, GLA_RANK, QK_GLA), GLA_RANK ** -0.5),
        'b_decay': nrm((DEPTH, N_DIR, QK_GLA), 0.1),
        'w_conv': nrm((DEPTH, CONV_W, 2 * W_MLSTM), CONV_W ** -0.5),
        'b_conv': nrm((DEPTH, 2 * W_MLSTM), 0.02),
        'f_bias': 3.0 + nrm((DEPTH, N_DIR, H_MLSTM), 0.1),
        'gla_norm_g': 1.0 + nrm((DEPTH, DV_GLA), 0.05),
        'mlstm_norm_g': 1.0 + nrm((DEPTH, DH_MLSTM), 0.05),
        'w_br_gla': nrm((DEPTH, V_GLA, D_MODEL), V_GLA ** -0.5),
        'w_br_mlstm': nrm((DEPTH, W_MLSTM, D_MODEL), W_MLSTM ** -0.5),
        'w_out': nrm((DEPTH, D_MODEL, D_MODEL), beta * d_in_scale),
        'ffn2_w_gate': nrm((DEPTH, D_MODEL, D_FF), d_in_scale),
        'ffn2_w_up': nrm((DEPTH, D_MODEL, D_FF), d_in_scale),
        'ffn2_w_down': nrm((DEPTH, D_FF, D_MODEL), beta * D_FF ** -0.5),
        'ln_g': 1.0 + nrm((DEPTH, 3, D_MODEL), 0.05),
        'ln_b': nrm((DEPTH, 3, D_MODEL), 0.02),
    }


def reference(x_prompt, x_sample, c, state_gla_s, state_mlstm_c, state_mlstm_n, state_mlstm_m, c_ctx,
              w_ada, b_ada, ffn1_w_gate, ffn1_w_up, ffn1_w_down, w_in, w_decay, b_decay, w_conv, b_conv,
              f_bias, gla_norm_g, mlstm_norm_g, w_br_gla, w_br_mlstm, w_out,
              ffn2_w_gate, ffn2_w_up, ffn2_w_down, ln_g, ln_b):
    p = dict(w_ada=w_ada, b_ada=b_ada, ffn1_w_gate=ffn1_w_gate, ffn1_w_up=ffn1_w_up,
             ffn1_w_down=ffn1_w_down, w_in=w_in, w_decay=w_decay, b_decay=b_decay,
             w_conv=w_conv, b_conv=b_conv, f_bias=f_bias, gla_norm_g=gla_norm_g,
             mlstm_norm_g=mlstm_norm_g, w_br_gla=w_br_gla, w_br_mlstm=w_br_mlstm, w_out=w_out,
             ffn2_w_gate=ffn2_w_gate, ffn2_w_up=ffn2_w_up, ffn2_w_down=ffn2_w_down,
             ln_g=ln_g, ln_b=ln_b)
    alpha = (2.0 * DEPTH) ** 0.25
    f32 = jnp.float32

    bp = x_prompt.shape[0]
    zero_st = (jnp.zeros((bp, N_DIR, H_GLA, DK_GLA, DV_GLA), f32),
               jnp.zeros((bp, N_DIR, H_MLSTM, DH_MLSTM, DH_MLSTM), f32),
               jnp.zeros((bp, N_DIR, H_MLSTM, DH_MLSTM), f32),
               jnp.zeros((bp, N_DIR, H_MLSTM), f32))
    h = x_prompt
    gla_s, mc, mn, mm = [], [], [], []
    for l in range(DEPTH):
        h, (s_l, c_l, n_l, m_l) = _layer(h, c_ctx[None, :], zero_st, l, p, alpha)
        gla_s.append(s_l)
        mc.append(c_l)
        mn.append(n_l)
        mm.append(m_l)
    y_prompt = h

    h = x_sample + _grid_pos_embed(x_sample.shape[1], x_sample.dtype)[None]
    for l in range(DEPTH):
        st = (state_gla_s[:, l], state_mlstm_c[:, l], state_mlstm_n[:, l], state_mlstm_m[:, l])
        h, _ = _layer(h, c, st, l, p, alpha)
    y_sample = h

    new_gla_s = jnp.stack(gla_s, axis=1)
    new_mlstm_c = jnp.stack(mc, axis=1)
    new_mlstm_n = jnp.stack(mn, axis=1)
    new_mlstm_m = jnp.stack(mm, axis=1)
    return (y_prompt, y_sample, new_gla_s, new_mlstm_c, new_mlstm_n, new_mlstm_m)
```

```cpp
#include <hip/hip_runtime.h>
#include <hip/hip_cooperative_groups.h>
#include <cstdio>
#include <cstdint>
namespace cg = cooperative_groups;

#define GAS __attribute__((address_space(1)))
#define LAS __attribute__((address_space(3)))

constexpr int M = 16384, D = 1024, FF = 2816, NPROMPT_ROWS = 8192;
constexpr int NADA = 9216, NCOND = 9;
constexpr int ZA_W = 5120, ZB_W = 4096, ZS_W = 64;
constexpr int WINA_N = 5376, WINB_N = 4096, W1A_N = 5632;
constexpr int DIN = 9264;
constexpr float ALPHA = 1.4142135623730951f;
constexpr float LN_EPS = 1e-5f, NORM_EPS = 1e-6f;

constexpr size_t MiB = 1u << 20;
constexpr size_t WS_CTL = 0, CTL_BYTES = 1 * MiB;
constexpr size_t WS_ADA = 1 * MiB;
constexpr size_t WS_WT = 2 * MiB;
constexpr size_t WT_W1A = 0, WT_W1D = WT_W1A + (size_t)W1A_N * D * 2, WT_WINA = WT_W1D + (size_t)D * FF * 2, WT_WINB = WT_WINA + (size_t)WINA_N * D * 2,
                 WT_WBG = WT_WINB + (size_t)WINB_N * D * 2, WT_WBM = WT_WBG + (size_t)D * D * 2, WT_WO = WT_WBM + (size_t)D * D * 2,
                 WT_W2A = WT_WO + (size_t)D * D * 2, WT_W2D = WT_W2A + (size_t)W1A_N * D * 2, WT_END = WT_W2D + (size_t)D * FF * 2;
static_assert(WT_END <= 58 * MiB, "weights fit");
constexpr size_t WS_H = 60 * MiB;
constexpr size_t WS_ZS = 92 * MiB;
constexpr size_t WS_ZA = 96 * MiB;
constexpr size_t WS_ACT = WS_ZA, WS_PRE = WS_ZA + 88 * MiB, WS_ZB = WS_ZA;
constexpr size_t WS_O = 256 * MiB;
constexpr size_t O_STRIDE = 32 * MiB;
constexpr size_t WS_END = 384 * MiB;

constexpr size_t OUT_GLA = (size_t)M * D, OUT_MC = OUT_GLA + 16777216ull, OUT_MN = OUT_MC + 33554432ull, OUT_MM = OUT_MN + 131072ull;

typedef unsigned short bf16;
typedef float f32x4 __attribute__((ext_vector_type(4)));
typedef unsigned u32x4 __attribute__((ext_vector_type(4)));
typedef unsigned u32x2 __attribute__((ext_vector_type(2)));

__device__ __forceinline__ unsigned f2bf(float f) { unsigned u = __builtin_bit_cast(unsigned, f); return (u + 0x7fffu + ((u >> 16) & 1u)) >> 16; }
__device__ __forceinline__ unsigned pk2(float lo, float hi) { return f2bf(lo) | (f2bf(hi) << 16); }
__device__ __forceinline__ float bf_lo(unsigned w) { return __builtin_bit_cast(float, w << 16); }
__device__ __forceinline__ float bf_hi(unsigned w) { return __builtin_bit_cast(float, w & 0xffff0000u); }
__device__ __forceinline__ float bf2f(bf16 v) { return __builtin_bit_cast(float, (unsigned)v << 16); }
__device__ __forceinline__ float fast_sigmoid(float x) { return __builtin_amdgcn_rcpf(1.0f + __builtin_amdgcn_exp2f(-1.4426950408889634f * x)); }
__device__ __forceinline__ float fast_silu(float x) { return x * fast_sigmoid(x); }
__device__ __forceinline__ float log_sigmoid(float x) { return fminf(x, 0.f) - log1pf(expf(-fabsf(x))); }
__device__ __forceinline__ float wave_sum(float v) {
#pragma unroll
    for (int o = 1; o < 64; o <<= 1) v += __shfl_xor(v, o);
    return v;
}
__device__ __forceinline__ int cond_of_row(int r) { return r < NPROMPT_ROWS ? 0 : 1 + ((r - NPROMPT_ROWS) >> 10); }

__device__ __forceinline__ int otid() { int t = threadIdx.x; asm volatile("" : "+v"(t)); return t; }

namespace pg8 {
#define PG8_LAS __attribute__((address_space(3)))
typedef unsigned short bf16_t;
typedef short bf16x8 __attribute__((ext_vector_type(8)));
typedef float f32x4 __attribute__((ext_vector_type(4)));
typedef unsigned u32x4 __attribute__((ext_vector_type(4)));
constexpr int BM = 256, BK = 64, HALF = 128, HTB = HALF * BK * 2  , STAGE_BYTES = 8 * HTB, NXCD = 8, WGM = 8;

__host__ __device__ __forceinline__ int lds_byte(int r, int c) { const int st = (r >> 4) * 2 + (c >> 5), rr = r & 15, cc = c & 31, ob = rr * 64 + cc * 2; return st * 1024 + (ob ^ (((ob >> 9) & 1) << 5)); }
__host__ __device__ __forceinline__ void stage_rc(int b, int& R, int& C) { const int st = b / 1024, sb = b % 1024, swz = sb ^ (((sb >> 9) & 1) << 5); R = (st >> 1) * 16 + swz / 64; C = (st & 1) * 32 + (swz % 64) / 2; }
__host__ __device__ __forceinline__ int perm32(int rho) { const int n = rho >> 4, i = rho & 15; return 8 * (i >> 2) + 4 * n + (i & 3); }

struct Unit { int pm, pn; };
struct Gemm { const bf16_t* A; const bf16_t* Bt; int M, N, K; };

struct StaticOrder {
    int nM, nN, nwg, G, c;
    __host__ __device__ void init(int M, int N, int G_, int c_) { nM = M / BM; nN = N / BM; nwg = nM * nN; G = G_; c = c_; }
    __host__ __device__ bool next(int i, Unit& u) const {
        const long L = (long)i * G + c; if (L >= nwg) return false;
        int wgid = (int)L; { const int q = nwg / NXCD, r = nwg % NXCD, xcd = wgid % NXCD, off = wgid / NXCD; wgid = (xcd < r ? xcd * (q + 1) : r * (q + 1) + (xcd - r) * q) + off; }
        const int nig = WGM * nN, gid = wgid / nig, fm = gid * WGM, gsz = (nM - fm) < WGM ? (nM - fm) : WGM;
        u.pm = fm + ((wgid % nig) % gsz); u.pn = (wgid % nig) / gsz; return true;
    }
    __device__ __forceinline__ void a_ready(const Unit&) const {}
    __device__ __forceinline__ void done(const Unit&) const {}
};

__device__ __forceinline__ unsigned cvt_pk_bf16(float lo, float hi) { unsigned r; asm volatile("v_cvt_pk_bf16_f32 %0, %1, %2" : "=v"(r) : "v"(lo), "v"(hi)); return r; }
typedef float f32x2 __attribute__((ext_vector_type(2)));
__device__ __forceinline__ int unit_cond(const Unit& u) { return u.pm < 32 ? 0 : 1 + ((u.pm - 32) >> 2); }
__device__ __forceinline__ float esig(float x) { return __builtin_amdgcn_rcpf(1.0f + __builtin_amdgcn_exp2f(-1.4426950408889634f * x)); }

struct EpiSwiglu {
    static constexpr bool PERM = true, AFTER_DRAIN = false;
    bf16_t* O; int ldc;
    __device__ __forceinline__ void operator()(const f32x4 (&acc)[2][2][4][2], const Unit& u, int wr, int wc, int fr, int fq) const {
        const int row0 = u.pm * BM + wr * 64 + fr, col0 = u.pn * HALF + wc * 32 + 8 * fq;
#pragma unroll
        for (int ai = 0; ai < 2; ++ai)
#pragma unroll
            for (int m = 0; m < 4; ++m) { bf16_t* rowp = O + (size_t)(row0 + ai * HALF + m * 16) * ldc + col0;
                f32x4 v0, v1;
#pragma unroll
                for (int e = 0; e < 4; ++e) { const float g0 = acc[ai][0][m][0][e], g1 = acc[ai][0][m][1][e]; v0[e] = g0 * esig(g0) * acc[ai][1][m][0][e]; v1[e] = g1 * esig(g1) * acc[ai][1][m][1][e]; }
                u32x4 w; w.x = cvt_pk_bf16(v0[0], v0[1]); w.y = cvt_pk_bf16(v0[2], v0[3]); w.z = cvt_pk_bf16(v1[0], v1[1]); w.w = cvt_pk_bf16(v1[2], v1[3]);
                *(u32x4*)rowp = w; }
    }
};
struct EpiPre {
    static constexpr bool PERM = false, AFTER_DRAIN = false;
    const float* X; float* P; const float* gate; float coef;
    __device__ __forceinline__ void operator()(const f32x4 (&acc)[2][2][4][2], const Unit& u, int wr, int wc, int fr, int fq) const {
        const int row0 = u.pm * BM + wr * 64 + fr, col0 = u.pn * BM + wc * 32 + 4 * fq;
        const float* g = gate + (size_t)unit_cond(u) * 9216;
        f32x4 gv[2][2];
#pragma unroll
        for (int bj = 0; bj < 2; ++bj)
#pragma unroll
            for (int n = 0; n < 2; ++n) gv[bj][n] = *(const f32x4*)(g + col0 + bj * HALF + n * 16) * coef;
#pragma unroll
        for (int ai = 0; ai < 2; ++ai)
#pragma unroll
            for (int m = 0; m < 4; ++m) { const size_t off = (size_t)(row0 + ai * HALF + m * 16) * 1024 + col0;
#pragma unroll
                for (int bj = 0; bj < 2; ++bj)
#pragma unroll
                    for (int n = 0; n < 2; ++n) { const f32x4 x = *(const f32x4*)(X + off + bj * HALF + n * 16);
                        *(f32x4*)(P + off + bj * HALF + n * 16) = x * 1.4142135623730951f + gv[bj][n] * acc[ai][bj][m][n]; } }
    }
};
template <int ACTSEL> struct EpiZ {
    static constexpr bool PERM = true, AFTER_DRAIN = false;
    bf16_t* O; int ldc; float* ZS; int nmain;
    __device__ __forceinline__ void operator()(const f32x4 (&acc)[2][2][4][2], const Unit& u, int wr, int wc, int fr, int fq) const {
        const int row0 = u.pm * BM + wr * 64 + fr, col0 = u.pn * BM + wc * 32 + 8 * fq;
        if (ACTSEL == 0 && u.pn >= nmain) {
            if (wc < 2) {
#pragma unroll
                for (int ai = 0; ai < 2; ++ai)
#pragma unroll
                    for (int m = 0; m < 4; ++m) { float* rowp = ZS + (size_t)(row0 + ai * HALF + m * 16) * 64 + wc * 32 + 8 * fq;
                        *(f32x4*)rowp = acc[ai][0][m][0]; *(f32x4*)(rowp + 4) = acc[ai][0][m][1]; }
            }
            return;
        }
#pragma unroll
        for (int ai = 0; ai < 2; ++ai)
#pragma unroll
            for (int m = 0; m < 4; ++m) { bf16_t* rowp = O + (size_t)(row0 + ai * HALF + m * 16) * ldc + col0;
#pragma unroll
                for (int bj = 0; bj < 2; ++bj) { f32x4 v0 = acc[ai][bj][m][0], v1 = acc[ai][bj][m][1];
                    if (ACTSEL == 1) {
                        if (u.pn < 4) {
#pragma unroll
                            for (int e = 0; e < 4; ++e) { v0[e] = v0[e] * esig(v0[e]); v1[e] = v1[e] * esig(v1[e]); }
                        } else {
#pragma unroll
                            for (int e = 0; e < 4; ++e) { v0[e] = esig(v0[e]); v1[e] = esig(v1[e]); }
                        }
                    }
                    u32x4 w; w.x = cvt_pk_bf16(v0[0], v0[1]); w.y = cvt_pk_bf16(v0[2], v0[3]); w.z = cvt_pk_bf16(v1[0], v1[1]); w.w = cvt_pk_bf16(v1[2], v1[3]);
                    *(u32x4*)(rowp + bj * HALF) = w; } }
    }
};
template <bool ADD> struct EpiBranch {
    static constexpr bool PERM = true, AFTER_DRAIN = false;
    const bf16_t* G; int ldg; const bf16_t* T; bf16_t* O;
    __device__ __forceinline__ void operator()(const f32x4 (&acc)[2][2][4][2], const Unit& u, int wr, int wc, int fr, int fq) const {
        const int row0 = u.pm * BM + wr * 64 + fr, col0 = u.pn * BM + wc * 32 + 8 * fq;
#pragma unroll
        for (int ai = 0; ai < 2; ++ai)
#pragma unroll
            for (int m = 0; m < 4; ++m) { const size_t r = (size_t)(row0 + ai * HALF + m * 16);
#pragma unroll
                for (int bj = 0; bj < 2; ++bj) {
                    const u32x4 gw = *(const u32x4*)(G + r * ldg + col0 + bj * HALF);
                    f32x4 v0 = acc[ai][bj][m][0], v1 = acc[ai][bj][m][1];
                    v0[0] *= __builtin_bit_cast(float, gw.x << 16); v0[1] *= __builtin_bit_cast(float, gw.x & 0xffff0000u);
                    v0[2] *= __builtin_bit_cast(float, gw.y << 16); v0[3] *= __builtin_bit_cast(float, gw.y & 0xffff0000u);
                    v1[0] *= __builtin_bit_cast(float, gw.z << 16); v1[1] *= __builtin_bit_cast(float, gw.z & 0xffff0000u);
                    v1[2] *= __builtin_bit_cast(float, gw.w << 16); v1[3] *= __builtin_bit_cast(float, gw.w & 0xffff0000u);
                    if (ADD) { const u32x4 tw = *(const u32x4*)(T + r * 1024 + col0 + bj * HALF);
                        v0[0] += __builtin_bit_cast(float, tw.x << 16); v0[1] += __builtin_bit_cast(float, tw.x & 0xffff0000u);
                        v0[2] += __builtin_bit_cast(float, tw.y << 16); v0[3] += __builtin_bit_cast(float, tw.y & 0xffff0000u);
                        v1[0] += __builtin_bit_cast(float, tw.z << 16); v1[1] += __builtin_bit_cast(float, tw.z & 0xffff0000u);
                        v1[2] += __builtin_bit_cast(float, tw.w << 16); v1[3] += __builtin_bit_cast(float, tw.w & 0xffff0000u); }
                    u32x4 w; w.x = cvt_pk_bf16(v0[0], v0[1]); w.y = cvt_pk_bf16(v0[2], v0[3]); w.z = cvt_pk_bf16(v1[0], v1[1]); w.w = cvt_pk_bf16(v1[2], v1[3]);
                    *(u32x4*)(O + r * 1024 + col0 + bj * HALF) = w; } }
    }
};

template <class Epi, class Sched, bool ALIGN_EPI = false, bool SP2 = false>
__device__ __forceinline__ void gemm_phase(PG8_LAS unsigned char* lds, const Gemm g, const Sched& S, const Epi& E) {
    int tid_ = threadIdx.x; asm volatile("" : "+v"(tid_)); const int tid = tid_, wid = __builtin_amdgcn_readfirstlane(tid >> 6), lane = tid & 63, wr = wid >> 2, wc = wid & 3, fr = lane & 15, fq = lane >> 4;
    const int K = g.K, nt = K / BK;
    unsigned voffA[2], voffB[2];
#pragma unroll
    for (int i = 0; i < 2; ++i) { int R, C; stage_rc(tid * 16 + i * 8192, R, C); const int Rb = Epi::PERM ? ((R & ~31) + perm32(R & 31)) : R;
        voffA[i] = (unsigned)(R * K + C) * 2u; voffB[i] = (unsigned)(Rb * K + C) * 2u; }
    const size_t kstep = (size_t)(BK * 2);
    const size_t hstep = (size_t)HALF * K * 2;
    const size_t tstep = 2 * hstep;
    const unsigned ldsw = (unsigned)wid * 1024u;
    const int aoff = lds_byte(wr * 64 + fr, fq * 8), boff = lds_byte(wc * 32 + fr, fq * 8);
#define PG8_SA(b, h) (((b) * 2 + (h)) * HTB)
#define PG8_SB(b, h) ((4 + (b) * 2 + (h)) * HTB)
#define PG8_STAGE(bufoff, gbase, voff) do { _Pragma("unroll") for (int _i = 0; _i < 2; ++_i) \
        __builtin_amdgcn_global_load_lds((const unsigned*)((const char*)(gbase) + (voff)[_i]), (PG8_LAS unsigned*)(lds + (bufoff) + ldsw + _i * 8192), 16, 0, 0); } while (0)
#define PG8_LDA(dst, b, h) do { _Pragma("unroll") for (int m = 0; m < 4; ++m) _Pragma("unroll") for (int k = 0; k < 2; ++k) dst[m][k] = *(const PG8_LAS bf16x8*)(lds + PG8_SA(b, h) + aoff + m * 2048 + k * 1024); } while (0)
#define PG8_LDB(dst, b, h) do { _Pragma("unroll") for (int n = 0; n < 2; ++n) _Pragma("unroll") for (int k = 0; k < 2; ++k) dst[n][k] = *(const PG8_LAS bf16x8*)(lds + PG8_SB(b, h) + boff + n * 2048 + k * 1024); } while (0)
#define PG8_MMA(ai, bj, At, Bt) do { __builtin_amdgcn_s_setprio(1); _Pragma("unroll") for (int m = 0; m < 4; ++m) _Pragma("unroll") for (int n = 0; n < 2; ++n) _Pragma("unroll") for (int k = 0; k < 2; ++k) \
        acc[ai][bj][m][n] = __builtin_amdgcn_mfma_f32_16x16x32_bf16(Bt[n][k], At[m][k], acc[ai][bj][m][n], 0, 0, 0); __builtin_amdgcn_s_setprio(0); } while (0)
#define PG8_WAIT_V(n) asm volatile("s_waitcnt vmcnt(" #n ")" ::: "memory")
#define PG8_WAIT_L(n) asm volatile("s_waitcnt lgkmcnt(" #n ")" ::: "memory")
#define PG8_BAR __builtin_amdgcn_s_barrier()
#define PG8_SCHED __builtin_amdgcn_sched_barrier(0)
    Unit cur, nxt; int ui = 0;
    if (!S.next(0, cur)) return;
    f32x4 acc[2][2][4][2];
#pragma unroll
    for (int a = 0; a < 2; ++a)
#pragma unroll
        for (int b = 0; b < 2; ++b)
#pragma unroll
            for (int m = 0; m < 4; ++m)
#pragma unroll
                for (int n = 0; n < 2; ++n) acc[a][b][m][n] = (f32x4){0.f, 0.f, 0.f, 0.f};
    bf16x8 At[4][2], B0[2][2], B1[2][2];
    const char* cA = (const char*)g.A + (size_t)cur.pm * tstep; const char* cB = (const char*)g.Bt + (size_t)cur.pn * tstep;
    S.a_ready(cur);
    if constexpr (SP2) {
        PG8_STAGE(PG8_SB(0, 0), cB, voffB); PG8_STAGE(PG8_SB(0, 1), cB + hstep, voffB); PG8_STAGE(PG8_SA(0, 0), cA, voffA); PG8_STAGE(PG8_SA(0, 1), cA + hstep, voffA);
        if (wr == 1) PG8_BAR;
        PG8_WAIT_V(2); PG8_BAR;
        PG8_STAGE(PG8_SB(1, 0), cB + kstep, voffB); PG8_STAGE(PG8_SA(1, 0), cA + kstep, voffA); PG8_STAGE(PG8_SB(1, 1), cB + hstep + kstep, voffB);
        PG8_WAIT_V(6); PG8_BAR;
    } else {
        PG8_STAGE(PG8_SB(0, 0), cB, voffB); PG8_STAGE(PG8_SA(0, 0), cA, voffA); PG8_STAGE(PG8_SB(0, 1), cB + hstep, voffB); PG8_STAGE(PG8_SA(0, 1), cA + hstep, voffA);
        if (wr == 1) PG8_BAR;
        PG8_WAIT_V(4); PG8_BAR;
        PG8_STAGE(PG8_SB(1, 0), cB + kstep, voffB); PG8_STAGE(PG8_SA(1, 0), cA + kstep, voffA); PG8_STAGE(PG8_SB(1, 1), cB + hstep + kstep, voffB);
        PG8_WAIT_V(6); PG8_BAR;
    }
    for (;;) {
        const bool has_next = S.next(ui + 1, nxt);
        const char* nA = has_next ? (const char*)g.A + (size_t)nxt.pm * tstep : cA; const char* nB = has_next ? (const char*)g.Bt + (size_t)nxt.pn * tstep : cB;
        for (int t = 0; t < nt; t += 2) {
            const bool last = (t == nt - 2);
            const char* a1 = cA + (size_t)(t + 1) * kstep;
            const char* a2 = last ? nA : cA + (size_t)(t + 2) * kstep; const char* b2 = last ? nB : cB + (size_t)(t + 2) * kstep;
            const char* a3 = a2 + kstep; const char* b3 = b2 + kstep;
            if (last && has_next) S.a_ready(nxt);
            if constexpr (SP2) {
            PG8_LDB(B0, 0, 0); PG8_LDB(B1, 0, 1); PG8_SCHED; PG8_LDA(At, 0, 0); PG8_STAGE(PG8_SA(1, 1), a1 + hstep, voffA);
            PG8_WAIT_V(8); PG8_WAIT_L(0); PG8_BAR; PG8_MMA(0, 0, At, B0); PG8_MMA(0, 1, At, B1); PG8_BAR; PG8_SCHED;
            PG8_LDA(At, 0, 1); PG8_STAGE(PG8_SB(0, 0), b2, voffB); PG8_STAGE(PG8_SB(0, 1), b2 + hstep, voffB); PG8_STAGE(PG8_SA(0, 0), a2, voffA);
            PG8_WAIT_V(8); PG8_WAIT_L(0); PG8_BAR; PG8_MMA(1, 0, At, B0); PG8_MMA(1, 1, At, B1); PG8_BAR; PG8_SCHED;
            PG8_LDB(B0, 1, 0); PG8_LDB(B1, 1, 1); PG8_SCHED; PG8_LDA(At, 1, 0); PG8_STAGE(PG8_SA(0, 1), a2 + hstep, voffA);
            PG8_WAIT_V(8); PG8_WAIT_L(0); PG8_BAR; PG8_MMA(0, 0, At, B0); PG8_MMA(0, 1, At, B1); PG8_BAR; PG8_SCHED;
            PG8_LDA(At, 1, 1); PG8_STAGE(PG8_SB(1, 0), b3, voffB); PG8_STAGE(PG8_SB(1, 1), b3 + hstep, voffB); PG8_STAGE(PG8_SA(1, 0), a3, voffA);
            PG8_WAIT_V(8); PG8_WAIT_L(0); PG8_BAR; PG8_MMA(1, 0, At, B0); PG8_MMA(1, 1, At, B1); PG8_BAR; PG8_SCHED;
            } else {
            PG8_LDB(B0, 0, 0); PG8_SCHED; PG8_LDA(At, 0, 0); PG8_STAGE(PG8_SA(1, 1), a1 + hstep, voffA);
            PG8_WAIT_L(8); PG8_BAR; PG8_WAIT_L(0); PG8_MMA(0, 0, At, B0); PG8_BAR; PG8_SCHED;
            PG8_LDB(B1, 0, 1); PG8_STAGE(PG8_SB(0, 0), b2, voffB);
            PG8_BAR; PG8_WAIT_L(0); PG8_MMA(0, 1, At, B1); PG8_BAR;
            PG8_LDA(At, 0, 1); PG8_STAGE(PG8_SA(0, 0), a2, voffA);
            PG8_BAR; PG8_WAIT_L(0); PG8_MMA(1, 0, At, B0); PG8_BAR; PG8_SCHED;
            PG8_STAGE(PG8_SB(0, 1), b2 + hstep, voffB);
            PG8_WAIT_V(6); PG8_BAR; PG8_MMA(1, 1, At, B1); PG8_BAR;
            PG8_LDB(B0, 1, 0); PG8_SCHED; PG8_LDA(At, 1, 0); PG8_STAGE(PG8_SA(0, 1), a2 + hstep, voffA);
            PG8_WAIT_L(8); PG8_BAR; PG8_WAIT_L(0); PG8_MMA(0, 0, At, B0); PG8_BAR; PG8_SCHED;
            PG8_LDB(B1, 1, 1); PG8_STAGE(PG8_SB(1, 0), b3, voffB);
            PG8_BAR; PG8_WAIT_L(0); PG8_MMA(0, 1, At, B1); PG8_BAR;
            PG8_LDA(At, 1, 1); PG8_STAGE(PG8_SA(1, 0), a3, voffA);
            PG8_BAR; PG8_WAIT_L(0); PG8_MMA(1, 0, At, B0); PG8_BAR; PG8_SCHED;
            PG8_STAGE(PG8_SB(1, 1), b3 + hstep, voffB);
            PG8_WAIT_V(6); PG8_BAR; PG8_MMA(1, 1, At, B1); PG8_BAR;
            }
        }
        if constexpr (ALIGN_EPI) { if (wr == 0) PG8_BAR; }
        if constexpr (!Epi::AFTER_DRAIN) { E(acc, cur, wr, wc, fr, fq); S.done(cur); }
        if (!has_next) break;
#pragma unroll
        for (int a = 0; a < 2; ++a)
#pragma unroll
            for (int b = 0; b < 2; ++b)
#pragma unroll
                for (int m = 0; m < 4; ++m)
#pragma unroll
                    for (int n = 0; n < 2; ++n) acc[a][b][m][n] = (f32x4){0.f, 0.f, 0.f, 0.f};
        cur = nxt; cA = nA; cB = nB; ++ui;
        if constexpr (ALIGN_EPI) { if (wr == 1) PG8_BAR; }
    }
    PG8_WAIT_V(0);
    if constexpr (!ALIGN_EPI) { if (wr == 0) PG8_BAR; }
    PG8_BAR;
    if constexpr (Epi::AFTER_DRAIN) { E.fused(acc, cur, wr, wc, fr, fq, lds, wid, lane); S.done(cur); }
#undef PG8_SA
#undef PG8_SB
#undef PG8_STAGE
#undef PG8_LDA
#undef PG8_LDB
#undef PG8_MMA
#undef PG8_WAIT_V
#undef PG8_WAIT_L
#undef PG8_BAR
#undef PG8_SCHED
}
}

#ifndef SSEL
#define SSEL 3
#endif
struct Args { const float* in[29]; float* out; unsigned char* ws; int ph_lo, ph_hi; };
constexpr int NW = 8, NT = NW * 64;
constexpr int LDS_BYTES = 147456;

__device__ __forceinline__ void transpose_item(const float* src, int srcN, int k0, int n0, int ncols, bf16* dst, int dstK, int dstrow, LAS float* scr, int lane) {
#pragma unroll 8
    for (int i = 0; i < 32; ++i) { const int kk = 2 * i + (lane >> 5), c = lane & 31; scr[kk * 33 + c] = (c < ncols) ? src[(size_t)(k0 + kk) * srcN + n0 + c] : 0.f; }
    asm volatile("s_waitcnt lgkmcnt(0)" ::: "memory");
    const int c = lane & 7;
#pragma unroll
    for (int j = 0; j < 4; ++j) { const int n = (lane >> 3) + 8 * j; const LAS float* s = scr + (8 * c) * 33 + n;
        u32x4 o; o.x = pk2(s[0 * 33], s[1 * 33]); o.y = pk2(s[2 * 33], s[3 * 33]); o.z = pk2(s[4 * 33], s[5 * 33]); o.w = pk2(s[6 * 33], s[7 * 33]);
        if (n < ncols) *(u32x4*)(dst + (size_t)(dstrow + n) * dstK + k0 + 8 * c) = o; }
    asm volatile("s_waitcnt lgkmcnt(0)" ::: "memory");
}
__device__ __forceinline__ void phase_wconv(const Args& a, int l, LAS unsigned char* lds) {
    const int tid = otid(), lane = tid & 63, wave = tid >> 6;
    LAS float* scr = (LAS float*)(lds + wave * 16384);
    unsigned char* wt = a.ws + WS_WT;
    const int gw = blockIdx.x * NW + wave, NGW = gridDim.x * NW;
    constexpr int I_1A = 16 * 176, I_1D = 44 * 32, I_INA = 16 * 162, I_INB = 16 * 128, I_SQ = 16 * 32;
    constexpr int NITEMS = 2 * I_1A + 2 * I_1D + I_INA + I_INB + 3 * I_SQ;
    for (int it = gw; it < NITEMS; it += NGW) {
        int r = it;
        if (r < 2 * I_1A) {
            const int f = r / I_1A; r -= f * I_1A; const int kb = r / 176, nb = r % 176, up = nb >= 88, c0 = 32 * (nb - 88 * up);
            const float* src = a.in[f == 0 ? (up ? 11 : 10) : (up ? 25 : 24)] + (size_t)l * D * FF;
            transpose_item(src, FF, 64 * kb, c0, 32, (bf16*)(wt + (f == 0 ? WT_W1A : WT_W2A)), D, 256 * (c0 >> 7) + (c0 & 127) + 128 * up, scr, lane); continue; }
        r -= 2 * I_1A;
        if (r < 2 * I_1D) {
            const int f = r / I_1D; r -= f * I_1D; const int kb = r / 32, nb = r % 32;
            transpose_item(a.in[f == 0 ? 12 : 26] + (size_t)l * FF * D, D, 64 * kb, 32 * nb, 32, (bf16*)(wt + (f == 0 ? WT_W1D : WT_W2D)), FF, 32 * nb, scr, lane); continue; }
        r -= 2 * I_1D;
        if (r < I_INA) { const int kb = r / 162, nb = r % 162; const float* src = a.in[13] + (size_t)l * D * DIN;
            int dr = 32 * nb, sc, nc = 32;
            if (nb < 160) sc = dr < 2048 ? dr : dr + 1056; else if (nb == 160) sc = 3072; else { sc = 7200; nc = 16; }
            transpose_item(src, DIN, 64 * kb, sc, nc, (bf16*)(wt + WT_WINA), D, dr, scr, lane); continue; }
        r -= I_INA;
        if (r < I_INB) { const int kb = r / 128, nb = r % 128; const float* src = a.in[13] + (size_t)l * D * DIN;
            const int dr = 32 * nb, sc = dr < 1024 ? dr + 2048 : (dr < 2048 ? dr + 5152 : dr + 5168);
            transpose_item(src, DIN, 64 * kb, sc, 32, (bf16*)(wt + WT_WINB), D, dr, scr, lane); continue; }
        r -= I_INB;
        { const int f = r / I_SQ; r -= f * I_SQ; const int kb = r / 32, nb = r % 32;
          transpose_item(a.in[21 + f] + (size_t)l * D * D, D, 64 * kb, 32 * nb, 32, (bf16*)(wt + (f == 0 ? WT_WBG : f == 1 ? WT_WBM : WT_WO)), D, 32 * nb, scr, lane); }
    }
}
__device__ __forceinline__ void phase_ada(const Args& a, LAS unsigned char* lds) {
    LAS float* sil = (LAS float*)lds;
    LAS float* red = (LAS float*)(lds + 36864);
    const int tid = otid();
    for (int i = tid; i < NCOND * D; i += NT) { const int ci = i >> 10, k = i & 1023; const float v = ci == 0 ? a.in[7][k] : a.in[2][(ci - 1) * D + k]; sil[i] = v / (1.f + expf(-v)); }
    __syncthreads();
    float* ada = (float*)(a.ws + WS_ADA);
    const int c = tid & 63, s = tid >> 6;
    for (int it = blockIdx.x; it < 2 * 144; it += gridDim.x) {
        const int l = it / 144, g = it % 144; const float* W = a.in[8] + (size_t)l * D * NADA + 64 * g + c;
        float acc[NCOND];
#pragma unroll
        for (int ci = 0; ci < NCOND; ++ci) acc[ci] = 0.f;
#pragma unroll 4
        for (int k = s; k < D; k += 8) { const float w = W[(size_t)k * NADA];
#pragma unroll
            for (int ci = 0; ci < NCOND; ++ci) acc[ci] += sil[ci * D + k] * w; }
#pragma unroll
        for (int ci = 0; ci < NCOND; ++ci) red[(s * NCOND + ci) * 64 + c] = acc[ci];
        __syncthreads();
        for (int i = tid; i < NCOND * 64; i += NT) { const int ci = i >> 6, cc = i & 63; float sum = a.in[9][(size_t)l * NADA + 64 * g + cc];
#pragma unroll
            for (int ss = 0; ss < 8; ++ss) sum += red[(ss * NCOND + ci) * 64 + cc];
            ada[((size_t)l * NCOND + ci) * NADA + 64 * g + cc] = sum; }
        __syncthreads();
    }
}
__device__ __forceinline__ void store_mod_row(bf16* hrow, const f32x4 (&v)[4], const float* sh, const float* sc, int lane) {
#pragma unroll
    for (int j = 0; j < 4; ++j) { const f32x4 s = *(const f32x4*)(sc + 256 * j + 4 * lane), t = *(const f32x4*)(sh + 256 * j + 4 * lane);
        const f32x4 h = v[j] * (s + 1.0f) + t; u32x2 w; w.x = pk2(h[0], h[1]); w.y = pk2(h[2], h[3]); *(u32x2*)(hrow + 256 * j + 4 * lane) = w; }
}
__device__ __forceinline__ void phase_xinit(const Args& a) {
    const int tid = otid(), lane = tid & 63, gw = blockIdx.x * NW + (tid >> 6), NGW = gridDim.x * NW;
    const float* ada = (const float*)(a.ws + WS_ADA);
    bf16* H = (bf16*)(a.ws + WS_H);
    for (int r = gw; r < M; r += NGW) {
        f32x4 v[4];
        if (r < NPROMPT_ROWS) {
#pragma unroll
            for (int j = 0; j < 4; ++j) v[j] = *(const f32x4*)(a.in[0] + (size_t)r * D + 256 * j + 4 * lane);
        } else {
            const int rs = r - NPROMPT_ROWS, t = rs & 1023; const float gr = (float)(t >> 6), gc = (float)(t & 63);
#pragma unroll
            for (int j = 0; j < 4; ++j) { v[j] = *(const f32x4*)(a.in[1] + (size_t)rs * D + 256 * j + 4 * lane);
#pragma unroll
                for (int e = 0; e < 4; ++e) { const float om = 1.0f / powf(10000.0f, (float)(4 * lane + e) * (1.0f / 256.0f)); const float ang = (j < 2 ? gr : gc) * om;
                    v[j][e] += (j & 1) ? cosf(ang) : sinf(ang); } }
        }
#pragma unroll
        for (int j = 0; j < 4; ++j) *(f32x4*)(a.out + (size_t)r * D + 256 * j + 4 * lane) = v[j];
        const float* ad = ada + (size_t)cond_of_row(r) * NADA;
        store_mod_row(H + (size_t)r * D, v, ad, ad + 1024, lane);
    }
}
__device__ __forceinline__ void phase_ln(const Args& a, const float* lng, const float* lnb, const float* mod) {
    const int tid = otid(), lane = tid & 63, gw = blockIdx.x * NW + (tid >> 6), NGW = gridDim.x * NW;
    const float* P = (const float*)(a.ws + WS_PRE);
    bf16* H = (bf16*)(a.ws + WS_H);
    for (int r = gw; r < M; r += NGW) {
        f32x4 v[4]; float s = 0.f;
#pragma unroll
        for (int j = 0; j < 4; ++j) { v[j] = *(const f32x4*)(P + (size_t)r * D + 256 * j + 4 * lane); s += (v[j][0] + v[j][1]) + (v[j][2] + v[j][3]); }
        const float mean = wave_sum(s) * (1.f / D); float s2 = 0.f;
#pragma unroll
        for (int j = 0; j < 4; ++j) { v[j] = v[j] - mean; s2 += (v[j][0] * v[j][0] + v[j][1] * v[j][1]) + (v[j][2] * v[j][2] + v[j][3] * v[j][3]); }
        const float rstd = 1.0f / sqrtf(wave_sum(s2) * (1.f / D) + LN_EPS);
#pragma unroll
        for (int j = 0; j < 4; ++j) { const f32x4 g = *(const f32x4*)(lng + 256 * j + 4 * lane), b = *(const f32x4*)(lnb + 256 * j + 4 * lane);
            v[j] = v[j] * rstd * g + b; *(f32x4*)(a.out + (size_t)r * D + 256 * j + 4 * lane) = v[j]; }
        if (mod) { const float* ad = mod + (size_t)cond_of_row(r) * NADA; store_mod_row(H + (size_t)r * D, v, ad, ad + 1024, lane); }
    }
}
__device__ __forceinline__ void phase_combine(const Args& a, int l) {
    const int tid = otid(), lane = tid & 63, gw = blockIdx.x * NW + (tid >> 6), NGW = gridDim.x * NW;
    const bf16* ZB = (const bf16*)(a.ws + WS_ZB);
    for (int r = gw; r < M; r += NGW) {
#pragma unroll
        for (int br = 0; br < 2; ++br) {
            bf16* OF = (bf16*)(a.ws + WS_O + (size_t)(2 * br) * O_STRIDE) + (size_t)r * D; const bf16* OB = (const bf16*)(a.ws + WS_O + (size_t)(2 * br + 1) * O_STRIDE) + (size_t)r * D;
            const float* gam = a.in[19 + br] + l * 256 + 4 * lane; const f32x4 gv = *(const f32x4*)gam;
            const bf16* gate = ZB + (size_t)r * ZB_W + br * 1024;
#pragma unroll
            for (int h = 0; h < 4; ++h) {
                const u32x2 wf = *(const u32x2*)(OF + 256 * h + 4 * lane), wb = *(const u32x2*)(OB + 256 * h + 4 * lane), wg = *(const u32x2*)(gate + 256 * h + 4 * lane);
                f32x4 s; s[0] = bf_lo(wf.x) + bf_lo(wb.x); s[1] = bf_hi(wf.x) + bf_hi(wb.x); s[2] = bf_lo(wf.y) + bf_lo(wb.y); s[3] = bf_hi(wf.y) + bf_hi(wb.y);
                const float ss = wave_sum((s[0] * s[0] + s[1] * s[1]) + (s[2] * s[2] + s[3] * s[3]));
                const float rs = 1.0f / sqrtf(ss * (1.f / 256.f) + NORM_EPS);
                f32x4 o = s * rs * gv; o[0] *= bf_lo(wg.x); o[1] *= bf_hi(wg.x); o[2] *= bf_lo(wg.y); o[3] *= bf_hi(wg.y);
                u32x2 w; w.x = pk2(o[0], o[1]); w.y = pk2(o[2], o[3]); *(u32x2*)(OF + 256 * h + 4 * lane) = w;
            }
        }
    }
}
__device__ __forceinline__ void scan_gla_naive(const Args& a, int l, int sample, int b, int h, int dir, LAS unsigned char* lds) {
    const int tid = otid(), dv = tid & 255, half = tid >> 8;
    const int T = sample ? 1024 : 256, row0 = sample ? NPROMPT_ROWS + b * 1024 : b * 256;
    const bf16* ZA = (const bf16*)(a.ws + WS_ZA); const float* ZS = (const float*)(a.ws + WS_ZS);
    bf16* OG = (bf16*)(a.ws + WS_O + (size_t)dir * O_STRIDE);
    LAS float* qs = (LAS float*)lds; LAS float* ks = qs + 16 * 128; LAS float* es = ks + 16 * 128; LAS float* op = es + 16 * 128; LAS float* vs = op + 32 * 256;
    float S[64];
    const size_t sidx = ((((size_t)b * 2 + l) * 2 + dir) * 4 + h) * (128 * 256);
    if (sample) {
#pragma unroll
        for (int i = 0; i < 64; ++i) { S[i] = a.in[3][sidx + (size_t)(half * 64 + i) * 256 + dv]; if ((i & 7) == 7) asm volatile("" ::: "memory"); }
    } else {
#pragma unroll
        for (int i = 0; i < 64; ++i) S[i] = 0.f;
    }
    const int d = tid & 127, jq = tid >> 7;
    float wd[16];
#pragma unroll
    for (int r = 0; r < 16; ++r) wd[r] = a.in[14][(((size_t)l * 2 + dir) * 16 + r) * 512 + h * 128 + d];
    const float bd = a.in[15][((size_t)l * 2 + dir) * 512 + h * 128 + d];
#pragma unroll 1
    for (int t0 = 0; t0 < T; t0 += 16) {
        __syncthreads();
#pragma unroll 1
        for (int i = 0; i < 4; ++i) { const int j = jq + 4 * i, tok = dir ? T - 1 - (t0 + j) : t0 + j; const size_t r = (size_t)(row0 + tok);
            float x = bd;
#pragma unroll
            for (int q4 = 0; q4 < 4; ++q4) { const f32x4 av = *(const f32x4*)(ZS + r * 64 + dir * 16 + 4 * q4); x += av[0] * wd[4 * q4] + av[1] * wd[4 * q4 + 1] + av[2] * wd[4 * q4 + 2] + av[3] * wd[4 * q4 + 3]; }
            es[j * 128 + d] = expf(log_sigmoid(x) * (1.f / 16.f));
            qs[j * 128 + d] = bf2f(ZA[r * ZA_W + h * 128 + d]) * 0.08838834764831845f;
            ks[j * 128 + d] = bf2f(ZA[r * ZA_W + 512 + h * 128 + d]); }
#pragma unroll 2
        for (int jj = 0; jj < 8; ++jj) { const int j = half * 8 + jj; const int tok = dir ? T - 1 - (t0 + j) : t0 + j; vs[j * 256 + dv] = bf2f(ZA[(size_t)(row0 + tok) * ZA_W + 1024 + h * 256 + dv]); }
        __syncthreads();
#pragma unroll 1
        for (int j = 0; j < 16; ++j) { float acc = 0.f; const float vj = vs[j * 256 + dv];
#pragma unroll
            for (int i4 = 0; i4 < 16; ++i4) { const int dk = half * 64 + 4 * i4; const f32x4 e4 = *(const LAS f32x4*)(es + j * 128 + dk), k4 = *(const LAS f32x4*)(ks + j * 128 + dk), q4 = *(const LAS f32x4*)(qs + j * 128 + dk);
#pragma unroll
                for (int e = 0; e < 4; ++e) { S[4 * i4 + e] = e4[e] * S[4 * i4 + e] + k4[e] * vj; acc += q4[e] * S[4 * i4 + e]; }
                asm volatile("" ::: "memory"); }
            op[(half * 16 + j) * 256 + dv] = acc; }
        __syncthreads();
#pragma unroll 2
        for (int jj = 0; jj < 8; ++jj) { const int j = half * 8 + jj; const int tok = dir ? T - 1 - (t0 + j) : t0 + j; OG[(size_t)(row0 + tok) * D + h * 256 + dv] = (bf16)f2bf(op[j * 256 + dv] + op[(16 + j) * 256 + dv]); }
    }
    if (!sample) {
#pragma unroll
        for (int i = 0; i < 64; ++i) { a.out[OUT_GLA + sidx + (size_t)(half * 64 + i) * 256 + dv] = S[i]; if ((i & 7) == 7) asm volatile("" ::: "memory"); }
    }
}
__device__ __forceinline__ void scan_mlstm_naive(const Args& a, int l, int sample, int b, int h, int dir, LAS unsigned char* lds) {
    const int tid = otid(), dv = tid & 255, half = tid >> 8, lane = tid & 63, wave = tid >> 6;
    const int T = sample ? 1024 : 256, row0 = sample ? NPROMPT_ROWS + b * 1024 : b * 256;
    const bf16* ZA = (const bf16*)(a.ws + WS_ZA); const float* ZS = (const float*)(a.ws + WS_ZS);
    bf16* OM = (bf16*)(a.ws + WS_O + (size_t)(2 + dir) * O_STRIDE);
    LAS float* qs = (LAS float*)lds; LAS float* ks = qs + 16 * 256; LAS float* op = ks + 16 * 256; LAS float* qnp = op + 32 * 256; LAS float* gt = qnp + 16 * 256; LAS float* vs = gt + 128;
    float C[128];
    const size_t hidx = (((size_t)b * 2 + l) * 2 + dir) * 4 + h;
    float n = 0.f, m = 0.f;
    if (sample) {
#pragma unroll
        for (int i = 0; i < 128; ++i) { C[i] = a.in[4][hidx * 65536 + (size_t)(half * 128 + i) * 256 + dv]; if ((i & 7) == 7) asm volatile("" ::: "memory"); }
        if (tid < 256) n = a.in[5][hidx * 256 + tid];
        m = a.in[6][hidx];
    } else {
#pragma unroll
        for (int i = 0; i < 128; ++i) C[i] = 0.f;
    }
    const int chan = (tid < 256) ? h * 256 + tid : 1024 + h * 256 + (tid - 256);
    const float w0 = a.in[16][((size_t)l * 3 + 0) * 2048 + chan], w1 = a.in[16][((size_t)l * 3 + 1) * 2048 + chan], w2 = a.in[16][((size_t)l * 3 + 2) * 2048 + chan], bc = a.in[17][(size_t)l * 2048 + chan];
    const float fb = a.in[18][((size_t)l * 2 + dir) * 4 + h];
#pragma unroll 1
    for (int t0 = 0; t0 < T; t0 += 16) {
        __syncthreads();
#pragma unroll 2
        for (int j = 0; j < 16; ++j) { const int tok = dir ? T - 1 - (t0 + j) : t0 + j; const bf16* zp = ZA + (size_t)(row0 + tok) * ZA_W + 2048 + chan;
            const float zc = bf2f(zp[0]), zm = tok > 0 ? bf2f(zp[-ZA_W]) : 0.f, zn = tok < T - 1 ? bf2f(zp[ZA_W]) : 0.f;
            const float x = w0 * zm + w1 * zc + w2 * zn + bc; const float sv = x / (1.f + expf(-x));
            if (tid < 256) qs[j * 256 + tid] = sv * 0.0625f; else ks[j * 256 + tid - 256] = sv; }
        if (tid == 0) { float mm = m;
            for (int j = 0; j < 16; ++j) { const int tok = dir ? T - 1 - (t0 + j) : t0 + j; const float* zr = ZS + (size_t)(row0 + tok) * 64 + 32 + dir * 8 + h;
                const float ig = zr[0], lf = log_sigmoid(zr[4] + fb); const float mn = fmaxf(lf + mm, ig);
                gt[j] = expf(lf + mm - mn); gt[16 + j] = expf(ig - mn); gt[32 + j] = expf(-mn); mm = mn; }
            gt[64] = mm; }
#pragma unroll 2
        for (int jj = 0; jj < 8; ++jj) { const int j = half * 8 + jj; const int tok = dir ? T - 1 - (t0 + j) : t0 + j; vs[j * 256 + dv] = bf2f(ZA[(size_t)(row0 + tok) * ZA_W + 4096 + h * 256 + dv]); }
        __syncthreads();
        m = gt[64];
#pragma unroll 1
        for (int j = 0; j < 16; ++j) { const float f = gt[j], w = gt[16 + j]; const float kv = w * vs[j * 256 + dv]; float acc = 0.f;
#pragma unroll
            for (int i4 = 0; i4 < 32; ++i4) { const int dk = half * 128 + 4 * i4; const f32x4 k4 = *(const LAS f32x4*)(ks + j * 256 + dk), q4 = *(const LAS f32x4*)(qs + j * 256 + dk);
#pragma unroll
                for (int e = 0; e < 4; ++e) { C[4 * i4 + e] = f * C[4 * i4 + e] + k4[e] * kv; acc += q4[e] * C[4 * i4 + e]; }
                asm volatile("" ::: "memory"); }
            op[(half * 16 + j) * 256 + dv] = acc;
            if (tid < 256) { n = f * n + w * ks[j * 256 + tid]; qnp[j * 256 + tid] = qs[j * 256 + tid] * n; } }
        __syncthreads();
#pragma unroll
        for (int jj = 0; jj < 2; ++jj) { const int j = 2 * wave + jj; const f32x4 p = *(const LAS f32x4*)(qnp + j * 256 + 4 * lane); const float s = wave_sum((p[0] + p[1]) + (p[2] + p[3])); if (lane == 0) gt[48 + j] = s; }
        __syncthreads();
#pragma unroll 2
        for (int jj = 0; jj < 8; ++jj) { const int j = half * 8 + jj; const int tok = dir ? T - 1 - (t0 + j) : t0 + j; const float den = fmaxf(fabsf(gt[48 + j]), gt[32 + j]);
            OM[(size_t)(row0 + tok) * D + h * 256 + dv] = (bf16)f2bf((op[j * 256 + dv] + op[(16 + j) * 256 + dv]) / den); }
    }
    if (!sample) {
#pragma unroll
        for (int i = 0; i < 128; ++i) { a.out[OUT_MC + hidx * 65536 + (size_t)(half * 128 + i) * 256 + dv] = C[i]; if ((i & 7) == 7) asm volatile("" ::: "memory"); }
        if (tid < 256) a.out[OUT_MN + hidx * 256 + tid] = n;
        if (tid == 0) a.out[OUT_MM + hidx] = m;
    }
}
__device__ __forceinline__ void phase_scan_naive(const Args& a, int l, LAS unsigned char* lds) {
    for (int u = blockIdx.x; u < 640; u += gridDim.x) {
        int kind, sample, v;
        if (u < 64) { kind = 1; sample = 1; v = u; } else if (u < 128) { kind = 0; sample = 1; v = u - 64; } else if (u < 384) { kind = 1; sample = 0; v = u - 128; } else { kind = 0; sample = 0; v = u - 384; }
        const int dir = v & 1, h = (v >> 1) & 3, b = v >> 3;
        if (kind) { if (SSEL & 2) scan_mlstm_naive(a, l, sample, b, h, dir, lds); } else { if (SSEL & 1) scan_gla_naive(a, l, sample, b, h, dir, lds); }
        __syncthreads();
    }
}

template <class Epi> __device__ __forceinline__ void run_gemm(LAS unsigned char* lds, const bf16* A, const bf16* Bt, int N, int K, const Epi& E) {
    pg8::Gemm g{A, Bt, M, N, K}; pg8::StaticOrder S; S.init(M, N, (int)gridDim.x, (int)blockIdx.x);
    pg8::gemm_phase<Epi, pg8::StaticOrder, true, true>(lds, g, S, E);
}
#ifndef GSEL
#define GSEL 0x1ff
#endif
constexpr int PH_PER_LAYER = 15, N_PHASES = 2 + 2 * PH_PER_LAYER;

template <bool COOP, int MASK> __global__ void __launch_bounds__(NT, 2) mk_fwd(Args a) {
    extern __shared__ __attribute__((aligned(16))) unsigned char lds_raw[];
    LAS unsigned char* lds = (LAS unsigned char*)lds_raw;
    const int lo = a.ph_lo, hi = a.ph_hi;
    unsigned char* ws = a.ws;
    const float* ada = (const float*)(ws + WS_ADA);
    bf16* H = (bf16*)(ws + WS_H); bf16* ACT = (bf16*)(ws + WS_ACT); float* PRE = (float*)(ws + WS_PRE);
    bf16* ZA = (bf16*)(ws + WS_ZA); bf16* ZB = (bf16*)(ws + WS_ZB); float* ZS = (float*)(ws + WS_ZS);
    bf16* O0 = (bf16*)(ws + WS_O); bf16* O1 = (bf16*)(ws + WS_O + O_STRIDE); bf16* O2 = (bf16*)(ws + WS_O + 2 * O_STRIDE); bf16* O3 = (bf16*)(ws + WS_O + 3 * O_STRIDE);
    const unsigned char* wt = ws + WS_WT;
#define MISC (MASK & 1)
#define SCAN (MASK & 2)
#define GEMM (MASK & 4)
#pragma unroll 1
    for (int ph = lo; ph < hi; ++ph) {
        int l = 0, q = ph;
        if (ph >= 2) { l = (ph - 2) / PH_PER_LAYER; q = 2 + (ph - 2) % PH_PER_LAYER; }
        const float* adl = ada + (size_t)l * NCOND * NADA;
        const float* lng = a.in[27] + (size_t)l * 3 * D; const float* lnb = a.in[28] + (size_t)l * 3 * D;
        switch (q) {
        case 0: if (MISC) { phase_ada(a, lds); __syncthreads(); phase_wconv(a, 0, lds); } break;
        case 1: if (MISC) { phase_xinit(a); } break;
        case 2: if (MISC) { if (l > 0) phase_wconv(a, l, lds); } break;
        case 3: if (GEMM && (GSEL >> 0 & 1)) { pg8::EpiSwiglu E{ACT, FF}; run_gemm(lds, H, (const bf16*)(wt + WT_W1A), W1A_N, D, E); } break;
        case 4: if (GEMM && (GSEL >> 1 & 1)) { pg8::EpiPre E{a.out, PRE, adl + 2 * D, 0.5f}; run_gemm(lds, ACT, (const bf16*)(wt + WT_W1D), D, FF, E); } break;
        case 5: if (MISC) { phase_ln(a, lng, lnb, adl + 3 * D); } break;
        case 6: if (GEMM && (GSEL >> 2 & 1)) { pg8::EpiZ<0> E{ZA, ZA_W, ZS, 20}; run_gemm(lds, H, (const bf16*)(wt + WT_WINA), WINA_N, D, E); } break;
        case 7: if (SCAN) { phase_scan_naive(a, l, lds); } break;
        case 8: if (GEMM && (GSEL >> 3 & 1)) { pg8::EpiZ<1> E{ZB, ZB_W, nullptr, 1 << 30}; run_gemm(lds, H, (const bf16*)(wt + WT_WINB), WINB_N, D, E); } break;
        case 9: if (MISC) { phase_combine(a, l); } break;
        case 10: if (GEMM && (GSEL >> 4 & 1)) { pg8::EpiBranch<false> E{ZB + 2048, ZB_W, nullptr, O1}; run_gemm(lds, O0, (const bf16*)(wt + WT_WBG), D, D, E); } break;
        case 11: if (GEMM && (GSEL >> 5 & 1)) { pg8::EpiBranch<true> E{ZB + 3072, ZB_W, O1, O3}; run_gemm(lds, O2, (const bf16*)(wt + WT_WBM), D, D, E); } break;
        case 12: if (GEMM && (GSEL >> 1 & 1)) { pg8::EpiPre E{a.out, PRE, adl + 5 * D, 1.0f}; run_gemm(lds, O3, (const bf16*)(wt + WT_WO), D, D, E); } break;
        case 13: if (MISC) { phase_ln(a, lng + D, lnb + D, adl + 6 * D); } break;
        case 14: if (GEMM && (GSEL >> 0 & 1)) { pg8::EpiSwiglu E{ACT, FF}; run_gemm(lds, H, (const bf16*)(wt + WT_W2A), W1A_N, D, E); } break;
        case 15: if (GEMM && (GSEL >> 1 & 1)) { pg8::EpiPre E{a.out, PRE, adl + 8 * D, 0.5f}; run_gemm(lds, ACT, (const bf16*)(wt + WT_W2D), D, FF, E); } break;
        case 16: if (MISC) { phase_ln(a, lng + 2 * D, lnb + 2 * D, l == 0 ? ada + (size_t)NCOND * NADA : nullptr); } break;
        default: break;
        }
        if (COOP && ph + 1 < hi) { __syncthreads(); cg::this_grid().sync(); }
    }
#undef MISC
#undef SCAN
#undef GEMM
}

#ifndef MK_ONE_LAUNCH
#define MK_ONE_LAUNCH 0
#endif
extern "C" void kernel_launch(void* const* d_in, const int* in_sizes, int n_in, void* d_out, int out_size, void* d_ws, size_t ws_size, hipStream_t stream) {
    static int grid = 0;
    if (grid == 0) {
        if (n_in != 29 || ws_size < WS_END) { fprintf(stderr, "kernel_launch: unexpected n_in %d or ws_size %zu (< %zu); nothing launched\n", n_in, ws_size, (size_t)WS_END); grid = -1; return; }
        int dev = 0, cus = 0;
        (void)hipGetDevice(&dev); (void)hipDeviceGetAttribute(&cus, hipDeviceAttributeMultiprocessorCount, dev);
        int per_cu = 0;
#if MK_ONE_LAUNCH
        (void)hipFuncSetAttribute((const void*)mk_fwd<true, 7>, hipFuncAttributeMaxDynamicSharedMemorySize, LDS_BYTES);
        (void)hipOccupancyMaxActiveBlocksPerMultiprocessor(&per_cu, (const void*)mk_fwd<true, 7>, NT, LDS_BYTES);
#else
        (void)hipFuncSetAttribute((const void*)mk_fwd<false, 1>, hipFuncAttributeMaxDynamicSharedMemorySize, LDS_BYTES);
        (void)hipFuncSetAttribute((const void*)mk_fwd<false, 2>, hipFuncAttributeMaxDynamicSharedMemorySize, LDS_BYTES);
        (void)hipFuncSetAttribute((const void*)mk_fwd<false, 4>, hipFuncAttributeMaxDynamicSharedMemorySize, LDS_BYTES);
        per_cu = 1;
#endif
        (void)hipGetLastError();
        grid = cus > 0 ? cus : 256;
        if (per_cu < 1) fprintf(stderr, "kernel_launch: occupancy query says %d blocks per CU\n", per_cu);
    }
    if (grid < 0) return;
    Args a{};
    for (int i = 0; i < 29; ++i) a.in[i] = (const float*)d_in[i];
    a.out = (float*)d_out; a.ws = (unsigned char*)d_ws;
#if MK_ONE_LAUNCH
    a.ph_lo = 0; a.ph_hi = N_PHASES;
    void* args[] = {&a};
    hipError_t e = hipLaunchCooperativeKernel((const void*)mk_fwd<true, 7>, dim3(grid), dim3(NT), args, LDS_BYTES, stream);
    if (e != hipSuccess) fprintf(stderr, "cooperative launch failed: %s (grid %d)\n", hipGetErrorString(e), grid);
#else
    for (int p = 0; p < N_PHASES; ++p) {
        if (p == 2) continue;
        a.ph_lo = p; a.ph_hi = p + 1;
        const int q = p < 2 ? -1 : (p - 2) % PH_PER_LAYER;
        if (q == 5) hipLaunchKernelGGL((mk_fwd<false, 2>), dim3(grid), dim3(NT), LDS_BYTES, stream, a);
        else if (q == 1 || q == 2 || q == 4 || q == 6 || q == 8 || q == 9 || q == 10 || q == 12 || q == 13) hipLaunchKernelGGL((mk_fwd<false, 4>), dim3(grid), dim3(NT), LDS_BYTES, stream, a);
        else hipLaunchKernelGGL((mk_fwd<false, 1>), dim3(grid), dim3(NT), LDS_BYTES, stream, a);
    }
#endif
}
```

```cpp
#include <hip/hip_runtime.h>
#include <hip/hip_cooperative_groups.h>
#include <cstdio>
#include <cstdint>
namespace cg = cooperative_groups;

#define GAS __attribute__((address_space(1)))
#define LAS __attribute__((address_space(3)))

constexpr int M = 16384, D = 1024, FF = 2816, NPROMPT_ROWS = 8192;
constexpr int NADA = 9216, NCOND = 9;
constexpr int ZA_W = 5120, ZB_W = 4096, ZS_W = 64;
constexpr int WINA_N = 5376, WINB_N = 4096, W1A_N = 5632;
constexpr int DIN = 9264;
constexpr float ALPHA = 1.4142135623730951f;
constexpr float LN_EPS = 1e-5f, NORM_EPS = 1e-6f;

constexpr size_t MiB = 1u << 20;
constexpr size_t WS_CTL = 0, CTL_BYTES = 1 * MiB;
constexpr size_t WS_ADA = 1 * MiB;
constexpr size_t WS_WT = 2 * MiB;
constexpr size_t WT_W1A = 0, WT_W1D = WT_W1A + (size_t)W1A_N * D * 2, WT_WINA = WT_W1D + (size_t)D * FF * 2, WT_WINB = WT_WINA + (size_t)WINA_N * D * 2,
                 WT_WBG = WT_WINB + (size_t)WINB_N * D * 2, WT_WBM = WT_WBG + (size_t)D * D * 2, WT_WO = WT_WBM + (size_t)D * D * 2,
                 WT_W2A = WT_WO + (size_t)D * D * 2, WT_W2D = WT_W2A + (size_t)W1A_N * D * 2, WT_END = WT_W2D + (size_t)D * FF * 2;
static_assert(WT_END <= 58 * MiB, "weights fit");
constexpr size_t WS_H = 60 * MiB;
constexpr size_t WS_ZS = 92 * MiB;
constexpr size_t WS_ZA = 96 * MiB;
constexpr size_t WS_ACT = WS_ZA, WS_PRE = WS_ZA + 88 * MiB, WS_ZB = WS_ZA;
constexpr size_t WS_O = 256 * MiB;
constexpr size_t O_STRIDE = 32 * MiB;
constexpr size_t WS_END = 384 * MiB;

constexpr size_t OUT_GLA = (size_t)M * D, OUT_MC = OUT_GLA + 16777216ull, OUT_MN = OUT_MC + 33554432ull, OUT_MM = OUT_MN + 131072ull;

typedef unsigned short bf16;
typedef float f32x4 __attribute__((ext_vector_type(4)));
typedef unsigned u32x4 __attribute__((ext_vector_type(4)));
typedef unsigned u32x2 __attribute__((ext_vector_type(2)));

__device__ __forceinline__ unsigned f2bf(float f) { unsigned u = __builtin_bit_cast(unsigned, f); return (u + 0x7fffu + ((u >> 16) & 1u)) >> 16; }
__device__ __forceinline__ unsigned pk2(float lo, float hi) { return f2bf(lo) | (f2bf(hi) << 16); }
__device__ __forceinline__ float bf_lo(unsigned w) { return __builtin_bit_cast(float, w << 16); }
__device__ __forceinline__ float bf_hi(unsigned w) { return __builtin_bit_cast(float, w & 0xffff0000u); }
__device__ __forceinline__ float bf2f(bf16 v) { return __builtin_bit_cast(float, (unsigned)v << 16); }
__device__ __forceinline__ float fast_sigmoid(float x) { return __builtin_amdgcn_rcpf(1.0f + __builtin_amdgcn_exp2f(-1.4426950408889634f * x)); }
__device__ __forceinline__ float fast_silu(float x) { return x * fast_sigmoid(x); }
__device__ __forceinline__ float log_sigmoid(float x) { return fminf(x, 0.f) - log1pf(expf(-fabsf(x))); }
__device__ __forceinline__ float wave_sum(float v) {
#pragma unroll
    for (int o = 1; o < 64; o <<= 1) v += __shfl_xor(v, o);
    return v;
}
__device__ __forceinline__ int cond_of_row(int r) { return r < NPROMPT_ROWS ? 0 : 1 + ((r - NPROMPT_ROWS) >> 10); }

__device__ __forceinline__ int otid() { int t = threadIdx.x; asm volatile("" : "+v"(t)); return t; }

namespace pg8 {
#define PG8_LAS __attribute__((address_space(3)))
typedef unsigned short bf16_t;
typedef short bf16x8 __attribute__((ext_vector_type(8)));
typedef float f32x4 __attribute__((ext_vector_type(4)));
typedef unsigned u32x4 __attribute__((ext_vector_type(4)));
constexpr int BM = 256, BK = 64, HALF = 128, HTB = HALF * BK * 2  , STAGE_BYTES = 8 * HTB, NXCD = 8, WGM = 8;

__host__ __device__ __forceinline__ int lds_byte(int r, int c) { const int st = (r >> 4) * 2 + (c >> 5), rr = r & 15, cc = c & 31, ob = rr * 64 + cc * 2; return st * 1024 + (ob ^ (((ob >> 9) & 1) << 5)); }
__host__ __device__ __forceinline__ void stage_rc(int b, int& R, int& C) { const int st = b / 1024, sb = b % 1024, swz = sb ^ (((sb >> 9) & 1) << 5); R = (st >> 1) * 16 + swz / 64; C = (st & 1) * 32 + (swz % 64) / 2; }
__host__ __device__ __forceinline__ int perm32(int rho) { const int n = rho >> 4, i = rho & 15; return 8 * (i >> 2) + 4 * n + (i & 3); }

struct Unit { int pm, pn; };
struct Gemm { const bf16_t* A; const bf16_t* Bt; int M, N, K; };

struct StaticOrder {
    int nM, nN, nwg, G, c;
    __host__ __device__ void init(int M, int N, int G_, int c_) { nM = M / BM; nN = N / BM; nwg = nM * nN; G = G_; c = c_; }
    __host__ __device__ bool next(int i, Unit& u) const {
        const long L = (long)i * G + c; if (L >= nwg) return false;
        int wgid = (int)L; { const int q = nwg / NXCD, r = nwg % NXCD, xcd = wgid % NXCD, off = wgid / NXCD; wgid = (xcd < r ? xcd * (q + 1) : r * (q + 1) + (xcd - r) * q) + off; }
        const int nig = WGM * nN, gid = wgid / nig, fm = gid * WGM, gsz = (nM - fm) < WGM ? (nM - fm) : WGM;
        u.pm = fm + ((wgid % nig) % gsz); u.pn = (wgid % nig) / gsz; return true;
    }
    __device__ __forceinline__ void a_ready(const Unit&) const {}
    __device__ __forceinline__ void done(const Unit&) const {}
};

__device__ __forceinline__ unsigned cvt_pk_bf16(float lo, float hi) { unsigned r; asm volatile("v_cvt_pk_bf16_f32 %0, %1, %2" : "=v"(r) : "v"(lo), "v"(hi)); return r; }
typedef float f32x2 __attribute__((ext_vector_type(2)));
__device__ __forceinline__ int unit_cond(const Unit& u) { return u.pm < 32 ? 0 : 1 + ((u.pm - 32) >> 2); }
__device__ __forceinline__ float esig(float x) { return __builtin_amdgcn_rcpf(1.0f + __builtin_amdgcn_exp2f(-1.4426950408889634f * x)); }

struct EpiSwiglu {
    static constexpr bool PERM = true, AFTER_DRAIN = false;
    bf16_t* O; int ldc;
    __device__ __forceinline__ void operator()(const f32x4 (&acc)[2][2][4][2], const Unit& u, int wr, int wc, int fr, int fq) const {
        const int row0 = u.pm * BM + wr * 64 + fr, col0 = u.pn * HALF + wc * 32 + 8 * fq;
#pragma unroll
        for (int ai = 0; ai < 2; ++ai)
#pragma unroll
            for (int m = 0; m < 4; ++m) { bf16_t* rowp = O + (size_t)(row0 + ai * HALF + m * 16) * ldc + col0;
                f32x4 v0, v1;
#pragma unroll
                for (int e = 0; e < 4; ++e) { const float g0 = acc[ai][0][m][0][e], g1 = acc[ai][0][m][1][e]; v0[e] = g0 * esig(g0) * acc[ai][1][m][0][e]; v1[e] = g1 * esig(g1) * acc[ai][1][m][1][e]; }
                u32x4 w; w.x = cvt_pk_bf16(v0[0], v0[1]); w.y = cvt_pk_bf16(v0[2], v0[3]); w.z = cvt_pk_bf16(v1[0], v1[1]); w.w = cvt_pk_bf16(v1[2], v1[3]);
                *(u32x4*)rowp = w; }
    }
};
struct EpiPre {
    static constexpr bool PERM = false, AFTER_DRAIN = false;
    const float* X; float* P; const float* gate; float coef;
    __device__ __forceinline__ void operator()(const f32x4 (&acc)[2][2][4][2], const Unit& u, int wr, int wc, int fr, int fq) const {
        const int row0 = u.pm * BM + wr * 64 + fr, col0 = u.pn * BM + wc * 32 + 4 * fq;
        const float* g = gate + (size_t)unit_cond(u) * 9216;
        f32x4 gv[2][2];
#pragma unroll
        for (int bj = 0; bj < 2; ++bj)
#pragma unroll
            for (int n = 0; n < 2; ++n) gv[bj][n] = *(const f32x4*)(g + col0 + bj * HALF + n * 16) * coef;
#pragma unroll
        for (int ai = 0; ai < 2; ++ai)
#pragma unroll
            for (int m = 0; m < 4; ++m) { const size_t off = (size_t)(row0 + ai * HALF + m * 16) * 1024 + col0;
#pragma unroll
                for (int bj = 0; bj < 2; ++bj)
#pragma unroll
                    for (int n = 0; n < 2; ++n) { const f32x4 x = *(const f32x4*)(X + off + bj * HALF + n * 16);
                        *(f32x4*)(P + off + bj * HALF + n * 16) = x * 1.4142135623730951f + gv[bj][n] * acc[ai][bj][m][n]; } }
    }
};
template <int ACTSEL> struct EpiZ {
    static constexpr bool PERM = true, AFTER_DRAIN = false;
    bf16_t* O; int ldc; float* ZS; int nmain;
    __device__ __forceinline__ void operator()(const f32x4 (&acc)[2][2][4][2], const Unit& u, int wr, int wc, int fr, int fq) const {
        const int row0 = u.pm * BM + wr * 64 + fr, col0 = u.pn * BM + wc * 32 + 8 * fq;
        if (ACTSEL == 0 && u.pn >= nmain) {
            if (wc < 2) {
#pragma unroll
                for (int ai = 0; ai < 2; ++ai)
#pragma unroll
                    for (int m = 0; m < 4; ++m) { float* rowp = ZS + (size_t)(row0 + ai * HALF + m * 16) * 64 + wc * 32 + 8 * fq;
                        *(f32x4*)rowp = acc[ai][0][m][0]; *(f32x4*)(rowp + 4) = acc[ai][0][m][1]; }
            }
            return;
        }
#pragma unroll
        for (int ai = 0; ai < 2; ++ai)
#pragma unroll
            for (int m = 0; m < 4; ++m) { bf16_t* rowp = O + (size_t)(row0 + ai * HALF + m * 16) * ldc + col0;
#pragma unroll
                for (int bj = 0; bj < 2; ++bj) { f32x4 v0 = acc[ai][bj][m][0], v1 = acc[ai][bj][m][1];
                    if (ACTSEL == 1) {
                        if (u.pn < 4) {
#pragma unroll
                            for (int e = 0; e < 4; ++e) { v0[e] = v0[e] * esig(v0[e]); v1[e] = v1[e] * esig(v1[e]); }
                        } else {
#pragma unroll
                            for (int e = 0; e < 4; ++e) { v0[e] = esig(v0[e]); v1[e] = esig(v1[e]); }
                        }
                    }
                    u32x4 w; w.x = cvt_pk_bf16(v0[0], v0[1]); w.y = cvt_pk_bf16(v0[2], v0[3]); w.z = cvt_pk_bf16(v1[0], v1[1]); w.w = cvt_pk_bf16(v1[2], v1[3]);
                    *(u32x4*)(rowp + bj * HALF) = w; } }
    }
};
template <bool ADD> struct EpiBranch {
    static constexpr bool PERM = true, AFTER_DRAIN = false;
    const bf16_t* G; int ldg; const bf16_t* T; bf16_t* O;
    __device__ __forceinline__ void operator()(const f32x4 (&acc)[2][2][4][2], const Unit& u, int wr, int wc, int fr, int fq) const {
        const int row0 = u.pm * BM + wr * 64 + fr, col0 = u.pn * BM + wc * 32 + 8 * fq;
#pragma unroll
        for (int ai = 0; ai < 2; ++ai)
#pragma unroll
            for (int m = 0; m < 4; ++m) { const size_t r = (size_t)(row0 + ai * HALF + m * 16);
#pragma unroll
                for (int bj = 0; bj < 2; ++bj) {
                    const u32x4 gw = *(const u32x4*)(G + r * ldg + col0 + bj * HALF);
                    f32x4 v0 = acc[ai][bj][m][0], v1 = acc[ai][bj][m][1];
                    v0[0] *= __builtin_bit_cast(float, gw.x << 16); v0[1] *= __builtin_bit_cast(float, gw.x & 0xffff0000u);
                    v0[2] *= __builtin_bit_cast(float, gw.y << 16); v0[3] *= __builtin_bit_cast(float, gw.y & 0xffff0000u);
                    v1[0] *= __builtin_bit_cast(float, gw.z << 16); v1[1] *= __builtin_bit_cast(float, gw.z & 0xffff0000u);
                    v1[2] *= __builtin_bit_cast(float, gw.w << 16); v1[3] *= __builtin_bit_cast(float, gw.w & 0xffff0000u);
                    if (ADD) { const u32x4 tw = *(const u32x4*)(T + r * 1024 + col0 + bj * HALF);
                        v0[0] += __builtin_bit_cast(float, tw.x << 16); v0[1] += __builtin_bit_cast(float, tw.x & 0xffff0000u);
                        v0[2] += __builtin_bit_cast(float, tw.y << 16); v0[3] += __builtin_bit_cast(float, tw.y & 0xffff0000u);
                        v1[0] += __builtin_bit_cast(float, tw.z << 16); v1[1] += __builtin_bit_cast(float, tw.z & 0xffff0000u);
                        v1[2] += __builtin_bit_cast(float, tw.w << 16); v1[3] += __builtin_bit_cast(float, tw.w & 0xffff0000u); }
                    u32x4 w; w.x = cvt_pk_bf16(v0[0], v0[1]); w.y = cvt_pk_bf16(v0[2], v0[3]); w.z = cvt_pk_bf16(v1[0], v1[1]); w.w = cvt_pk_bf16(v1[2], v1[3]);
                    *(u32x4*)(O + r * 1024 + col0 + bj * HALF) = w; } }
    }
};

template <class Epi, class Sched, bool ALIGN_EPI = false, bool SP2 = false>
__device__ __forceinline__ void gemm_phase(PG8_LAS unsigned char* lds, const Gemm g, const Sched& S, const Epi& E) {
    int tid_ = threadIdx.x; asm volatile("" : "+v"(tid_)); const int tid = tid_, wid = __builtin_amdgcn_readfirstlane(tid >> 6), lane = tid & 63, wr = wid >> 2, wc = wid & 3, fr = lane & 15, fq = lane >> 4;
    const int K = g.K, nt = K / BK;
    unsigned voffA[2], voffB[2];
#pragma unroll
    for (int i = 0; i < 2; ++i) { int R, C; stage_rc(tid * 16 + i * 8192, R, C); const int Rb = Epi::PERM ? ((R & ~31) + perm32(R & 31)) : R;
        voffA[i] = (unsigned)(R * K + C) * 2u; voffB[i] = (unsigned)(Rb * K + C) * 2u; }
    const size_t kstep = (size_t)(BK * 2);
    const size_t hstep = (size_t)HALF * K * 2;
    const size_t tstep = 2 * hstep;
    const unsigned ldsw = (unsigned)wid * 1024u;
    const int aoff = lds_byte(wr * 64 + fr, fq * 8), boff = lds_byte(wc * 32 + fr, fq * 8);
#define PG8_SA(b, h) (((b) * 2 + (h)) * HTB)
#define PG8_SB(b, h) ((4 + (b) * 2 + (h)) * HTB)
#define PG8_STAGE(bufoff, gbase, voff) do { _Pragma("unroll") for (int _i = 0; _i < 2; ++_i) \
        __builtin_amdgcn_global_load_lds((const unsigned*)((const char*)(gbase) + (voff)[_i]), (PG8_LAS unsigned*)(lds + (bufoff) + ldsw + _i * 8192), 16, 0, 0); } while (0)
#define PG8_LDA(dst, b, h) do { _Pragma("unroll") for (int m = 0; m < 4; ++m) _Pragma("unroll") for (int k = 0; k < 2; ++k) dst[m][k] = *(const PG8_LAS bf16x8*)(lds + PG8_SA(b, h) + aoff + m * 2048 + k * 1024); } while (0)
#define PG8_LDB(dst, b, h) do { _Pragma("unroll") for (int n = 0; n < 2; ++n) _Pragma("unroll") for (int k = 0; k < 2; ++k) dst[n][k] = *(const PG8_LAS bf16x8*)(lds + PG8_SB(b, h) + boff + n * 2048 + k * 1024); } while (0)
#define PG8_MMA(ai, bj, At, Bt) do { __builtin_amdgcn_s_setprio(1); _Pragma("unroll") for (int m = 0; m < 4; ++m) _Pragma("unroll") for (int n = 0; n < 2; ++n) _Pragma("unroll") for (int k = 0; k < 2; ++k) \
        acc[ai][bj][m][n] = __builtin_amdgcn_mfma_f32_16x16x32_bf16(Bt[n][k], At[m][k], acc[ai][bj][m][n], 0, 0, 0); __builtin_amdgcn_s_setprio(0); } while (0)
#define PG8_WAIT_V(n) asm volatile("s_waitcnt vmcnt(" #n ")" ::: "memory")
#define PG8_WAIT_L(n) asm volatile("s_waitcnt lgkmcnt(" #n ")" ::: "memory")
#define PG8_BAR __builtin_amdgcn_s_barrier()
#define PG8_SCHED __builtin_amdgcn_sched_barrier(0)
    Unit cur, nxt; int ui = 0;
    if (!S.next(0, cur)) return;
    f32x4 acc[2][2][4][2];
#pragma unroll
    for (int a = 0; a < 2; ++a)
#pragma unroll
        for (int b = 0; b < 2; ++b)
#pragma unroll
            for (int m = 0; m < 4; ++m)
#pragma unroll
                for (int n = 0; n < 2; ++n) acc[a][b][m][n] = (f32x4){0.f, 0.f, 0.f, 0.f};
    bf16x8 At[4][2], B0[2][2], B1[2][2];
    const char* cA = (const char*)g.A + (size_t)cur.pm * tstep; const char* cB = (const char*)g.Bt + (size_t)cur.pn * tstep;
    S.a_ready(cur);
    if constexpr (SP2) {
        PG8_STAGE(PG8_SB(0, 0), cB, voffB); PG8_STAGE(PG8_SB(0, 1), cB + hstep, voffB); PG8_STAGE(PG8_SA(0, 0), cA, voffA); PG8_STAGE(PG8_SA(0, 1), cA + hstep, voffA);
        if (wr == 1) PG8_BAR;
        PG8_WAIT_V(2); PG8_BAR;
        PG8_STAGE(PG8_SB(1, 0), cB + kstep, voffB); PG8_STAGE(PG8_SA(1, 0), cA + kstep, voffA); PG8_STAGE(PG8_SB(1, 1), cB + hstep + kstep, voffB);
        PG8_WAIT_V(6); PG8_BAR;
    } else {
        PG8_STAGE(PG8_SB(0, 0), cB, voffB); PG8_STAGE(PG8_SA(0, 0), cA, voffA); PG8_STAGE(PG8_SB(0, 1), cB + hstep, voffB); PG8_STAGE(PG8_SA(0, 1), cA + hstep, voffA);
        if (wr == 1) PG8_BAR;
        PG8_WAIT_V(4); PG8_BAR;
        PG8_STAGE(PG8_SB(1, 0), cB + kstep, voffB); PG8_STAGE(PG8_SA(1, 0), cA + kstep, voffA); PG8_STAGE(PG8_SB(1, 1), cB + hstep + kstep, voffB);
        PG8_WAIT_V(6); PG8_BAR;
    }
    for (;;) {
        const bool has_next = S.next(ui + 1, nxt);
        const char* nA = has_next ? (const char*)g.A + (size_t)nxt.pm * tstep : cA; const char* nB = has_next ? (const char*)g.Bt + (size_t)nxt.pn * tstep : cB;
        for (int t = 0; t < nt; t += 2) {
            const bool last = (t == nt - 2);
            const char* a1 = cA + (size_t)(t + 1) * kstep;
            const char* a2 = last ? nA : cA + (size_t)(t + 2) * kstep; const char* b2 = last ? nB : cB + (size_t)(t + 2) * kstep;
            const char* a3 = a2 + kstep; const char* b3 = b2 + kstep;
            if (last && has_next) S.a_ready(nxt);
            if constexpr (SP2) {
            PG8_LDB(B0, 0, 0); PG8_LDB(B1, 0, 1); PG8_SCHED; PG8_LDA(At, 0, 0); PG8_STAGE(PG8_SA(1, 1), a1 + hstep, voffA);
            PG8_WAIT_V(8); PG8_WAIT_L(0); PG8_BAR; PG8_MMA(0, 0, At, B0); PG8_MMA(0, 1, At, B1); PG8_BAR; PG8_SCHED;
            PG8_LDA(At, 0, 1); PG8_STAGE(PG8_SB(0, 0), b2, voffB); PG8_STAGE(PG8_SB(0, 1), b2 + hstep, voffB); PG8_STAGE(PG8_SA(0, 0), a2, voffA);
            PG8_WAIT_V(8); PG8_WAIT_L(0); PG8_BAR; PG8_MMA(1, 0, At, B0); PG8_MMA(1, 1, At, B1); PG8_BAR; PG8_SCHED;
            PG8_LDB(B0, 1, 0); PG8_LDB(B1, 1, 1); PG8_SCHED; PG8_LDA(At, 1, 0); PG8_STAGE(PG8_SA(0, 1), a2 + hstep, voffA);
            PG8_WAIT_V(8); PG8_WAIT_L(0); PG8_BAR; PG8_MMA(0, 0, At, B0); PG8_MMA(0, 1, At, B1); PG8_BAR; PG8_SCHED;
            PG8_LDA(At, 1, 1); PG8_STAGE(PG8_SB(1, 0), b3, voffB); PG8_STAGE(PG8_SB(1, 1), b3 + hstep, voffB); PG8_STAGE(PG8_SA(1, 0), a3, voffA);
            PG8_WAIT_V(8); PG8_WAIT_L(0); PG8_BAR; PG8_MMA(1, 0, At, B0); PG8_MMA(1, 1, At, B1); PG8_BAR; PG8_SCHED;
            } else {
            PG8_LDB(B0, 0, 0); PG8_SCHED; PG8_LDA(At, 0, 0); PG8_STAGE(PG8_SA(1, 1), a1 + hstep, voffA);
            PG8_WAIT_L(8); PG8_BAR; PG8_WAIT_L(0); PG8_MMA(0, 0, At, B0); PG8_BAR; PG8_SCHED;
            PG8_LDB(B1, 0, 1); PG8_STAGE(PG8_SB(0, 0), b2, voffB);
            PG8_BAR; PG8_WAIT_L(0); PG8_MMA(0, 1, At, B1); PG8_BAR;
            PG8_LDA(At, 0, 1); PG8_STAGE(PG8_SA(0, 0), a2, voffA);
            PG8_BAR; PG8_WAIT_L(0); PG8_MMA(1, 0, At, B0); PG8_BAR; PG8_SCHED;
            PG8_STAGE(PG8_SB(0, 1), b2 + hstep, voffB);
            PG8_WAIT_V(6); PG8_BAR; PG8_MMA(1, 1, At, B1); PG8_BAR;
            PG8_LDB(B0, 1, 0); PG8_SCHED; PG8_LDA(At, 1, 0); PG8_STAGE(PG8_SA(0, 1), a2 + hstep, voffA);
            PG8_WAIT_L(8); PG8_BAR; PG8_WAIT_L(0); PG8_MMA(0, 0, At, B0); PG8_BAR; PG8_SCHED;
            PG8_LDB(B1, 1, 1); PG8_STAGE(PG8_SB(1, 0), b3, voffB);
            PG8_BAR; PG8_WAIT_L(0); PG8_MMA(0, 1, At, B1); PG8_BAR;
            PG8_LDA(At, 1, 1); PG8_STAGE(PG8_SA(1, 0), a3, voffA);
            PG8_BAR; PG8_WAIT_L(0); PG8_MMA(1, 0, At, B0); PG8_BAR; PG8_SCHED;
            PG8_STAGE(PG8_SB(1, 1), b3 + hstep, voffB);
            PG8_WAIT_V(6); PG8_BAR; PG8_MMA(1, 1, At, B1); PG8_BAR;
            }
        }
        if constexpr (ALIGN_EPI) { if (wr == 0) PG8_BAR; }
        if constexpr (!Epi::AFTER_DRAIN) { E(acc, cur, wr, wc, fr, fq); S.done(cur); }
        if (!has_next) break;
#pragma unroll
        for (int a = 0; a < 2; ++a)
#pragma unroll
            for (int b = 0; b < 2; ++b)
#pragma unroll
                for (int m = 0; m < 4; ++m)
#pragma unroll
                    for (int n = 0; n < 2; ++n) acc[a][b][m][n] = (f32x4){0.f, 0.f, 0.f, 0.f};
        cur = nxt; cA = nA; cB = nB; ++ui;
        if constexpr (ALIGN_EPI) { if (wr == 1) PG8_BAR; }
    }
    PG8_WAIT_V(0);
    if constexpr (!ALIGN_EPI) { if (wr == 0) PG8_BAR; }
    PG8_BAR;
    if constexpr (Epi::AFTER_DRAIN) { E.fused(acc, cur, wr, wc, fr, fq, lds, wid, lane); S.done(cur); }
#undef PG8_SA
#undef PG8_SB
#undef PG8_STAGE
#undef PG8_LDA
#undef PG8_LDB
#undef PG8_MMA
#undef PG8_WAIT_V
#undef PG8_WAIT_L
#undef PG8_BAR
#undef PG8_SCHED
}
}

#ifndef SSEL
#define SSEL 3
#endif
struct Args { const float* in[29]; float* out; unsigned char* ws; int ph_lo, ph_hi; };
constexpr int PTR_OFF = 131072 + 1024;
struct Ctx { LAS unsigned char* lds; float* out; unsigned char* ws;
    __device__ __forceinline__ const float* in(int i) const { const LAS unsigned* p = (const LAS unsigned*)(lds + PTR_OFF) + 2 * i;
        const unsigned lo = __builtin_amdgcn_readfirstlane(p[0]), hi = __builtin_amdgcn_readfirstlane(p[1]); return (const float*)(((unsigned long long)hi << 32) | lo); } };
constexpr int NW = 8, NT = NW * 64;
constexpr int LDS_BYTES = 147456;

__device__ __forceinline__ void transpose_item(const float* src, int srcN, int k0, int n0, int ncols, bf16* dst, int dstK, int dstrow, LAS float* scr, int lane) {
#pragma unroll 8
    for (int i = 0; i < 32; ++i) { const int kk = 2 * i + (lane >> 5), c = lane & 31; scr[kk * 33 + c] = (c < ncols) ? src[(size_t)(k0 + kk) * srcN + n0 + c] : 0.f; }
    asm volatile("s_waitcnt lgkmcnt(0)" ::: "memory");
    const int c = lane & 7;
#pragma unroll
    for (int j = 0; j < 4; ++j) { const int n = (lane >> 3) + 8 * j; const LAS float* s = scr + (8 * c) * 33 + n;
        u32x4 o; o.x = pk2(s[0 * 33], s[1 * 33]); o.y = pk2(s[2 * 33], s[3 * 33]); o.z = pk2(s[4 * 33], s[5 * 33]); o.w = pk2(s[6 * 33], s[7 * 33]);
        if (n < ncols) *(u32x4*)(dst + (size_t)(dstrow + n) * dstK + k0 + 8 * c) = o; }
    asm volatile("s_waitcnt lgkmcnt(0)" ::: "memory");
}
__device__ __forceinline__ void phase_wconv(const Ctx& a, int l, LAS unsigned char* lds) {
    const int tid = otid(), lane = tid & 63, wave = tid >> 6;
    LAS float* scr = (LAS float*)(lds + wave * 16384);
    unsigned char* wt = a.ws + WS_WT;
    const int gw = blockIdx.x * NW + wave, NGW = gridDim.x * NW;
    constexpr int I_1A = 16 * 176, I_1D = 44 * 32, I_INA = 16 * 162, I_INB = 16 * 128, I_SQ = 16 * 32;
    constexpr int NITEMS = 2 * I_1A + 2 * I_1D + I_INA + I_INB + 3 * I_SQ;
    for (int it = gw; it < NITEMS; it += NGW) {
        int r = it;
        if (r < 2 * I_1A) {
            const int f = r / I_1A; r -= f * I_1A; const int kb = r / 176, nb = r % 176, up = nb >= 88, c0 = 32 * (nb - 88 * up);
            const float* src = a.in(f == 0 ? (up ? 11 : 10) : (up ? 25 : 24)) + (size_t)l * D * FF;
            transpose_item(src, FF, 64 * kb, c0, 32, (bf16*)(wt + (f == 0 ? WT_W1A : WT_W2A)), D, 256 * (c0 >> 7) + (c0 & 127) + 128 * up, scr, lane); continue; }
        r -= 2 * I_1A;
        if (r < 2 * I_1D) {
            const int f = r / I_1D; r -= f * I_1D; const int kb = r / 32, nb = r % 32;
            transpose_item(a.in(f == 0 ? 12 : 26) + (size_t)l * FF * D, D, 64 * kb, 32 * nb, 32, (bf16*)(wt + (f == 0 ? WT_W1D : WT_W2D)), FF, 32 * nb, scr, lane); continue; }
        r -= 2 * I_1D;
        if (r < I_INA) { const int kb = r / 162, nb = r % 162; const float* src = a.in(13) + (size_t)l * D * DIN;
            int dr = 32 * nb, sc, nc = 32;
            if (nb < 160) sc = dr < 2048 ? dr : dr + 1056; else if (nb == 160) sc = 3072; else { sc = 7200; nc = 16; }
            transpose_item(src, DIN, 64 * kb, sc, nc, (bf16*)(wt + WT_WINA), D, dr, scr, lane); continue; }
        r -= I_INA;
        if (r < I_INB) { const int kb = r / 128, nb = r % 128; const float* src = a.in(13) + (size_t)l * D * DIN;
            const int dr = 32 * nb, sc = dr < 1024 ? dr + 2048 : (dr < 2048 ? dr + 5152 : dr + 5168);
            transpose_item(src, DIN, 64 * kb, sc, 32, (bf16*)(wt + WT_WINB), D, dr, scr, lane); continue; }
        r -= I_INB;
        { const int f = r / I_SQ; r -= f * I_SQ; const int kb = r / 32, nb = r % 32;
          transpose_item(a.in(21 + f) + (size_t)l * D * D, D, 64 * kb, 32 * nb, 32, (bf16*)(wt + (f == 0 ? WT_WBG : f == 1 ? WT_WBM : WT_WO)), D, 32 * nb, scr, lane); }
    }
}
__device__ __forceinline__ void phase_ada(const Ctx& a, LAS unsigned char* lds) {
    LAS float* sil = (LAS float*)lds;
    LAS float* red = (LAS float*)(lds + 36864);
    const int tid = otid();
    for (int i = tid; i < NCOND * D; i += NT) { const int ci = i >> 10, k = i & 1023; const float v = ci == 0 ? a.in(7)[k] : a.in(2)[(ci - 1) * D + k]; sil[i] = v / (1.f + expf(-v)); }
    __syncthreads();
    float* ada = (float*)(a.ws + WS_ADA);
    const int c = tid & 63, s = tid >> 6;
    for (int it = blockIdx.x; it < 2 * 144; it += gridDim.x) {
        const int l = it / 144, g = it % 144; const float* W = a.in(8) + (size_t)l * D * NADA + 64 * g + c;
        float acc[NCOND];
#pragma unroll
        for (int ci = 0; ci < NCOND; ++ci) acc[ci] = 0.f;
#pragma unroll 4
        for (int k = s; k < D; k += 8) { const float w = W[(size_t)k * NADA];
#pragma unroll
            for (int ci = 0; ci < NCOND; ++ci) acc[ci] += sil[ci * D + k] * w; }
#pragma unroll
        for (int ci = 0; ci < NCOND; ++ci) red[(s * NCOND + ci) * 64 + c] = acc[ci];
        __syncthreads();
        for (int i = tid; i < NCOND * 64; i += NT) { const int ci = i >> 6, cc = i & 63; float sum = a.in(9)[(size_t)l * NADA + 64 * g + cc];
#pragma unroll
            for (int ss = 0; ss < 8; ++ss) sum += red[(ss * NCOND + ci) * 64 + cc];
            ada[((size_t)l * NCOND + ci) * NADA + 64 * g + cc] = sum; }
        __syncthreads();
    }
}
__device__ __forceinline__ void store_mod_row(bf16* hrow, const f32x4 (&v)[4], const float* sh, const float* sc, int lane) {
#pragma unroll
    for (int j = 0; j < 4; ++j) { const f32x4 s = *(const f32x4*)(sc + 256 * j + 4 * lane), t = *(const f32x4*)(sh + 256 * j + 4 * lane);
        const f32x4 h = v[j] * (s + 1.0f) + t; u32x2 w; w.x = pk2(h[0], h[1]); w.y = pk2(h[2], h[3]); *(u32x2*)(hrow + 256 * j + 4 * lane) = w; }
}
__device__ __forceinline__ void phase_xinit(const Ctx& a) {
    const int tid = otid(), lane = tid & 63, gw = blockIdx.x * NW + (tid >> 6), NGW = gridDim.x * NW;
    const float* ada = (const float*)(a.ws + WS_ADA);
    bf16* H = (bf16*)(a.ws + WS_H);
    for (int r = gw; r < M; r += NGW) {
        f32x4 v[4];
        if (r < NPROMPT_ROWS) {
#pragma unroll
            for (int j = 0; j < 4; ++j) v[j] = *(const f32x4*)(a.in(0) + (size_t)r * D + 256 * j + 4 * lane);
        } else {
            const int rs = r - NPROMPT_ROWS, t = rs & 1023; const float gr = (float)(t >> 6), gc = (float)(t & 63);
#pragma unroll
            for (int j = 0; j < 4; ++j) { v[j] = *(const f32x4*)(a.in(1) + (size_t)rs * D + 256 * j + 4 * lane);
#pragma unroll
                for (int e = 0; e < 4; ++e) { const float om = 1.0f / powf(10000.0f, (float)(4 * lane + e) * (1.0f / 256.0f)); const float ang = (j < 2 ? gr : gc) * om;
                    v[j][e] += (j & 1) ? cosf(ang) : sinf(ang); } }
        }
#pragma unroll
        for (int j = 0; j < 4; ++j) *(f32x4*)(a.out + (size_t)r * D + 256 * j + 4 * lane) = v[j];
        const float* ad = ada + (size_t)cond_of_row(r) * NADA;
        store_mod_row(H + (size_t)r * D, v, ad, ad + 1024, lane);
    }
}
__device__ __forceinline__ void phase_ln(const Ctx& a, const float* lng, const float* lnb, const float* mod) {
    const int tid = otid(), lane = tid & 63, gw = blockIdx.x * NW + (tid >> 6), NGW = gridDim.x * NW;
    const float* P = (const float*)(a.ws + WS_PRE);
    bf16* H = (bf16*)(a.ws + WS_H);
    for (int r = gw; r < M; r += NGW) {
        f32x4 v[4]; float s = 0.f;
#pragma unroll
        for (int j = 0; j < 4; ++j) { v[j] = *(const f32x4*)(P + (size_t)r * D + 256 * j + 4 * lane); s += (v[j][0] + v[j][1]) + (v[j][2] + v[j][3]); }
        const float mean = wave_sum(s) * (1.f / D); float s2 = 0.f;
#pragma unroll
        for (int j = 0; j < 4; ++j) { v[j] = v[j] - mean; s2 += (v[j][0] * v[j][0] + v[j][1] * v[j][1]) + (v[j][2] * v[j][2] + v[j][3] * v[j][3]); }
        const float rstd = 1.0f / sqrtf(wave_sum(s2) * (1.f / D) + LN_EPS);
#pragma unroll
        for (int j = 0; j < 4; ++j) { const f32x4 g = *(const f32x4*)(lng + 256 * j + 4 * lane), b = *(const f32x4*)(lnb + 256 * j + 4 * lane);
            v[j] = v[j] * rstd * g + b; *(f32x4*)(a.out + (size_t)r * D + 256 * j + 4 * lane) = v[j]; }
        if (mod) { const float* ad = mod + (size_t)cond_of_row(r) * NADA; store_mod_row(H + (size_t)r * D, v, ad, ad + 1024, lane); }
    }
}
__device__ __forceinline__ void phase_combine(const Ctx& a, int l) {
    const int tid = otid(), lane = tid & 63, gw = blockIdx.x * NW + (tid >> 6), NGW = gridDim.x * NW;
    const bf16* ZB = (const bf16*)(a.ws + WS_ZB);
    for (int r = gw; r < M; r += NGW) {
#pragma unroll
        for (int br = 0; br < 2; ++br) {
            bf16* OF = (bf16*)(a.ws + WS_O + (size_t)(2 * br) * O_STRIDE) + (size_t)r * D; const bf16* OB = (const bf16*)(a.ws + WS_O + (size_t)(2 * br + 1) * O_STRIDE) + (size_t)r * D;
            const float* gam = a.in(19 + br) + l * 256 + 4 * lane; const f32x4 gv = *(const f32x4*)gam;
            const bf16* gate = ZB + (size_t)r * ZB_W + br * 1024;
#pragma unroll
            for (int h = 0; h < 4; ++h) {
                const u32x2 wf = *(const u32x2*)(OF + 256 * h + 4 * lane), wb = *(const u32x2*)(OB + 256 * h + 4 * lane), wg = *(const u32x2*)(gate + 256 * h + 4 * lane);
                f32x4 s; s[0] = bf_lo(wf.x) + bf_lo(wb.x); s[1] = bf_hi(wf.x) + bf_hi(wb.x); s[2] = bf_lo(wf.y) + bf_lo(wb.y); s[3] = bf_hi(wf.y) + bf_hi(wb.y);
                const float ss = wave_sum((s[0] * s[0] + s[1] * s[1]) + (s[2] * s[2] + s[3] * s[3]));
                const float rs = 1.0f / sqrtf(ss * (1.f / 256.f) + NORM_EPS);
                f32x4 o = s * rs * gv; o[0] *= bf_lo(wg.x); o[1] *= bf_hi(wg.x); o[2] *= bf_lo(wg.y); o[3] *= bf_hi(wg.y);
                u32x2 w; w.x = pk2(o[0], o[1]); w.y = pk2(o[2], o[3]); *(u32x2*)(OF + 256 * h + 4 * lane) = w;
            }
        }
    }
}
__device__ __forceinline__ void scan_gla_naive(const Ctx& a, int l, int sample, int b, int h, int dir, LAS unsigned char* lds) {
    const int tid = otid(), dv = tid & 255, half = tid >> 8;
    const int T = sample ? 1024 : 256, row0 = sample ? NPROMPT_ROWS + b * 1024 : b * 256;
    const bf16* ZA = (const bf16*)(a.ws + WS_ZA); const float* ZS = (const float*)(a.ws + WS_ZS);
    bf16* OG = (bf16*)(a.ws + WS_O + (size_t)dir * O_STRIDE);
    LAS float* qs = (LAS float*)lds; LAS float* ks = qs + 16 * 128; LAS float* es = ks + 16 * 128; LAS float* op = es + 16 * 128; LAS float* vs = op + 32 * 256;
    float S[64];
    const size_t sidx = ((((size_t)b * 2 + l) * 2 + dir) * 4 + h) * (128 * 256);
    if (sample) {
#pragma unroll
        for (int i = 0; i < 64; ++i) { S[i] = a.in(3)[sidx + (size_t)(half * 64 + i) * 256 + dv]; if ((i & 7) == 7) asm volatile("" ::: "memory"); }
    } else {
#pragma unroll
        for (int i = 0; i < 64; ++i) S[i] = 0.f;
    }
    const int d = tid & 127, jq = tid >> 7;
    float wd[16];
#pragma unroll
    for (int r = 0; r < 16; ++r) wd[r] = a.in(14)[(((size_t)l * 2 + dir) * 16 + r) * 512 + h * 128 + d];
    const float bd = a.in(15)[((size_t)l * 2 + dir) * 512 + h * 128 + d];
#pragma unroll 1
    for (int t0 = 0; t0 < T; t0 += 16) {
        __syncthreads();
#pragma unroll 1
        for (int i = 0; i < 4; ++i) { const int j = jq + 4 * i, tok = dir ? T - 1 - (t0 + j) : t0 + j; const size_t r = (size_t)(row0 + tok);
            float x = bd;
#pragma unroll
            for (int q4 = 0; q4 < 4; ++q4) { const f32x4 av = *(const f32x4*)(ZS + r * 64 + dir * 16 + 4 * q4); x += av[0] * wd[4 * q4] + av[1] * wd[4 * q4 + 1] + av[2] * wd[4 * q4 + 2] + av[3] * wd[4 * q4 + 3]; }
            es[j * 128 + d] = expf(log_sigmoid(x) * (1.f / 16.f));
            qs[j * 128 + d] = bf2f(ZA[r * ZA_W + h * 128 + d]) * 0.08838834764831845f;
            ks[j * 128 + d] = bf2f(ZA[r * ZA_W + 512 + h * 128 + d]); }
#pragma unroll 2
        for (int jj = 0; jj < 8; ++jj) { const int j = half * 8 + jj; const int tok = dir ? T - 1 - (t0 + j) : t0 + j; vs[j * 256 + dv] = bf2f(ZA[(size_t)(row0 + tok) * ZA_W + 1024 + h * 256 + dv]); }
        __syncthreads();
#pragma unroll 1
        for (int j = 0; j < 16; ++j) { float acc = 0.f; const float vj = vs[j * 256 + dv];
#pragma unroll
            for (int i4 = 0; i4 < 16; ++i4) { const int dk = half * 64 + 4 * i4; const f32x4 e4 = *(const LAS f32x4*)(es + j * 128 + dk), k4 = *(const LAS f32x4*)(ks + j * 128 + dk), q4 = *(const LAS f32x4*)(qs + j * 128 + dk);
#pragma unroll
                for (int e = 0; e < 4; ++e) { S[4 * i4 + e] = e4[e] * S[4 * i4 + e] + k4[e] * vj; acc += q4[e] * S[4 * i4 + e]; }
                asm volatile("" ::: "memory"); }
            op[(half * 16 + j) * 256 + dv] = acc; }
        __syncthreads();
#pragma unroll 2
        for (int jj = 0; jj < 8; ++jj) { const int j = half * 8 + jj; const int tok = dir ? T - 1 - (t0 + j) : t0 + j; OG[(size_t)(row0 + tok) * D + h * 256 + dv] = (bf16)f2bf(op[j * 256 + dv] + op[(16 + j) * 256 + dv]); }
    }
    if (!sample) {
#pragma unroll
        for (int i = 0; i < 64; ++i) { a.out[OUT_GLA + sidx + (size_t)(half * 64 + i) * 256 + dv] = S[i]; if ((i & 7) == 7) asm volatile("" ::: "memory"); }
    }
}
__device__ __forceinline__ void scan_mlstm_naive(const Ctx& a, int l, int sample, int b, int h, int dir, LAS unsigned char* lds) {
    const int tid = otid(), dv = tid & 255, half = tid >> 8, lane = tid & 63, wave = tid >> 6;
    const int T = sample ? 1024 : 256, row0 = sample ? NPROMPT_ROWS + b * 1024 : b * 256;
    const bf16* ZA = (const bf16*)(a.ws + WS_ZA); const float* ZS = (const float*)(a.ws + WS_ZS);
    bf16* OM = (bf16*)(a.ws + WS_O + (size_t)(2 + dir) * O_STRIDE);
    LAS float* qs = (LAS float*)lds; LAS float* ks = qs + 16 * 256; LAS float* op = ks + 16 * 256; LAS float* qnp = op + 32 * 256; LAS float* gt = qnp + 16 * 256; LAS float* vs = gt + 128;
    float C[128];
    const size_t hidx = (((size_t)b * 2 + l) * 2 + dir) * 4 + h;
    float n = 0.f, m = 0.f;
    if (sample) {
#pragma unroll
        for (int i = 0; i < 128; ++i) { C[i] = a.in(4)[hidx * 65536 + (size_t)(half * 128 + i) * 256 + dv]; if ((i & 7) == 7) asm volatile("" ::: "memory"); }
        if (tid < 256) n = a.in(5)[hidx * 256 + tid];
        m = a.in(6)[hidx];
    } else {
#pragma unroll
        for (int i = 0; i < 128; ++i) C[i] = 0.f;
    }
    const int chan = (tid < 256) ? h * 256 + tid : 1024 + h * 256 + (tid - 256);
    const float w0 = a.in(16)[((size_t)l * 3 + 0) * 2048 + chan], w1 = a.in(16)[((size_t)l * 3 + 1) * 2048 + chan], w2 = a.in(16)[((size_t)l * 3 + 2) * 2048 + chan], bc = a.in(17)[(size_t)l * 2048 + chan];
    const float fb = a.in(18)[((size_t)l * 2 + dir) * 4 + h];
#pragma unroll 1
    for (int t0 = 0; t0 < T; t0 += 16) {
        __syncthreads();
#pragma unroll 2
        for (int j = 0; j < 16; ++j) { const int tok = dir ? T - 1 - (t0 + j) : t0 + j; const bf16* zp = ZA + (size_t)(row0 + tok) * ZA_W + 2048 + chan;
            const float zc = bf2f(zp[0]), zm = tok > 0 ? bf2f(zp[-ZA_W]) : 0.f, zn = tok < T - 1 ? bf2f(zp[ZA_W]) : 0.f;
            const float x = w0 * zm + w1 * zc + w2 * zn + bc; const float sv = x / (1.f + expf(-x));
            if (tid < 256) qs[j * 256 + tid] = sv * 0.0625f; else ks[j * 256 + tid - 256] = sv; }
        if (tid == 0) { float mm = m;
            for (int j = 0; j < 16; ++j) { const int tok = dir ? T - 1 - (t0 + j) : t0 + j; const float* zr = ZS + (size_t)(row0 + tok) * 64 + 32 + dir * 8 + h;
                const float ig = zr[0], lf = log_sigmoid(zr[4] + fb); const float mn = fmaxf(lf + mm, ig);
                gt[j] = expf(lf + mm - mn); gt[16 + j] = expf(ig - mn); gt[32 + j] = expf(-mn); mm = mn; }
            gt[64] = mm; }
#pragma unroll 2
        for (int jj = 0; jj < 8; ++jj) { const int j = half * 8 + jj; const int tok = dir ? T - 1 - (t0 + j) : t0 + j; vs[j * 256 + dv] = bf2f(ZA[(size_t)(row0 + tok) * ZA_W + 4096 + h * 256 + dv]); }
        __syncthreads();
        m = gt[64];
#pragma unroll 1
        for (int j = 0; j < 16; ++j) { const float f = gt[j], w = gt[16 + j]; const float kv = w * vs[j * 256 + dv]; float acc = 0.f;
#pragma unroll
            for (int i4 = 0; i4 < 32; ++i4) { const int dk = half * 128 + 4 * i4; const f32x4 k4 = *(const LAS f32x4*)(ks + j * 256 + dk), q4 = *(const LAS f32x4*)(qs + j * 256 + dk);
#pragma unroll
                for (int e = 0; e < 4; ++e) { C[4 * i4 + e] = f * C[4 * i4 + e] + k4[e] * kv; acc += q4[e] * C[4 * i4 + e]; }
                asm volatile("" ::: "memory"); }
            op[(half * 16 + j) * 256 + dv] = acc;
            if (tid < 256) { n = f * n + w * ks[j * 256 + tid]; qnp[j * 256 + tid] = qs[j * 256 + tid] * n; } }
        __syncthreads();
#pragma unroll
        for (int jj = 0; jj < 2; ++jj) { const int j = 2 * wave + jj; const f32x4 p = *(const LAS f32x4*)(qnp + j * 256 + 4 * lane); const float s = wave_sum((p[0] + p[1]) + (p[2] + p[3])); if (lane == 0) gt[48 + j] = s; }
        __syncthreads();
#pragma unroll 2
        for (int jj = 0; jj < 8; ++jj) { const int j = half * 8 + jj; const int tok = dir ? T - 1 - (t0 + j) : t0 + j; const float den = fmaxf(fabsf(gt[48 + j]), gt[32 + j]);
            OM[(size_t)(row0 + tok) * D + h * 256 + dv] = (bf16)f2bf((op[j * 256 + dv] + op[(16 + j) * 256 + dv]) / den); }
    }
    if (!sample) {
#pragma unroll
        for (int i = 0; i < 128; ++i) { a.out[OUT_MC + hidx * 65536 + (size_t)(half * 128 + i) * 256 + dv] = C[i]; if ((i & 7) == 7) asm volatile("" ::: "memory"); }
        if (tid < 256) a.out[OUT_MN + hidx * 256 + tid] = n;
        if (tid == 0) a.out[OUT_MM + hidx] = m;
    }
}
__device__ __forceinline__ void phase_scan_naive(const Ctx& a, int l, LAS unsigned char* lds) {
    for (int u = blockIdx.x; u < 640; u += gridDim.x) {
        int kind, sample, v;
        if (u < 64) { kind = 1; sample = 1; v = u; } else if (u < 128) { kind = 0; sample = 1; v = u - 64; } else if (u < 384) { kind = 1; sample = 0; v = u - 128; } else { kind = 0; sample = 0; v = u - 384; }
        const int dir = v & 1, h = (v >> 1) & 3, b = v >> 3;
        if (kind) { if (SSEL & 2) scan_mlstm_naive(a, l, sample, b, h, dir, lds); } else { if (SSEL & 1) scan_gla_naive(a, l, sample, b, h, dir, lds); }
        __syncthreads();
    }
}

template <class Epi> __device__ __forceinline__ void run_gemm(LAS unsigned char* lds, const bf16* A, const bf16* Bt, int N, int K, const Epi& E) {
    pg8::Gemm g{A, Bt, M, N, K}; pg8::StaticOrder S; S.init(M, N, (int)gridDim.x, (int)blockIdx.x);
    pg8::gemm_phase<Epi, pg8::StaticOrder, true, true>(lds, g, S, E);
}
#ifndef GSEL
#define GSEL 0x1ff
#endif
constexpr int PH_PER_LAYER = 15, N_PHASES = 2 + 2 * PH_PER_LAYER;

template <bool COOP, int MASK> __global__ void __launch_bounds__(NT, 2) mk_fwd(Args ka) {
    extern __shared__ __attribute__((aligned(16))) unsigned char lds_raw[];
    LAS unsigned char* lds = (LAS unsigned char*)lds_raw;
    const int lo = ka.ph_lo, hi = ka.ph_hi;
    {
        LAS unsigned long long* tab = (LAS unsigned long long*)(lds + PTR_OFF);
        if (threadIdx.x == 0) {
#pragma unroll
            for (int i = 0; i < 29; ++i) tab[i] = (unsigned long long)ka.in[i];
        }
        __syncthreads();
    }
#define MISC (MASK & 1)
#define SCAN (MASK & 2)
#define GEMM (MASK & 4)
#pragma unroll 1
    for (int ph = lo; ph < hi; ++ph) {
        unsigned char* ws = ka.ws; float* outp = ka.out;
        asm volatile("" : "+s"(ws), "+s"(outp));
        const Ctx a{lds, outp, ws};
        const float* ada = (const float*)(ws + WS_ADA);
        bf16* H = (bf16*)(ws + WS_H); bf16* ACT = (bf16*)(ws + WS_ACT); float* PRE = (float*)(ws + WS_PRE);
        bf16* ZA = (bf16*)(ws + WS_ZA); bf16* ZB = (bf16*)(ws + WS_ZB); float* ZS = (float*)(ws + WS_ZS);
        bf16* O0 = (bf16*)(ws + WS_O); bf16* O1 = (bf16*)(ws + WS_O + O_STRIDE); bf16* O2 = (bf16*)(ws + WS_O + 2 * O_STRIDE); bf16* O3 = (bf16*)(ws + WS_O + 3 * O_STRIDE);
        const unsigned char* wt = ws + WS_WT;
        int l = 0, q = ph;
        if (ph >= 2) { l = (ph - 2) / PH_PER_LAYER; q = 2 + (ph - 2) % PH_PER_LAYER; }
        const float* adl = ada + (size_t)l * NCOND * NADA;
        const float* lng = a.in(27) + (size_t)l * 3 * D; const float* lnb = a.in(28) + (size_t)l * 3 * D;
        switch (q) {
        case 0: if (MISC) { phase_ada(a, lds); __syncthreads(); phase_wconv(a, 0, lds); } break;
        case 1: if (MISC) { phase_xinit(a); } break;
        case 2: if (MISC) { if (l > 0) phase_wconv(a, l, lds); } break;
        case 3: if (GEMM && (GSEL >> 0 & 1)) { pg8::EpiSwiglu E{ACT, FF}; run_gemm(lds, H, (const bf16*)(wt + WT_W1A), W1A_N, D, E); } break;
        case 4: if (GEMM && (GSEL >> 1 & 1)) { pg8::EpiPre E{a.out, PRE, adl + 2 * D, 0.5f}; run_gemm(lds, ACT, (const bf16*)(wt + WT_W1D), D, FF, E); } break;
        case 5: if (MISC) { phase_ln(a, lng, lnb, adl + 3 * D); } break;
        case 6: if (GEMM && (GSEL >> 2 & 1)) { pg8::EpiZ<0> E{ZA, ZA_W, ZS, 20}; run_gemm(lds, H, (const bf16*)(wt + WT_WINA), WINA_N, D, E); } break;
        case 7: if (SCAN) { phase_scan_naive(a, l, lds); } break;
        case 8: if (GEMM && (GSEL >> 3 & 1)) { pg8::EpiZ<1> E{ZB, ZB_W, nullptr, 1 << 30}; run_gemm(lds, H, (const bf16*)(wt + WT_WINB), WINB_N, D, E); } break;
        case 9: if (MISC) { phase_combine(a, l); } break;
        case 10: if (GEMM && (GSEL >> 4 & 1)) { pg8::EpiBranch<false> E{ZB + 2048, ZB_W, nullptr, O1}; run_gemm(lds, O0, (const bf16*)(wt + WT_WBG), D, D, E); } break;
        case 11: if (GEMM && (GSEL >> 5 & 1)) { pg8::EpiBranch<true> E{ZB + 3072, ZB_W, O1, O3}; run_gemm(lds, O2, (const bf16*)(wt + WT_WBM), D, D, E); } break;
        case 12: if (GEMM && (GSEL >> 1 & 1)) { pg8::EpiPre E{a.out, PRE, adl + 5 * D, 1.0f}; run_gemm(lds, O3, (const bf16*)(wt + WT_WO), D, D, E); } break;
        case 13: if (MISC) { phase_ln(a, lng + D, lnb + D, adl + 6 * D); } break;
        case 14: if (GEMM && (GSEL >> 0 & 1)) { pg8::EpiSwiglu E{ACT, FF}; run_gemm(lds, H, (const bf16*)(wt + WT_W2A), W1A_N, D, E); } break;
        case 15: if (GEMM && (GSEL >> 1 & 1)) { pg8::EpiPre E{a.out, PRE, adl + 8 * D, 0.5f}; run_gemm(lds, ACT, (const bf16*)(wt + WT_W2D), D, FF, E); } break;
        case 16: if (MISC) { phase_ln(a, lng + 2 * D, lnb + 2 * D, l == 0 ? ada + (size_t)NCOND * NADA : nullptr); } break;
        default: break;
        }
        if (COOP && ph + 1 < hi) { __syncthreads(); cg::this_grid().sync(); }
    }
#undef MISC
#undef SCAN
#undef GEMM
}

#ifndef MK_ONE_LAUNCH
#define MK_ONE_LAUNCH 1
#endif
extern "C" void kernel_launch(void* const* d_in, const int* in_sizes, int n_in, void* d_out, int out_size, void* d_ws, size_t ws_size, hipStream_t stream) {
    static int grid = 0;
    if (grid == 0) {
        if (n_in != 29 || ws_size < WS_END) { fprintf(stderr, "kernel_launch: unexpected n_in %d or ws_size %zu (< %zu); nothing launched\n", n_in, ws_size, (size_t)WS_END); grid = -1; return; }
        int dev = 0, cus = 0;
        (void)hipGetDevice(&dev); (void)hipDeviceGetAttribute(&cus, hipDeviceAttributeMultiprocessorCount, dev);
        int per_cu = 0;
#if MK_ONE_LAUNCH
        (void)hipFuncSetAttribute((const void*)mk_fwd<true, 7>, hipFuncAttributeMaxDynamicSharedMemorySize, LDS_BYTES);
        (void)hipOccupancyMaxActiveBlocksPerMultiprocessor(&per_cu, (const void*)mk_fwd<true, 7>, NT, LDS_BYTES);
#else
        (void)hipFuncSetAttribute((const void*)mk_fwd<false, 1>, hipFuncAttributeMaxDynamicSharedMemorySize, LDS_BYTES);
        (void)hipFuncSetAttribute((const void*)mk_fwd<false, 2>, hipFuncAttributeMaxDynamicSharedMemorySize, LDS_BYTES);
        (void)hipFuncSetAttribute((const void*)mk_fwd<false, 4>, hipFuncAttributeMaxDynamicSharedMemorySize, LDS_BYTES);
        per_cu = 1;
#endif
        (void)hipGetLastError();
        grid = cus > 0 ? cus : 256;
        if (per_cu < 1) fprintf(stderr, "kernel_launch: occupancy query says %d blocks per CU\n", per_cu);
    }
    if (grid < 0) return;
    Args a{};
    for (int i = 0; i < 29; ++i) a.in[i] = (const float*)d_in[i];
    a.out = (float*)d_out; a.ws = (unsigned char*)d_ws;
#if MK_ONE_LAUNCH
    a.ph_lo = 0; a.ph_hi = N_PHASES;
    void* args[] = {&a};
    hipError_t e = hipLaunchCooperativeKernel((const void*)mk_fwd<true, 7>, dim3(grid), dim3(NT), args, LDS_BYTES, stream);
    if (e != hipSuccess) fprintf(stderr, "cooperative launch failed: %s (grid %d)\n", hipGetErrorString(e), grid);
#else
    for (int p = 0; p < N_PHASES; ++p) {
        if (p == 2) continue;
        a.ph_lo = p; a.ph_hi = p + 1;
        const int q = p < 2 ? -1 : (p - 2) % PH_PER_LAYER;
        if (q == 5) hipLaunchKernelGGL((mk_fwd<false, 2>), dim3(grid), dim3(NT), LDS_BYTES, stream, a);
        else if (q == 1 || q == 2 || q == 4 || q == 6 || q == 8 || q == 9 || q == 10 || q == 12 || q == 13) hipLaunchKernelGGL((mk_fwd<false, 4>), dim3(grid), dim3(NT), LDS_BYTES, stream, a);
        else hipLaunchKernelGGL((mk_fwd<false, 1>), dim3(grid), dim3(NT), LDS_BYTES, stream, a);
    }
#endif
}
```

```cpp
#include <hip/hip_runtime.h>
#include <hip/hip_cooperative_groups.h>
#include <cstdio>
#include <cstdint>
namespace cg = cooperative_groups;

#define GAS __attribute__((address_space(1)))
#define LAS __attribute__((address_space(3)))

constexpr int M = 16384, D = 1024, FF = 2816, NPROMPT_ROWS = 8192;
constexpr int NADA = 9216, NCOND = 9;
constexpr int ZA_W = 5120, ZB_W = 4096, ZS_W = 64;
constexpr int WINA_N = 5376, WINB_N = 4096, W1A_N = 5632;
constexpr int DIN = 9264;
constexpr float ALPHA = 1.4142135623730951f;
constexpr float LN_EPS = 1e-5f, NORM_EPS = 1e-6f;

constexpr size_t MiB = 1u << 20;
constexpr size_t WS_CTL = 0, CTL_BYTES = 65536;
constexpr size_t WS_ADA = 1 * MiB;
constexpr size_t WS_WT = 2 * MiB, WT_LAYER = 58 * MiB;
constexpr size_t WT_W1A = 0, WT_W1D = WT_W1A + (size_t)W1A_N * D * 2, WT_WINA = WT_W1D + (size_t)D * FF * 2, WT_WINB = WT_WINA + (size_t)WINA_N * D * 2,
                 WT_WBG = WT_WINB + (size_t)WINB_N * D * 2, WT_WBM = WT_WBG + (size_t)D * D * 2, WT_WO = WT_WBM + (size_t)D * D * 2,
                 WT_W2A = WT_WO + (size_t)D * D * 2, WT_W2D = WT_W2A + (size_t)W1A_N * D * 2, WT_END = WT_W2D + (size_t)D * FF * 2;
static_assert(WT_END <= WT_LAYER, "weights fit");
constexpr size_t WS_H = 118 * MiB;
constexpr size_t WS_ZS = 150 * MiB;
constexpr size_t WS_ZA = 154 * MiB;
constexpr size_t WS_ZB = 314 * MiB;
constexpr size_t WS_O = 442 * MiB;
constexpr size_t O_STRIDE = 32 * MiB;
constexpr size_t WS_ACT = 570 * MiB;
constexpr size_t WS_PRE = 658 * MiB;
constexpr size_t WS_QKC = 722 * MiB;
constexpr size_t WS_LA = 786 * MiB;
constexpr size_t WS_O2 = WS_ACT;
constexpr size_t WS_ST2 = 850 * MiB;
constexpr size_t WS_END = 960 * MiB;

constexpr size_t OUT_GLA = (size_t)M * D, OUT_MC = OUT_GLA + 16777216ull, OUT_MN = OUT_MC + 33554432ull, OUT_MM = OUT_MN + 131072ull;

typedef unsigned short bf16;
typedef float f32x4 __attribute__((ext_vector_type(4)));
typedef unsigned u32x4 __attribute__((ext_vector_type(4)));
typedef unsigned u32x2 __attribute__((ext_vector_type(2)));

__device__ __forceinline__ unsigned f2bf(float f) { unsigned u = __builtin_bit_cast(unsigned, f); return (u + 0x7fffu + ((u >> 16) & 1u)) >> 16; }
__device__ __forceinline__ unsigned pk2(float lo, float hi) { return f2bf(lo) | (f2bf(hi) << 16); }
__device__ __forceinline__ float bf_lo(unsigned w) { return __builtin_bit_cast(float, w << 16); }
__device__ __forceinline__ float bf_hi(unsigned w) { return __builtin_bit_cast(float, w & 0xffff0000u); }
__device__ __forceinline__ float bf2f(bf16 v) { return __builtin_bit_cast(float, (unsigned)v << 16); }
__device__ __forceinline__ float fast_sigmoid(float x) { return __builtin_amdgcn_rcpf(1.0f + __builtin_amdgcn_exp2f(-1.4426950408889634f * x)); }
__device__ __forceinline__ float fast_silu(float x) { return x * fast_sigmoid(x); }
__device__ __forceinline__ float log_sigmoid(float x) { return fminf(x, 0.f) - log1pf(expf(-fabsf(x))); }
__device__ __forceinline__ float wave_sum(float v) {
#pragma unroll
    for (int o = 1; o < 64; o <<= 1) v += __shfl_xor(v, o);
    return v;
}
__device__ __forceinline__ int cond_of_row(int r) { return r < NPROMPT_ROWS ? 0 : 1 + ((r - NPROMPT_ROWS) >> 10); }

__device__ __forceinline__ int otid() { int t = threadIdx.x; asm volatile("" : "+v"(t)); return t; }

namespace pg8 {
#define PG8_LAS __attribute__((address_space(3)))
typedef unsigned short bf16_t;
typedef short bf16x8 __attribute__((ext_vector_type(8)));
typedef float f32x4 __attribute__((ext_vector_type(4)));
typedef unsigned u32x4 __attribute__((ext_vector_type(4)));
constexpr int BM = 256, BK = 64, HALF = 128, HTB = HALF * BK * 2  , STAGE_BYTES = 8 * HTB, NXCD = 8, WGM = 8;

__host__ __device__ __forceinline__ int lds_byte(int r, int c) { const int st = (r >> 4) * 2 + (c >> 5), rr = r & 15, cc = c & 31, ob = rr * 64 + cc * 2; return st * 1024 + (ob ^ (((ob >> 9) & 1) << 5)); }
__host__ __device__ __forceinline__ void stage_rc(int b, int& R, int& C) { const int st = b / 1024, sb = b % 1024, swz = sb ^ (((sb >> 9) & 1) << 5); R = (st >> 1) * 16 + swz / 64; C = (st & 1) * 32 + (swz % 64) / 2; }
__host__ __device__ __forceinline__ int perm32(int rho) { const int n = rho >> 4, i = rho & 15; return 8 * (i >> 2) + 4 * n + (i & 3); }

struct Unit { int pm, pn; };
struct Gemm { const bf16_t* A; const bf16_t* Bt; int M, N, K; };

struct StaticOrder {
    int nM, nN, nwg, G, c;
    __host__ __device__ void init(int M, int N, int G_, int c_) { nM = M / BM; nN = N / BM; nwg = nM * nN; G = G_; c = c_; }
    __host__ __device__ bool next(int i, Unit& u) const {
        const long L = (long)i * G + c; if (L >= nwg) return false;
        int wgid = (int)L; { const int q = nwg / NXCD, r = nwg % NXCD, xcd = wgid % NXCD, off = wgid / NXCD; wgid = (xcd < r ? xcd * (q + 1) : r * (q + 1) + (xcd - r) * q) + off; }
        const int nig = WGM * nN, gid = wgid / nig, fm = gid * WGM, gsz = (nM - fm) < WGM ? (nM - fm) : WGM;
        u.pm = fm + ((wgid % nig) % gsz); u.pn = (wgid % nig) / gsz; return true;
    }
    __device__ __forceinline__ void a_ready(const Unit&) const {}
    __device__ __forceinline__ void done(const Unit&) const {}
};

__device__ __forceinline__ unsigned cvt_pk_bf16(float lo, float hi) { unsigned r; asm volatile("v_cvt_pk_bf16_f32 %0, %1, %2" : "=v"(r) : "v"(lo), "v"(hi)); return r; }
typedef float f32x2 __attribute__((ext_vector_type(2)));
__device__ __forceinline__ int unit_cond(const Unit& u) { return u.pm < 32 ? 0 : 1 + ((u.pm - 32) >> 2); }
__device__ __forceinline__ float esig(float x) { return __builtin_amdgcn_rcpf(1.0f + __builtin_amdgcn_exp2f(-1.4426950408889634f * x)); }

struct EpiSwiglu {
    static constexpr bool PERM = true, AFTER_DRAIN = false;
    bf16_t* O; int ldc;
    __device__ __forceinline__ void operator()(const f32x4 (&acc)[2][2][4][2], const Unit& u, int wr, int wc, int fr, int fq) const {
        const int row0 = u.pm * BM + wr * 64 + fr, col0 = u.pn * HALF + wc * 32 + 8 * fq;
#pragma unroll
        for (int ai = 0; ai < 2; ++ai)
#pragma unroll
            for (int m = 0; m < 4; ++m) { bf16_t* rowp = O + (size_t)(row0 + ai * HALF + m * 16) * ldc + col0;
                f32x4 v0, v1;
#pragma unroll
                for (int e = 0; e < 4; ++e) { const float g0 = acc[ai][0][m][0][e], g1 = acc[ai][0][m][1][e]; v0[e] = g0 * esig(g0) * acc[ai][1][m][0][e]; v1[e] = g1 * esig(g1) * acc[ai][1][m][1][e]; }
                u32x4 w; w.x = cvt_pk_bf16(v0[0], v0[1]); w.y = cvt_pk_bf16(v0[2], v0[3]); w.z = cvt_pk_bf16(v1[0], v1[1]); w.w = cvt_pk_bf16(v1[2], v1[3]);
                *(u32x4*)rowp = w; }
    }
};
struct EpiPre {
    static constexpr bool PERM = false, AFTER_DRAIN = false;
    const float* X; float* P; const float* gate; float coef;
    __device__ __forceinline__ void operator()(const f32x4 (&acc)[2][2][4][2], const Unit& u, int wr, int wc, int fr, int fq) const {
        const int row0 = u.pm * BM + wr * 64 + fr, col0 = u.pn * BM + wc * 32 + 4 * fq;
        const float* g = gate + (size_t)unit_cond(u) * 9216;
        f32x4 gv[2][2];
#pragma unroll
        for (int bj = 0; bj < 2; ++bj)
#pragma unroll
            for (int n = 0; n < 2; ++n) gv[bj][n] = *(const f32x4*)(g + col0 + bj * HALF + n * 16) * coef;
#pragma unroll
        for (int ai = 0; ai < 2; ++ai)
#pragma unroll
            for (int m = 0; m < 4; ++m) { const size_t off = (size_t)(row0 + ai * HALF + m * 16) * 1024 + col0;
#pragma unroll
                for (int bj = 0; bj < 2; ++bj)
#pragma unroll
                    for (int n = 0; n < 2; ++n) { const f32x4 x = *(const f32x4*)(X + off + bj * HALF + n * 16);
                        *(f32x4*)(P + off + bj * HALF + n * 16) = x * 1.4142135623730951f + gv[bj][n] * acc[ai][bj][m][n]; } }
    }
};
template <int ACTSEL> struct EpiZ {
    static constexpr bool PERM = true, AFTER_DRAIN = false;
    bf16_t* O; int ldc; float* ZS; int nmain;
    __device__ __forceinline__ void operator()(const f32x4 (&acc)[2][2][4][2], const Unit& u, int wr, int wc, int fr, int fq) const {
        const int row0 = u.pm * BM + wr * 64 + fr, col0 = u.pn * BM + wc * 32 + 8 * fq;
        if (ACTSEL == 0 && u.pn >= nmain) {
            if (wc < 2) {
#pragma unroll
                for (int ai = 0; ai < 2; ++ai)
#pragma unroll
                    for (int m = 0; m < 4; ++m) { float* rowp = ZS + (size_t)(row0 + ai * HALF + m * 16) * 64 + wc * 32 + 8 * fq;
                        *(f32x4*)rowp = acc[ai][0][m][0]; *(f32x4*)(rowp + 4) = acc[ai][0][m][1]; }
            }
            return;
        }
#pragma unroll
        for (int ai = 0; ai < 2; ++ai)
#pragma unroll
            for (int m = 0; m < 4; ++m) { bf16_t* rowp = O + (size_t)(row0 + ai * HALF + m * 16) * ldc + col0;
#pragma unroll
                for (int bj = 0; bj < 2; ++bj) { f32x4 v0 = acc[ai][bj][m][0], v1 = acc[ai][bj][m][1];
                    if (ACTSEL == 1) {
                        if (u.pn < 4) {
#pragma unroll
                            for (int e = 0; e < 4; ++e) { v0[e] = v0[e] * esig(v0[e]); v1[e] = v1[e] * esig(v1[e]); }
                        } else {
#pragma unroll
                            for (int e = 0; e < 4; ++e) { v0[e] = esig(v0[e]); v1[e] = esig(v1[e]); }
                        }
                    }
                    u32x4 w; w.x = cvt_pk_bf16(v0[0], v0[1]); w.y = cvt_pk_bf16(v0[2], v0[3]); w.z = cvt_pk_bf16(v1[0], v1[1]); w.w = cvt_pk_bf16(v1[2], v1[3]);
                    *(u32x4*)(rowp + bj * HALF) = w; } }
    }
};
template <bool ADD> struct EpiBranch {
    static constexpr bool PERM = true, AFTER_DRAIN = false;
    const bf16_t* G; int ldg; const bf16_t* T; bf16_t* O;
    __device__ __forceinline__ void operator()(const f32x4 (&acc)[2][2][4][2], const Unit& u, int wr, int wc, int fr, int fq) const {
        const int row0 = u.pm * BM + wr * 64 + fr, col0 = u.pn * BM + wc * 32 + 8 * fq;
#pragma unroll
        for (int ai = 0; ai < 2; ++ai)
#pragma unroll
            for (int m = 0; m < 4; ++m) { const size_t r = (size_t)(row0 + ai * HALF + m * 16);
#pragma unroll
                for (int bj = 0; bj < 2; ++bj) {
                    const u32x4 gw = *(const u32x4*)(G + r * ldg + col0 + bj * HALF);
                    f32x4 v0 = acc[ai][bj][m][0], v1 = acc[ai][bj][m][1];
                    v0[0] *= __builtin_bit_cast(float, gw.x << 16); v0[1] *= __builtin_bit_cast(float, gw.x & 0xffff0000u);
                    v0[2] *= __builtin_bit_cast(float, gw.y << 16); v0[3] *= __builtin_bit_cast(float, gw.y & 0xffff0000u);
                    v1[0] *= __builtin_bit_cast(float, gw.z << 16); v1[1] *= __builtin_bit_cast(float, gw.z & 0xffff0000u);
                    v1[2] *= __builtin_bit_cast(float, gw.w << 16); v1[3] *= __builtin_bit_cast(float, gw.w & 0xffff0000u);
                    if (ADD) { const u32x4 tw = *(const u32x4*)(T + r * 1024 + col0 + bj * HALF);
                        v0[0] += __builtin_bit_cast(float, tw.x << 16); v0[1] += __builtin_bit_cast(float, tw.x & 0xffff0000u);
                        v0[2] += __builtin_bit_cast(float, tw.y << 16); v0[3] += __builtin_bit_cast(float, tw.y & 0xffff0000u);
                        v1[0] += __builtin_bit_cast(float, tw.z << 16); v1[1] += __builtin_bit_cast(float, tw.z & 0xffff0000u);
                        v1[2] += __builtin_bit_cast(float, tw.w << 16); v1[3] += __builtin_bit_cast(float, tw.w & 0xffff0000u); }
                    u32x4 w; w.x = cvt_pk_bf16(v0[0], v0[1]); w.y = cvt_pk_bf16(v0[2], v0[3]); w.z = cvt_pk_bf16(v1[0], v1[1]); w.w = cvt_pk_bf16(v1[2], v1[3]);
                    *(u32x4*)(O + r * 1024 + col0 + bj * HALF) = w; } }
    }
};

template <class Epi, class Sched, bool ALIGN_EPI = false, bool SP2 = false>
__device__ __forceinline__ void gemm_phase(PG8_LAS unsigned char* lds, const Gemm g, const Sched& S, const Epi& E) {
    int tid_ = threadIdx.x; asm volatile("" : "+v"(tid_)); const int tid = tid_, wid = __builtin_amdgcn_readfirstlane(tid >> 6), lane = tid & 63, wr = wid >> 2, wc = wid & 3, fr = lane & 15, fq = lane >> 4;
    const int K = g.K, nt = K / BK;
    unsigned voffA[2], voffB[2];
#pragma unroll
    for (int i = 0; i < 2; ++i) { int R, C; stage_rc(tid * 16 + i * 8192, R, C); const int Rb = Epi::PERM ? ((R & ~31) + perm32(R & 31)) : R;
        voffA[i] = (unsigned)(R * K + C) * 2u; voffB[i] = (unsigned)(Rb * K + C) * 2u; }
    const size_t kstep = (size_t)(BK * 2);
    const size_t hstep = (size_t)HALF * K * 2;
    const size_t tstep = 2 * hstep;
    const unsigned ldsw = (unsigned)wid * 1024u;
    const int aoff = lds_byte(wr * 64 + fr, fq * 8), boff = lds_byte(wc * 32 + fr, fq * 8);
#define PG8_SA(b, h) (((b) * 2 + (h)) * HTB)
#define PG8_SB(b, h) ((4 + (b) * 2 + (h)) * HTB)
#define PG8_STAGE(bufoff, gbase, voff) do { _Pragma("unroll") for (int _i = 0; _i < 2; ++_i) \
        __builtin_amdgcn_global_load_lds((const unsigned*)((const char*)(gbase) + (voff)[_i]), (PG8_LAS unsigned*)(lds + (bufoff) + ldsw + _i * 8192), 16, 0, 0); } while (0)
#define PG8_LDA(dst, b, h) do { _Pragma("unroll") for (int m = 0; m < 4; ++m) _Pragma("unroll") for (int k = 0; k < 2; ++k) dst[m][k] = *(const PG8_LAS bf16x8*)(lds + PG8_SA(b, h) + aoff + m * 2048 + k * 1024); } while (0)
#define PG8_LDB(dst, b, h) do { _Pragma("unroll") for (int n = 0; n < 2; ++n) _Pragma("unroll") for (int k = 0; k < 2; ++k) dst[n][k] = *(const PG8_LAS bf16x8*)(lds + PG8_SB(b, h) + boff + n * 2048 + k * 1024); } while (0)
#define PG8_MMA(ai, bj, At, Bt) do { __builtin_amdgcn_s_setprio(1); _Pragma("unroll") for (int m = 0; m < 4; ++m) _Pragma("unroll") for (int n = 0; n < 2; ++n) _Pragma("unroll") for (int k = 0; k < 2; ++k) \
        acc[ai][bj][m][n] = __builtin_amdgcn_mfma_f32_16x16x32_bf16(Bt[n][k], At[m][k], acc[ai][bj][m][n], 0, 0, 0); __builtin_amdgcn_s_setprio(0); } while (0)
#define PG8_WAIT_V(n) asm volatile("s_waitcnt vmcnt(" #n ")" ::: "memory")
#define PG8_WAIT_L(n) asm volatile("s_waitcnt lgkmcnt(" #n ")" ::: "memory")
#define PG8_BAR __builtin_amdgcn_s_barrier()
#define PG8_SCHED __builtin_amdgcn_sched_barrier(0)
    Unit cur, nxt; int ui = 0;
    if (!S.next(0, cur)) return;
    f32x4 acc[2][2][4][2];
#pragma unroll
    for (int a = 0; a < 2; ++a)
#pragma unroll
        for (int b = 0; b < 2; ++b)
#pragma unroll
            for (int m = 0; m < 4; ++m)
#pragma unroll
                for (int n = 0; n < 2; ++n) acc[a][b][m][n] = (f32x4){0.f, 0.f, 0.f, 0.f};
    bf16x8 At[4][2], B0[2][2], B1[2][2];
    const char* cA = (const char*)g.A + (size_t)cur.pm * tstep; const char* cB = (const char*)g.Bt + (size_t)cur.pn * tstep;
    S.a_ready(cur);
    if constexpr (SP2) {
        PG8_STAGE(PG8_SB(0, 0), cB, voffB); PG8_STAGE(PG8_SB(0, 1), cB + hstep, voffB); PG8_STAGE(PG8_SA(0, 0), cA, voffA); PG8_STAGE(PG8_SA(0, 1), cA + hstep, voffA);
        if (wr == 1) PG8_BAR;
        PG8_WAIT_V(2); PG8_BAR;
        PG8_STAGE(PG8_SB(1, 0), cB + kstep, voffB); PG8_STAGE(PG8_SA(1, 0), cA + kstep, voffA); PG8_STAGE(PG8_SB(1, 1), cB + hstep + kstep, voffB);
        PG8_WAIT_V(6); PG8_BAR;
    } else {
        PG8_STAGE(PG8_SB(0, 0), cB, voffB); PG8_STAGE(PG8_SA(0, 0), cA, voffA); PG8_STAGE(PG8_SB(0, 1), cB + hstep, voffB); PG8_STAGE(PG8_SA(0, 1), cA + hstep, voffA);
        if (wr == 1) PG8_BAR;
        PG8_WAIT_V(4); PG8_BAR;
        PG8_STAGE(PG8_SB(1, 0), cB + kstep, voffB); PG8_STAGE(PG8_SA(1, 0), cA + kstep, voffA); PG8_STAGE(PG8_SB(1, 1), cB + hstep + kstep, voffB);
        PG8_WAIT_V(6); PG8_BAR;
    }
    for (;;) {
        const bool has_next = S.next(ui + 1, nxt);
        const char* nA = has_next ? (const char*)g.A + (size_t)nxt.pm * tstep : cA; const char* nB = has_next ? (const char*)g.Bt + (size_t)nxt.pn * tstep : cB;
        for (int t = 0; t < nt; t += 2) {
            const bool last = (t == nt - 2);
            const char* a1 = cA + (size_t)(t + 1) * kstep;
            const char* a2 = last ? nA : cA + (size_t)(t + 2) * kstep; const char* b2 = last ? nB : cB + (size_t)(t + 2) * kstep;
            const char* a3 = a2 + kstep; const char* b3 = b2 + kstep;
            if (last && has_next) S.a_ready(nxt);
            if constexpr (SP2) {
            PG8_LDB(B0, 0, 0); PG8_LDB(B1, 0, 1); PG8_SCHED; PG8_LDA(At, 0, 0); PG8_STAGE(PG8_SA(1, 1), a1 + hstep, voffA);
            PG8_WAIT_V(8); PG8_WAIT_L(0); PG8_BAR; PG8_MMA(0, 0, At, B0); PG8_MMA(0, 1, At, B1); PG8_BAR; PG8_SCHED;
            PG8_LDA(At, 0, 1); PG8_STAGE(PG8_SB(0, 0), b2, voffB); PG8_STAGE(PG8_SB(0, 1), b2 + hstep, voffB); PG8_STAGE(PG8_SA(0, 0), a2, voffA);
            PG8_WAIT_V(8); PG8_WAIT_L(0); PG8_BAR; PG8_MMA(1, 0, At, B0); PG8_MMA(1, 1, At, B1); PG8_BAR; PG8_SCHED;
            PG8_LDB(B0, 1, 0); PG8_LDB(B1, 1, 1); PG8_SCHED; PG8_LDA(At, 1, 0); PG8_STAGE(PG8_SA(0, 1), a2 + hstep, voffA);
            PG8_WAIT_V(8); PG8_WAIT_L(0); PG8_BAR; PG8_MMA(0, 0, At, B0); PG8_MMA(0, 1, At, B1); PG8_BAR; PG8_SCHED;
            PG8_LDA(At, 1, 1); PG8_STAGE(PG8_SB(1, 0), b3, voffB); PG8_STAGE(PG8_SB(1, 1), b3 + hstep, voffB); PG8_STAGE(PG8_SA(1, 0), a3, voffA);
            PG8_WAIT_V(8); PG8_WAIT_L(0); PG8_BAR; PG8_MMA(1, 0, At, B0); PG8_MMA(1, 1, At, B1); PG8_BAR; PG8_SCHED;
            } else {
            PG8_LDB(B0, 0, 0); PG8_SCHED; PG8_LDA(At, 0, 0); PG8_STAGE(PG8_SA(1, 1), a1 + hstep, voffA);
            PG8_WAIT_L(8); PG8_BAR; PG8_WAIT_L(0); PG8_MMA(0, 0, At, B0); PG8_BAR; PG8_SCHED;
            PG8_LDB(B1, 0, 1); PG8_STAGE(PG8_SB(0, 0), b2, voffB);
            PG8_BAR; PG8_WAIT_L(0); PG8_MMA(0, 1, At, B1); PG8_BAR;
            PG8_LDA(At, 0, 1); PG8_STAGE(PG8_SA(0, 0), a2, voffA);
            PG8_BAR; PG8_WAIT_L(0); PG8_MMA(1, 0, At, B0); PG8_BAR; PG8_SCHED;
            PG8_STAGE(PG8_SB(0, 1), b2 + hstep, voffB);
            PG8_WAIT_V(6); PG8_BAR; PG8_MMA(1, 1, At, B1); PG8_BAR;
            PG8_LDB(B0, 1, 0); PG8_SCHED; PG8_LDA(At, 1, 0); PG8_STAGE(PG8_SA(0, 1), a2 + hstep, voffA);
            PG8_WAIT_L(8); PG8_BAR; PG8_WAIT_L(0); PG8_MMA(0, 0, At, B0); PG8_BAR; PG8_SCHED;
            PG8_LDB(B1, 1, 1); PG8_STAGE(PG8_SB(1, 0), b3, voffB);
            PG8_BAR; PG8_WAIT_L(0); PG8_MMA(0, 1, At, B1); PG8_BAR;
            PG8_LDA(At, 1, 1); PG8_STAGE(PG8_SA(1, 0), a3, voffA);
            PG8_BAR; PG8_WAIT_L(0); PG8_MMA(1, 0, At, B0); PG8_BAR; PG8_SCHED;
            PG8_STAGE(PG8_SB(1, 1), b3 + hstep, voffB);
            PG8_WAIT_V(6); PG8_BAR; PG8_MMA(1, 1, At, B1); PG8_BAR;
            }
        }
        if constexpr (ALIGN_EPI) { if (wr == 0) PG8_BAR; }
        if constexpr (!Epi::AFTER_DRAIN) { E(acc, cur, wr, wc, fr, fq); S.done(cur); }
        if (!has_next) break;
#pragma unroll
        for (int a = 0; a < 2; ++a)
#pragma unroll
            for (int b = 0; b < 2; ++b)
#pragma unroll
                for (int m = 0; m < 4; ++m)
#pragma unroll
                    for (int n = 0; n < 2; ++n) acc[a][b][m][n] = (f32x4){0.f, 0.f, 0.f, 0.f};
        cur = nxt; cA = nA; cB = nB; ++ui;
        if constexpr (ALIGN_EPI) { if (wr == 1) PG8_BAR; }
    }
    PG8_WAIT_V(0);
    if constexpr (!ALIGN_EPI) { if (wr == 0) PG8_BAR; }
    PG8_BAR;
    if constexpr (Epi::AFTER_DRAIN) { E.fused(acc, cur, wr, wc, fr, fq, lds, wid, lane); S.done(cur); }
#undef PG8_SA
#undef PG8_SB
#undef PG8_STAGE
#undef PG8_LDA
#undef PG8_LDB
#undef PG8_MMA
#undef PG8_WAIT_V
#undef PG8_WAIT_L
#undef PG8_BAR
#undef PG8_SCHED
}
}

#ifndef SSEL
#define SSEL 3
#endif
struct Args { const float* in[29]; float* out; unsigned char* ws; int ph_lo, ph_hi; };
constexpr int PTR_OFF = 131072 + 1024;
struct Ctx { LAS unsigned char* lds; float* out; unsigned char* ws;
    __device__ __forceinline__ const float* in(int i) const { const LAS unsigned* p = (const LAS unsigned*)(lds + PTR_OFF) + 2 * i;
        const unsigned lo = __builtin_amdgcn_readfirstlane(p[0]), hi = __builtin_amdgcn_readfirstlane(p[1]); return (const float*)(((unsigned long long)hi << 32) | lo); } };
constexpr int NW = 8, NT = NW * 64;
constexpr int LDS_BYTES = 147456;

__device__ __forceinline__ void transpose_item(const float* src, int srcN, int k0, int n0, int ncols, bf16* dst, int dstK, int dstrow, LAS float* scr, int lane) {
#pragma unroll 8
    for (int i = 0; i < 32; ++i) { const int kk = 2 * i + (lane >> 5), c = lane & 31; scr[kk * 33 + c] = (c < ncols) ? src[(size_t)(k0 + kk) * srcN + n0 + c] : 0.f; }
    asm volatile("s_waitcnt lgkmcnt(0)" ::: "memory");
    const int c = lane & 7;
#pragma unroll
    for (int j = 0; j < 4; ++j) { const int n = (lane >> 3) + 8 * j; const LAS float* s = scr + (8 * c) * 33 + n;
        u32x4 o; o.x = pk2(s[0 * 33], s[1 * 33]); o.y = pk2(s[2 * 33], s[3 * 33]); o.z = pk2(s[4 * 33], s[5 * 33]); o.w = pk2(s[6 * 33], s[7 * 33]);
        if (n < ncols) *(u32x4*)(dst + (size_t)(dstrow + n) * dstK + k0 + 8 * c) = o; }
    asm volatile("s_waitcnt lgkmcnt(0)" ::: "memory");
}
__device__ __forceinline__ void phase_wconv(const Ctx& a, int l, LAS unsigned char* lds) {
    const int tid = otid(), lane = tid & 63, wave = tid >> 6;
    LAS float* scr = (LAS float*)(lds + wave * 16384);
    unsigned char* wt = a.ws + WS_WT + (size_t)l * WT_LAYER;
    const int gw = blockIdx.x * NW + wave, NGW = gridDim.x * NW;
    constexpr int I_1A = 16 * 176, I_1D = 44 * 32, I_INA = 16 * 162, I_INB = 16 * 128, I_SQ = 16 * 32;
    constexpr int NITEMS = 2 * I_1A + 2 * I_1D + I_INA + I_INB + 3 * I_SQ;
    for (int it = gw; it < NITEMS; it += NGW) {
        int r = it;
        if (r < 2 * I_1A) {
            const int f = r / I_1A; r -= f * I_1A; const int kb = r / 176, nb = r % 176, up = nb >= 88, c0 = 32 * (nb - 88 * up);
            const float* src = a.in(f == 0 ? (up ? 11 : 10) : (up ? 25 : 24)) + (size_t)l * D * FF;
            transpose_item(src, FF, 64 * kb, c0, 32, (bf16*)(wt + (f == 0 ? WT_W1A : WT_W2A)), D, 256 * (c0 >> 7) + (c0 & 127) + 128 * up, scr, lane); continue; }
        r -= 2 * I_1A;
        if (r < 2 * I_1D) {
            const int f = r / I_1D; r -= f * I_1D; const int kb = r / 32, nb = r % 32;
            transpose_item(a.in(f == 0 ? 12 : 26) + (size_t)l * FF * D, D, 64 * kb, 32 * nb, 32, (bf16*)(wt + (f == 0 ? WT_W1D : WT_W2D)), FF, 32 * nb, scr, lane); continue; }
        r -= 2 * I_1D;
        if (r < I_INA) { const int kb = r / 162, nb = r % 162; const float* src = a.in(13) + (size_t)l * D * DIN;
            int dr = 32 * nb, sc, nc = 32;
            if (nb < 160) sc = dr < 2048 ? dr : dr + 1056; else if (nb == 160) sc = 3072; else { sc = 7200; nc = 16; }
            transpose_item(src, DIN, 64 * kb, sc, nc, (bf16*)(wt + WT_WINA), D, dr, scr, lane); continue; }
        r -= I_INA;
        if (r < I_INB) { const int kb = r / 128, nb = r % 128; const float* src = a.in(13) + (size_t)l * D * DIN;
            const int dr = 32 * nb, sc = dr < 1024 ? dr + 2048 : (dr < 2048 ? dr + 5152 : dr + 5168);
            transpose_item(src, DIN, 64 * kb, sc, 32, (bf16*)(wt + WT_WINB), D, dr, scr, lane); continue; }
        r -= I_INB;
        { const int f = r / I_SQ; r -= f * I_SQ; const int kb = r / 32, nb = r % 32;
          transpose_item(a.in(21 + f) + (size_t)l * D * D, D, 64 * kb, 32 * nb, 32, (bf16*)(wt + (f == 0 ? WT_WBG : f == 1 ? WT_WBM : WT_WO)), D, 32 * nb, scr, lane); }
    }
}
__device__ __forceinline__ void phase_ada(const Ctx& a, LAS unsigned char* lds) {
    LAS float* sil = (LAS float*)lds;
    LAS float* red = (LAS float*)(lds + 36864);
    const int tid = otid();
    for (int i = tid; i < NCOND * D; i += NT) { const int ci = i >> 10, k = i & 1023; const float v = ci == 0 ? a.in(7)[k] : a.in(2)[(ci - 1) * D + k]; sil[i] = v / (1.f + expf(-v)); }
    __syncthreads();
    float* ada = (float*)(a.ws + WS_ADA);
    const int c = tid & 63, s = tid >> 6;
    for (int it = blockIdx.x; it < 2 * 144; it += gridDim.x) {
        const int l = it / 144, g = it % 144; const float* W = a.in(8) + (size_t)l * D * NADA + 64 * g + c;
        float acc[NCOND];
#pragma unroll
        for (int ci = 0; ci < NCOND; ++ci) acc[ci] = 0.f;
#pragma unroll 4
        for (int k = s; k < D; k += 8) { const float w = W[(size_t)k * NADA];
#pragma unroll
            for (int ci = 0; ci < NCOND; ++ci) acc[ci] += sil[ci * D + k] * w; }
#pragma unroll
        for (int ci = 0; ci < NCOND; ++ci) red[(s * NCOND + ci) * 64 + c] = acc[ci];
        __syncthreads();
        for (int i = tid; i < NCOND * 64; i += NT) { const int ci = i >> 6, cc = i & 63; float sum = a.in(9)[(size_t)l * NADA + 64 * g + cc];
#pragma unroll
            for (int ss = 0; ss < 8; ++ss) sum += red[(ss * NCOND + ci) * 64 + cc];
            ada[((size_t)l * NCOND + ci) * NADA + 64 * g + cc] = sum; }
        __syncthreads();
    }
}
__device__ __forceinline__ void store_mod_row(bf16* hrow, const f32x4 (&v)[4], const float* sh, const float* sc, int lane) {
#pragma unroll
    for (int j = 0; j < 4; ++j) { const f32x4 s = *(const f32x4*)(sc + 256 * j + 4 * lane), t = *(const f32x4*)(sh + 256 * j + 4 * lane);
        const f32x4 h = v[j] * (s + 1.0f) + t; u32x2 w; w.x = pk2(h[0], h[1]); w.y = pk2(h[2], h[3]); *(u32x2*)(hrow + 256 * j + 4 * lane) = w; }
}
__device__ __forceinline__ void phase_xinit(const Ctx& a) {
    const int tid = otid(), lane = tid & 63, gw = blockIdx.x * NW + (tid >> 6), NGW = gridDim.x * NW;
    const float* ada = (const float*)(a.ws + WS_ADA);
    bf16* H = (bf16*)(a.ws + WS_H);
    for (int r = gw; r < M; r += NGW) {
        f32x4 v[4];
        if (r < NPROMPT_ROWS) {
#pragma unroll
            for (int j = 0; j < 4; ++j) v[j] = *(const f32x4*)(a.in(0) + (size_t)r * D + 256 * j + 4 * lane);
        } else {
            const int rs = r - NPROMPT_ROWS, t = rs & 1023; const float gr = (float)(t >> 6), gc = (float)(t & 63);
#pragma unroll
            for (int j = 0; j < 4; ++j) { v[j] = *(const f32x4*)(a.in(1) + (size_t)rs * D + 256 * j + 4 * lane);
#pragma unroll
                for (int e = 0; e < 4; ++e) { const float om = 1.0f / powf(10000.0f, (float)(4 * lane + e) * (1.0f / 256.0f)); const float ang = (j < 2 ? gr : gc) * om;
                    v[j][e] += (j & 1) ? cosf(ang) : sinf(ang); } }
        }
#pragma unroll
        for (int j = 0; j < 4; ++j) *(f32x4*)(a.out + (size_t)r * D + 256 * j + 4 * lane) = v[j];
        const float* ad = ada + (size_t)cond_of_row(r) * NADA;
        store_mod_row(H + (size_t)r * D, v, ad, ad + 1024, lane);
    }
}
__device__ __forceinline__ void phase_ln(const Ctx& a, const float* lng, const float* lnb, const float* mod) {
    const int tid = otid(), lane = tid & 63, gw = blockIdx.x * NW + (tid >> 6), NGW = gridDim.x * NW;
    const float* P = (const float*)(a.ws + WS_PRE);
    bf16* H = (bf16*)(a.ws + WS_H);
    for (int r = gw; r < M; r += NGW) {
        f32x4 v[4]; float s = 0.f;
#pragma unroll
        for (int j = 0; j < 4; ++j) { v[j] = *(const f32x4*)(P + (size_t)r * D + 256 * j + 4 * lane); s += (v[j][0] + v[j][1]) + (v[j][2] + v[j][3]); }
        const float mean = wave_sum(s) * (1.f / D); float s2 = 0.f;
#pragma unroll
        for (int j = 0; j < 4; ++j) { v[j] = v[j] - mean; s2 += (v[j][0] * v[j][0] + v[j][1] * v[j][1]) + (v[j][2] * v[j][2] + v[j][3] * v[j][3]); }
        const float rstd = 1.0f / sqrtf(wave_sum(s2) * (1.f / D) + LN_EPS);
#pragma unroll
        for (int j = 0; j < 4; ++j) { const f32x4 g = *(const f32x4*)(lng + 256 * j + 4 * lane), b = *(const f32x4*)(lnb + 256 * j + 4 * lane);
            v[j] = v[j] * rstd * g + b; *(f32x4*)(a.out + (size_t)r * D + 256 * j + 4 * lane) = v[j]; }
        if (mod) { const float* ad = mod + (size_t)cond_of_row(r) * NADA; store_mod_row(H + (size_t)r * D, v, ad, ad + 1024, lane); }
    }
}
__device__ __forceinline__ void phase_combine(const Ctx& a, int l) {
    const int tid = otid(), lane = tid & 63, gw = blockIdx.x * NW + (tid >> 6), NGW = gridDim.x * NW;
    const bf16* ZB = (const bf16*)(a.ws + WS_ZB);
    for (int r = gw; r < M; r += NGW) {
#pragma unroll
        for (int br = 0; br < 2; ++br) {
            bf16* OF = (bf16*)(a.ws + WS_O + (size_t)(2 * br) * O_STRIDE) + (size_t)r * D; const bf16* OB = (const bf16*)(a.ws + WS_O + (size_t)(2 * br + 1) * O_STRIDE) + (size_t)r * D;
            const float* gam = a.in(19 + br) + l * 256 + 4 * lane; const f32x4 gv = *(const f32x4*)gam;
            const bf16* gate = ZB + (size_t)r * ZB_W + br * 1024;
#pragma unroll
            for (int h = 0; h < 4; ++h) {
                const u32x2 wf = *(const u32x2*)(OF + 256 * h + 4 * lane), wb = *(const u32x2*)(OB + 256 * h + 4 * lane), wg = *(const u32x2*)(gate + 256 * h + 4 * lane);
                f32x4 s; s[0] = bf_lo(wf.x) + bf_lo(wb.x); s[1] = bf_hi(wf.x) + bf_hi(wb.x); s[2] = bf_lo(wf.y) + bf_lo(wb.y); s[3] = bf_hi(wf.y) + bf_hi(wb.y);
                const float ss = wave_sum((s[0] * s[0] + s[1] * s[1]) + (s[2] * s[2] + s[3] * s[3]));
                const float rs = 1.0f / sqrtf(ss * (1.f / 256.f) + NORM_EPS);
                f32x4 o = s * rs * gv; o[0] *= bf_lo(wg.x); o[1] *= bf_hi(wg.x); o[2] *= bf_lo(wg.y); o[3] *= bf_hi(wg.y);
                u32x2 w; w.x = pk2(o[0], o[1]); w.y = pk2(o[2], o[3]); *(u32x2*)(OF + 256 * h + 4 * lane) = w;
            }
        }
    }
}
struct ScanOut { unsigned char* obase; float* gla; float* mc; float* mn; float* mm; int lsel; };
__device__ __forceinline__ void scan_gla_naive(const Ctx& a, const ScanOut& so, int l, int sample, int b, int h, int dir, LAS unsigned char* lds) {
    const int tid = otid(), dv = tid & 255, half = tid >> 8;
    const int T = sample ? 1024 : 256, row0 = sample ? NPROMPT_ROWS + b * 1024 : b * 256;
    const bf16* ZA = (const bf16*)(a.ws + WS_ZA); const float* ZS = (const float*)(a.ws + WS_ZS);
    bf16* OG = (bf16*)(so.obase + (size_t)dir * O_STRIDE);
    LAS float* qs = (LAS float*)lds; LAS float* ks = qs + 16 * 128; LAS float* es = ks + 16 * 128; LAS float* op = es + 16 * 128; LAS float* vs = op + 32 * 256;
    float S[64];
    const size_t sidx = ((((size_t)b * 2 + l) * 2 + dir) * 4 + h) * (128 * 256), sidx2 = (so.lsel < 0 ? ((((size_t)b * 2 + l) * 2 + dir) * 4 + h) : (((size_t)b * 2 + dir) * 4 + h)) * (128 * 256);
    if (sample) {
#pragma unroll
        for (int i = 0; i < 64; ++i) { S[i] = a.in(3)[sidx + (size_t)(half * 64 + i) * 256 + dv]; if ((i & 7) == 7) asm volatile("" ::: "memory"); }
    } else {
#pragma unroll
        for (int i = 0; i < 64; ++i) S[i] = 0.f;
    }
    const int d = tid & 127, jq = tid >> 7;
    float wd[16];
#pragma unroll
    for (int r = 0; r < 16; ++r) wd[r] = a.in(14)[(((size_t)l * 2 + dir) * 16 + r) * 512 + h * 128 + d];
    const float bd = a.in(15)[((size_t)l * 2 + dir) * 512 + h * 128 + d];
#pragma unroll 1
    for (int t0 = 0; t0 < T; t0 += 16) {
        __syncthreads();
#pragma unroll 1
        for (int i = 0; i < 4; ++i) { const int j = jq + 4 * i, tok = dir ? T - 1 - (t0 + j) : t0 + j; const size_t r = (size_t)(row0 + tok);
            float x = bd;
#pragma unroll
            for (int q4 = 0; q4 < 4; ++q4) { const f32x4 av = *(const f32x4*)(ZS + r * 64 + dir * 16 + 4 * q4); x += av[0] * wd[4 * q4] + av[1] * wd[4 * q4 + 1] + av[2] * wd[4 * q4 + 2] + av[3] * wd[4 * q4 + 3]; }
            es[j * 128 + d] = expf(log_sigmoid(x) * (1.f / 16.f));
            qs[j * 128 + d] = bf2f(ZA[r * ZA_W + h * 128 + d]) * 0.08838834764831845f;
            ks[j * 128 + d] = bf2f(ZA[r * ZA_W + 512 + h * 128 + d]); }
#pragma unroll 2
        for (int jj = 0; jj < 8; ++jj) { const int j = half * 8 + jj; const int tok = dir ? T - 1 - (t0 + j) : t0 + j; vs[j * 256 + dv] = bf2f(ZA[(size_t)(row0 + tok) * ZA_W + 1024 + h * 256 + dv]); }
        __syncthreads();
#pragma unroll 1
        for (int j = 0; j < 16; ++j) { float acc = 0.f; const float vj = vs[j * 256 + dv];
#pragma unroll
            for (int i4 = 0; i4 < 16; ++i4) { const int dk = half * 64 + 4 * i4; const f32x4 e4 = *(const LAS f32x4*)(es + j * 128 + dk), k4 = *(const LAS f32x4*)(ks + j * 128 + dk), q4 = *(const LAS f32x4*)(qs + j * 128 + dk);
#pragma unroll
                for (int e = 0; e < 4; ++e) { S[4 * i4 + e] = e4[e] * S[4 * i4 + e] + k4[e] * vj; acc += q4[e] * S[4 * i4 + e]; }
                asm volatile("" ::: "memory"); }
            op[(half * 16 + j) * 256 + dv] = acc; }
        __syncthreads();
#pragma unroll 2
        for (int jj = 0; jj < 8; ++jj) { const int j = half * 8 + jj; const int tok = dir ? T - 1 - (t0 + j) : t0 + j; OG[(size_t)(row0 + tok) * D + h * 256 + dv] = (bf16)f2bf(op[j * 256 + dv] + op[(16 + j) * 256 + dv]); }
    }
    if (!sample) {
#pragma unroll
        for (int i = 0; i < 64; ++i) { so.gla[sidx2 + (size_t)(half * 64 + i) * 256 + dv] = S[i]; if ((i & 7) == 7) asm volatile("" ::: "memory"); }
    }
}
__device__ __forceinline__ void scan_mlstm_naive(const Ctx& a, const ScanOut& so, int l, int sample, int b, int h, int dir, LAS unsigned char* lds) {
    const int tid = otid(), dv = tid & 255, half = tid >> 8, lane = tid & 63, wave = tid >> 6;
    const int T = sample ? 1024 : 256, row0 = sample ? NPROMPT_ROWS + b * 1024 : b * 256;
    const bf16* ZA = (const bf16*)(a.ws + WS_ZA); const float* ZS = (const float*)(a.ws + WS_ZS);
    bf16* OM = (bf16*)(so.obase + (size_t)(2 + dir) * O_STRIDE);
    LAS float* qs = (LAS float*)lds; LAS float* ks = qs + 16 * 256; LAS float* op = ks + 16 * 256; LAS float* qnp = op + 32 * 256; LAS float* gt = qnp + 16 * 256; LAS float* vs = gt + 128;
    float C[128];
    const size_t hidx = (((size_t)b * 2 + l) * 2 + dir) * 4 + h, hidx2 = so.lsel < 0 ? ((((size_t)b * 2 + l) * 2 + dir) * 4 + h) : (((size_t)b * 2 + dir) * 4 + h);
    float n = 0.f, m = 0.f;
    if (sample) {
#pragma unroll
        for (int i = 0; i < 128; ++i) { C[i] = a.in(4)[hidx * 65536 + (size_t)(half * 128 + i) * 256 + dv]; if ((i & 7) == 7) asm volatile("" ::: "memory"); }
        if (tid < 256) n = a.in(5)[hidx * 256 + tid];
        m = a.in(6)[hidx];
    } else {
#pragma unroll
        for (int i = 0; i < 128; ++i) C[i] = 0.f;
    }
    const int chan = (tid < 256) ? h * 256 + tid : 1024 + h * 256 + (tid - 256);
    const float w0 = a.in(16)[((size_t)l * 3 + 0) * 2048 + chan], w1 = a.in(16)[((size_t)l * 3 + 1) * 2048 + chan], w2 = a.in(16)[((size_t)l * 3 + 2) * 2048 + chan], bc = a.in(17)[(size_t)l * 2048 + chan];
    const float fb = a.in(18)[((size_t)l * 2 + dir) * 4 + h];
#pragma unroll 1
    for (int t0 = 0; t0 < T; t0 += 16) {
        __syncthreads();
#pragma unroll 2
        for (int j = 0; j < 16; ++j) { const int tok = dir ? T - 1 - (t0 + j) : t0 + j; const bf16* zp = ZA + (size_t)(row0 + tok) * ZA_W + 2048 + chan;
            const float zc = bf2f(zp[0]), zm = tok > 0 ? bf2f(zp[-ZA_W]) : 0.f, zn = tok < T - 1 ? bf2f(zp[ZA_W]) : 0.f;
            const float x = w0 * zm + w1 * zc + w2 * zn + bc; const float sv = x / (1.f + expf(-x));
            if (tid < 256) qs[j * 256 + tid] = sv * 0.0625f; else ks[j * 256 + tid - 256] = sv; }
        if (tid == 0) { float mm = m;
            for (int j = 0; j < 16; ++j) { const int tok = dir ? T - 1 - (t0 + j) : t0 + j; const float* zr = ZS + (size_t)(row0 + tok) * 64 + 32 + dir * 8 + h;
                const float ig = zr[0], lf = log_sigmoid(zr[4] + fb); const float mn = fmaxf(lf + mm, ig);
                gt[j] = expf(lf + mm - mn); gt[16 + j] = expf(ig - mn); gt[32 + j] = expf(-mn); mm = mn; }
            gt[64] = mm; }
#pragma unroll 2
        for (int jj = 0; jj < 8; ++jj) { const int j = half * 8 + jj; const int tok = dir ? T - 1 - (t0 + j) : t0 + j; vs[j * 256 + dv] = bf2f(ZA[(size_t)(row0 + tok) * ZA_W + 4096 + h * 256 + dv]); }
        __syncthreads();
        m = gt[64];
#pragma unroll 1
        for (int j = 0; j < 16; ++j) { const float f = gt[j], w = gt[16 + j]; const float kv = w * vs[j * 256 + dv]; float acc = 0.f;
#pragma unroll
            for (int i4 = 0; i4 < 32; ++i4) { const int dk = half * 128 + 4 * i4; const f32x4 k4 = *(const LAS f32x4*)(ks + j * 256 + dk), q4 = *(const LAS f32x4*)(qs + j * 256 + dk);
#pragma unroll
                for (int e = 0; e < 4; ++e) { C[4 * i4 + e] = f * C[4 * i4 + e] + k4[e] * kv; acc += q4[e] * C[4 * i4 + e]; }
                asm volatile("" ::: "memory"); }
            op[(half * 16 + j) * 256 + dv] = acc;
            if (tid < 256) { n = f * n + w * ks[j * 256 + tid]; qnp[j * 256 + tid] = qs[j * 256 + tid] * n; } }
        __syncthreads();
#pragma unroll
        for (int jj = 0; jj < 2; ++jj) { const int j = 2 * wave + jj; const f32x4 p = *(const LAS f32x4*)(qnp + j * 256 + 4 * lane); const float s = wave_sum((p[0] + p[1]) + (p[2] + p[3])); if (lane == 0) gt[48 + j] = s; }
        __syncthreads();
#pragma unroll 2
        for (int jj = 0; jj < 8; ++jj) { const int j = half * 8 + jj; const int tok = dir ? T - 1 - (t0 + j) : t0 + j; const float den = fmaxf(fabsf(gt[48 + j]), gt[32 + j]);
            OM[(size_t)(row0 + tok) * D + h * 256 + dv] = (bf16)f2bf((op[j * 256 + dv] + op[(16 + j) * 256 + dv]) / den); }
    }
    if (!sample) {
#pragma unroll
        for (int i = 0; i < 128; ++i) { so.mc[hidx2 * 65536 + (size_t)(half * 128 + i) * 256 + dv] = C[i]; if ((i & 7) == 7) asm volatile("" ::: "memory"); }
        if (tid < 256) so.mn[hidx2 * 256 + tid] = n;
        if (tid == 0) so.mm[hidx2] = m;
    }
}
__device__ __forceinline__ void phase_scan_naive(const Ctx& a, const ScanOut& so, int l, LAS unsigned char* lds) {
    for (int u = blockIdx.x; u < 640; u += gridDim.x) {
        int kind, sample, v;
        if (u < 64) { kind = 1; sample = 1; v = u; } else if (u < 128) { kind = 0; sample = 1; v = u - 64; } else if (u < 384) { kind = 1; sample = 0; v = u - 128; } else { kind = 0; sample = 0; v = u - 384; }
        const int dir = v & 1, h = (v >> 1) & 3, b = v >> 3;
        if (kind) { if (SSEL & 2) scan_mlstm_naive(a, so, l, sample, b, h, dir, lds); } else { if (SSEL & 1) scan_gla_naive(a, so, l, sample, b, h, dir, lds); }
        __syncthreads();
    }
}


typedef float f32x16 __attribute__((ext_vector_type(16)));
typedef short s16x8 __attribute__((ext_vector_type(8)));
typedef short s16x4 __attribute__((ext_vector_type(4)));
typedef float f32x2_t __attribute__((ext_vector_type(2)));
typedef __bf16 bf16x2_t __attribute__((ext_vector_type(2)));
#define MFMA32(a, b, c) __builtin_amdgcn_mfma_f32_32x32x16_bf16((a), (b), (c), 0, 0, 0)
#define MFMA16(a, b, c) __builtin_amdgcn_mfma_f32_16x16x32_bf16((a), (b), (c), 0, 0, 0)
__device__ __forceinline__ unsigned cvtpk(float lo, float hi) { f32x2_t v = {lo, hi}; bf16x2_t b = __builtin_convertvector(v, bf16x2_t); return __builtin_bit_cast(unsigned, b); }
__device__ __forceinline__ s16x4 vtr(const LAS unsigned char* p) { typedef short v4i16_t __attribute__((ext_vector_type(4))); return __builtin_bit_cast(s16x4, __builtin_amdgcn_ds_read_tr16_b64_v4i16((LAS v4i16_t*)p)); }
__device__ __forceinline__ s16x8 cat8(s16x4 lo, s16x4 hi) { return __builtin_shufflevector(lo, hi, 0, 1, 2, 3, 4, 5, 6, 7); }
__device__ __forceinline__ int crow(int r, int h) { return (r & 3) + 8 * (r >> 2) + 4 * h; }
__device__ __forceinline__ s16x8 pack_step(const f32x16& x, int s) {
    u32x4 p; p.x = cvtpk(x[8 * s + 0], x[8 * s + 1]); p.y = cvtpk(x[8 * s + 2], x[8 * s + 3]); p.z = cvtpk(x[8 * s + 4], x[8 * s + 5]); p.w = cvtpk(x[8 * s + 6], x[8 * s + 7]);
    return __builtin_bit_cast(s16x8, p);
}
__device__ __forceinline__ s16x8 frag_tr(const LAS unsigned char* base, int trofs, int RS) { return cat8(vtr(base + trofs), vtr(base + trofs + 4 * RS)); }
__device__ __forceinline__ s16x8 frag_perm(const LAS unsigned char* p) { return cat8(*(const LAS s16x4*)p, *(const LAS s16x4*)(p + 16)); }

constexpr int SC_CHUNK = 64;
constexpr int ML_RSQ = 528, ML_RSK = 576, ML_RSV = 576, RSP = 144;
constexpr int ML_Q = 0, ML_K = ML_Q + 64 * ML_RSQ, ML_V = ML_K + 64 * ML_RSK, ML_P = ML_V + 64 * ML_RSV, ML_SC = ML_P + 64 * RSP, ML_N = ML_SC + 2048, ML_END = ML_N + 1024;
static_assert(ML_END <= 131072, "mLSTM LDS");
__device__ __forceinline__ void scan_mlstm_fast(const Ctx& a, int l, int sample, int b, int h, int dir, LAS unsigned char* lds) {
    const int tid = otid(), lane = tid & 63, wave = __builtin_amdgcn_readfirstlane(tid >> 6);
    const int T = sample ? 1024 : 256, row0 = sample ? NPROMPT_ROWS + b * 1024 : b * 256;
    const bf16* QKC = (const bf16*)(a.ws + WS_QKC); const bf16* ZA = (const bf16*)(a.ws + WS_ZA); const float* ZS = (const float*)(a.ws + WS_ZS);
    bf16* OM = (bf16*)(a.ws + WS_O + (size_t)(2 + dir) * O_STRIDE);
    LAS float* SC = (LAS float*)(lds + ML_SC); LAS float* NV = (LAS float*)(lds + ML_N);
    LAS float* sR = SC, *sIR = SC + 64, *sEM = SC + 128, *sW = SC + 192, *sDEN = SC + 256, *sQN = SC + 320, *sINT = SC + 384, *sMISC = SC + 448;
    const int hh = lane >> 5, c32 = lane & 31;
    const size_t hidx = (((size_t)b * 2 + l) * 2 + dir) * 4 + h;
    f32x16 C[8];
    if (sample) {
        const float* cp = a.in(4) + hidx * 65536 + 32 * wave + c32;
#pragma unroll
        for (int blk = 0; blk < 8; ++blk) {
#pragma unroll
            for (int r = 0; r < 16; ++r) C[blk][r] = cp[(size_t)(32 * blk + crow(r, hh)) * 256];
            asm volatile("" ::: "memory"); }
        if (tid < 256) NV[tid] = a.in(5)[hidx * 256 + tid];
        if (tid == 0) sMISC[0] = a.in(6)[hidx];
    } else {
#pragma unroll
        for (int blk = 0; blk < 8; ++blk)
#pragma unroll
            for (int r = 0; r < 16; ++r) C[blk][r] = 0.f;
        if (tid < 256) NV[tid] = 0.f;
        if (tid == 0) sMISC[0] = 0.f;
    }
    for (int i = tid; i < 64 * RSP / 4; i += NT) ((LAS unsigned*)(lds + ML_P))[i] = 0u;
    const float fb = a.in(18)[((size_t)l * 2 + dir) * 4 + h];
    __syncthreads();
#pragma unroll 1
    for (int t0 = 0; t0 < T; t0 += SC_CHUNK) {
        int tid_l = tid; asm volatile("" : "+v"(tid_l));
        const int tid = tid_l, lane = tid & 63, hh = lane >> 5, c32 = lane & 31;
        const int i16 = lane & 15, tq = i16 >> 2, tp = i16 & 3, tblk = (lane >> 4) & 1;
        const int trofs_k = (8 * hh + tq) * ML_RSK + (16 * tblk + 4 * tp) * 2;
        const int g16 = lane >> 4;
        {
            u32x4 qv[4], kv[4];
#pragma unroll
            for (int i = 0; i < 4; ++i) { const int idx = tid + NT * i, j = idx >> 5, pc = idx & 31; const int tok = dir ? T - 1 - (t0 + j) : t0 + j; const size_t r = (size_t)(row0 + tok);
                qv[i] = *(const u32x4*)(QKC + r * 2048 + h * 256 + pc * 8); kv[i] = *(const u32x4*)(QKC + r * 2048 + 1024 + h * 256 + pc * 8); }
            if (wave == 0) {
                const int tok = dir ? T - 1 - (t0 + lane) : t0 + lane; const float* zr = ZS + (size_t)(row0 + tok) * 64 + 32 + dir * 8 + h;
                const float ig = zr[0], lf = log_sigmoid(zr[4] + fb); const float mprev = sMISC[0];
                float cum = lf;
#pragma unroll
                for (int o = 1; o < 64; o <<= 1) { const float t = __shfl_up(cum, o); if (lane >= o) cum += t; }
                const float g = ig - cum; float pm = g;
#pragma unroll
                for (int o = 1; o < 64; o <<= 1) { const float t = __shfl_up(pm, o); if (lane >= o) pm = fmaxf(pm, t); }
                const float mj = cum + fmaxf(mprev, pm); const float mnew = __shfl(mj, 63), c63 = __shfl(cum, 63);
                const float r = expf(cum - mj - c63 + mnew), inter = expf(cum + mprev - mj);
                sR[lane] = r; sIR[lane] = inter / r; sINT[lane] = inter; sEM[lane] = expf(-mj); sW[lane] = expf(c63 + g - mnew); sDEN[lane] = 0.f;
                if (lane == 0) { sMISC[1] = expf(c63 + mprev - mnew); sMISC[2] = mnew; }
            }
#pragma unroll
            for (int i = 0; i < 4; ++i) { const int idx = tid + NT * i, j = idx >> 5, pc = idx & 31;
                *(LAS u32x4*)(lds + ML_Q + j * ML_RSQ + pc * 16) = qv[i]; *(LAS u32x4*)(lds + ML_K + j * ML_RSK + pc * 16) = kv[i]; }
        }
        __syncthreads();
        {
#pragma unroll
            for (int i = 0; i < 4; ++i) { const int idx = tid + NT * i, j = idx >> 5, pc = idx & 31; const int tok = dir ? T - 1 - (t0 + j) : t0 + j; const size_t r = (size_t)(row0 + tok);
                const u32x4 v = *(const u32x4*)(ZA + r * ZA_W + 4096 + h * 256 + pc * 8); const float w = sW[j];
                u32x4 o; o.x = cvtpk(bf_lo(v.x) * w, bf_hi(v.x) * w); o.y = cvtpk(bf_lo(v.y) * w, bf_hi(v.y) * w); o.z = cvtpk(bf_lo(v.z) * w, bf_hi(v.z) * w); o.w = cvtpk(bf_lo(v.w) * w, bf_hi(v.w) * w);
                *(LAS u32x4*)(lds + ML_V + j * ML_RSV + pc * 16) = o; }
        }
        {
            const int t = tid >> 3, part = tid & 7; float s = 0.f;
#pragma unroll
            for (int i = 0; i < 4; ++i) { const u32x4 qv = *(const LAS u32x4*)(lds + ML_Q + t * ML_RSQ + part * 64 + i * 16); const f32x4 n0 = *(const LAS f32x4*)(NV + part * 32 + i * 8), n1 = *(const LAS f32x4*)(NV + part * 32 + i * 8 + 4);
                s += bf_lo(qv.x) * n0[0] + bf_hi(qv.x) * n0[1] + bf_lo(qv.y) * n0[2] + bf_hi(qv.y) * n0[3] + bf_lo(qv.z) * n1[0] + bf_hi(qv.z) * n1[1] + bf_lo(qv.w) * n1[2] + bf_hi(qv.w) * n1[3]; }
            s += __shfl_xor(s, 1); s += __shfl_xor(s, 2); s += __shfl_xor(s, 4);
            if (part == 0) sQN[t] = s;
        }
#pragma unroll 1
        for (int bi = wave; bi < 10; bi += 8) {
            int ti, si;
            if (bi < 1) { ti = 0; si = 0; } else if (bi < 3) { ti = 1; si = bi - 1; } else if (bi < 6) { ti = 2; si = bi - 3; } else { ti = 3; si = bi - 6; }
            pg8::f32x4 acc = {0.f, 0.f, 0.f, 0.f};
            const LAS unsigned char* ka = lds + ML_K + (16 * si + i16) * ML_RSK + g16 * 16; const LAS unsigned char* qb = lds + ML_Q + (16 * ti + i16) * ML_RSQ + g16 * 16;
#pragma unroll
            for (int ks = 0; ks < 8; ++ks) acc = MFMA16(*(const LAS s16x8*)(ka + ks * 64), *(const LAS s16x8*)(qb + ks * 64), acc);
            const int t = 16 * ti + i16, s0 = 16 * si + 4 * g16; float dsum = 0.f;
#pragma unroll
            for (int i = 0; i < 4; ++i) { if (s0 + i > t) acc[i] = 0.f; dsum += acc[i] * sW[s0 + i]; }
            u32x2 pw; pw.x = cvtpk(acc[0], acc[1]); pw.y = cvtpk(acc[2], acc[3]);
            *(LAS u32x2*)(lds + ML_P + t * RSP + s0 * 2) = pw;
            __hip_atomic_fetch_add(sDEN + t, dsum, __ATOMIC_RELAXED, __HIP_MEMORY_SCOPE_WORKGROUP);
        }
        f32x16 Z[2];
#pragma unroll
        for (int r = 0; r < 16; ++r) { Z[0][r] = 0.f; Z[1][r] = 0.f; }
#pragma unroll
        for (int blk = 0; blk < 8; ++blk)
#pragma unroll
            for (int s = 0; s < 2; ++s) { const s16x8 cf = pack_step(C[blk], s);
#pragma unroll
                for (int tb = 0; tb < 2; ++tb) Z[tb] = MFMA32(cf, frag_perm(lds + ML_Q + (32 * tb + c32) * ML_RSQ + (32 * blk + 16 * s + 4 * hh) * 2), Z[tb]);
                asm volatile("" ::: "memory"); }
#pragma unroll
        for (int tb = 0; tb < 2; ++tb) { const float ir = sIR[32 * tb + c32];
#pragma unroll
            for (int r = 0; r < 16; ++r) Z[tb][r] *= ir; }
        __syncthreads();
        s16x8 vf[4];
#pragma unroll
        for (int ks = 0; ks < 4; ++ks) vf[ks] = frag_tr(lds + ML_V + (16 * ks) * ML_RSV + (32 * wave) * 2, trofs_k, ML_RSV);
#pragma unroll
        for (int tb = 0; tb < 2; ++tb)
#pragma unroll
            for (int ks = 0; ks < 2 + 2 * tb; ++ks) Z[tb] = MFMA32(vf[ks], *(const LAS s16x8*)(lds + ML_P + (32 * tb + c32) * RSP + (16 * ks + 8 * hh) * 2), Z[tb]);
#pragma unroll
        for (int tb = 0; tb < 2; ++tb) { const int j = 32 * tb + c32; const float r = sR[j]; const float den = fmaxf(fabsf(r * sDEN[j] + sINT[j] * sQN[j]), sEM[j]); const float sc = r / den;
            const int tok = dir ? T - 1 - (t0 + j) : t0 + j; bf16* op = OM + (size_t)(row0 + tok) * D + h * 256 + 32 * wave + 4 * hh;
#pragma unroll
            for (int g = 0; g < 4; ++g) { u32x2 w; w.x = cvtpk(Z[tb][4 * g] * sc, Z[tb][4 * g + 1] * sc); w.y = cvtpk(Z[tb][4 * g + 2] * sc, Z[tb][4 * g + 3] * sc); *(u32x2*)(op + 8 * g) = w; } }
        {
            const float decay = sMISC[1];
#pragma unroll
            for (int blk = 0; blk < 8; ++blk) {
#pragma unroll
                for (int r = 0; r < 16; ++r) C[blk][r] *= decay;
#pragma unroll
                for (int ks = 0; ks < 4; ++ks) C[blk] = MFMA32(frag_tr(lds + ML_K + (16 * ks) * ML_RSK + (32 * blk) * 2, trofs_k, ML_RSK), vf[ks], C[blk]);
                asm volatile("" ::: "memory"); }
            if (tid < 256) { float n = NV[tid] * decay;
#pragma unroll 8
                for (int s = 0; s < 64; ++s) n += sW[s] * bf2f(*(const LAS bf16*)(lds + ML_K + s * ML_RSK + tid * 2));
                NV[tid] = n; }
            if (tid == 0) sMISC[0] = sMISC[2];
        }
        __syncthreads();
    }
    if (!sample) {
        float* cp = a.out + OUT_MC + hidx * 65536 + 32 * wave + c32;
#pragma unroll
        for (int blk = 0; blk < 8; ++blk) {
#pragma unroll
            for (int r = 0; r < 16; ++r) cp[(size_t)(32 * blk + crow(r, hh)) * 256] = C[blk][r];
            asm volatile("" ::: "memory"); }
        if (tid < 256) a.out[OUT_MN + hidx * 256 + tid] = NV[tid];
        if (tid == 0) a.out[OUT_MM + hidx] = sMISC[0];
    }
    __syncthreads();
}
constexpr int GL_RSQ = 272, GL_RSK = 320, GL_RSV = 576;
constexpr int GL_Q = 0, GL_K = GL_Q + 64 * GL_RSQ, GL_V = GL_K + 64 * GL_RSK, GL_P = GL_V + 64 * GL_RSV, GL_E = GL_P + 64 * RSP, GL_TOT = GL_E + 512, GL_END = GL_TOT + 2048;
__device__ __forceinline__ void scan_gla_fast(const Ctx& a, int l, int sample, int b, int h, int dir, LAS unsigned char* lds) {
    const int tid = otid(), lane = tid & 63, wave = __builtin_amdgcn_readfirstlane(tid >> 6);
    const int T = sample ? 1024 : 256, row0 = sample ? NPROMPT_ROWS + b * 1024 : b * 256;
    const bf16* ZA = (const bf16*)(a.ws + WS_ZA); const float* LA = (const float*)(a.ws + WS_LA) + (size_t)dir * M * 512;
    bf16* OG = (bf16*)(a.ws + WS_O + (size_t)dir * O_STRIDE);
    LAS float* sE = (LAS float*)(lds + GL_E); LAS float* sTOT = (LAS float*)(lds + GL_TOT);
    const int hh = lane >> 5, c32 = lane & 31;
    const size_t sidx = ((((size_t)b * 2 + l) * 2 + dir) * 4 + h) * (128 * 256);
    f32x16 S[4];
    if (sample) {
        const float* sp = a.in(3) + sidx + 32 * wave + c32;
#pragma unroll
        for (int blk = 0; blk < 4; ++blk) {
#pragma unroll
            for (int r = 0; r < 16; ++r) S[blk][r] = sp[(size_t)(32 * blk + crow(r, hh)) * 256];
            asm volatile("" ::: "memory"); }
    } else {
#pragma unroll
        for (int blk = 0; blk < 4; ++blk)
#pragma unroll
            for (int r = 0; r < 16; ++r) S[blk][r] = 0.f;
    }
    for (int i = tid; i < 64 * RSP / 4; i += NT) ((LAS unsigned*)(lds + GL_P))[i] = 0u;
    __syncthreads();
#pragma unroll 1
    for (int t0 = 0; t0 < T; t0 += SC_CHUNK) {
        int tid_l = tid; asm volatile("" : "+v"(tid_l));
        const int tid = tid_l, lane = tid & 63, hh = lane >> 5, c32 = lane & 31;
        const int i16 = lane & 15, tq = i16 >> 2, tp = i16 & 3, tblk = (lane >> 4) & 1;
        const int trofs_k = (8 * hh + tq) * GL_RSK + (16 * tblk + 4 * tp) * 2, trofs_v = (8 * hh + tq) * GL_RSV + (16 * tblk + 4 * tp) * 2;
        const int g16 = lane >> 4;
        const int d = tid & 127, seg = tid >> 7;
        u32x4 vv[4];
#pragma unroll
        for (int i = 0; i < 4; ++i) { const int idx = tid + NT * i, j = idx >> 5, pc = idx & 31; const int tok = dir ? T - 1 - (t0 + j) : t0 + j;
            vv[i] = *(const u32x4*)(ZA + (size_t)(row0 + tok) * ZA_W + 1024 + h * 256 + pc * 8); }
        float cum[16]; float run = 0.f;
#pragma unroll
        for (int i = 0; i < 16; ++i) { const int j = 16 * seg + i; const int tok = dir ? T - 1 - (t0 + j) : t0 + j; run += LA[(size_t)(row0 + tok) * 512 + h * 128 + d]; cum[i] = run; }
        sTOT[seg * 128 + d] = run;
#pragma unroll
        for (int i = 0; i < 4; ++i) { const int idx = tid + NT * i, j = idx >> 5, pc = idx & 31; *(LAS u32x4*)(lds + GL_V + j * GL_RSV + pc * 16) = vv[i]; }
        __syncthreads();
        float offs = 0.f;
#pragma unroll
        for (int s2 = 0; s2 < 3; ++s2) if (s2 < seg) offs += sTOT[s2 * 128 + d];
        if (seg == 3) sE[d] = expf(offs + run);
#pragma unroll
        for (int i = 0; i < 16; ++i) { const int j = 16 * seg + i; const int tok = dir ? T - 1 - (t0 + j) : t0 + j; const bf16* zp = ZA + (size_t)(row0 + tok) * ZA_W + h * 128 + d;
            const float cu = offs + cum[i]; const float e = expf(cu);
            *(LAS bf16*)(lds + GL_Q + j * GL_RSQ + d * 2) = (bf16)f2bf(bf2f(zp[0]) * 0.08838834764831845f * e);
            *(LAS bf16*)(lds + GL_K + j * GL_RSK + d * 2) = (bf16)f2bf(bf2f(zp[512]) / e); }
        __syncthreads();
#pragma unroll 1
        for (int bi = wave; bi < 10; bi += 8) {
            int ti, si;
            if (bi < 1) { ti = 0; si = 0; } else if (bi < 3) { ti = 1; si = bi - 1; } else if (bi < 6) { ti = 2; si = bi - 3; } else { ti = 3; si = bi - 6; }
            pg8::f32x4 acc = {0.f, 0.f, 0.f, 0.f};
            const LAS unsigned char* ka = lds + GL_K + (16 * si + i16) * GL_RSK + g16 * 16; const LAS unsigned char* qb = lds + GL_Q + (16 * ti + i16) * GL_RSQ + g16 * 16;
#pragma unroll
            for (int ks = 0; ks < 4; ++ks) acc = MFMA16(*(const LAS s16x8*)(ka + ks * 64), *(const LAS s16x8*)(qb + ks * 64), acc);
            const int t = 16 * ti + i16, s0 = 16 * si + 4 * g16;
#pragma unroll
            for (int i = 0; i < 4; ++i) if (s0 + i > t) acc[i] = 0.f;
            u32x2 pw; pw.x = cvtpk(acc[0], acc[1]); pw.y = cvtpk(acc[2], acc[3]);
            *(LAS u32x2*)(lds + GL_P + t * RSP + s0 * 2) = pw;
        }
        f32x16 Z[2];
#pragma unroll
        for (int r = 0; r < 16; ++r) { Z[0][r] = 0.f; Z[1][r] = 0.f; }
#pragma unroll
        for (int blk = 0; blk < 4; ++blk)
#pragma unroll
            for (int s = 0; s < 2; ++s) { const s16x8 cf = pack_step(S[blk], s);
#pragma unroll
                for (int tb = 0; tb < 2; ++tb) Z[tb] = MFMA32(cf, frag_perm(lds + GL_Q + (32 * tb + c32) * GL_RSQ + (32 * blk + 16 * s + 4 * hh) * 2), Z[tb]); }
        __syncthreads();
        s16x8 vf[4];
#pragma unroll
        for (int ks = 0; ks < 4; ++ks) vf[ks] = frag_tr(lds + GL_V + (16 * ks) * GL_RSV + (32 * wave) * 2, trofs_v, GL_RSV);
#pragma unroll
        for (int tb = 0; tb < 2; ++tb)
#pragma unroll
            for (int ks = 0; ks < 2 + 2 * tb; ++ks) Z[tb] = MFMA32(vf[ks], *(const LAS s16x8*)(lds + GL_P + (32 * tb + c32) * RSP + (16 * ks + 8 * hh) * 2), Z[tb]);
#pragma unroll
        for (int tb = 0; tb < 2; ++tb) { const int j = 32 * tb + c32; const int tok = dir ? T - 1 - (t0 + j) : t0 + j; bf16* op = OG + (size_t)(row0 + tok) * D + h * 256 + 32 * wave + 4 * hh;
#pragma unroll
            for (int g = 0; g < 4; ++g) { u32x2 w; w.x = cvtpk(Z[tb][4 * g], Z[tb][4 * g + 1]); w.y = cvtpk(Z[tb][4 * g + 2], Z[tb][4 * g + 3]); *(u32x2*)(op + 8 * g) = w; } }
#pragma unroll
        for (int blk = 0; blk < 4; ++blk) {
#pragma unroll
            for (int ks = 0; ks < 4; ++ks) S[blk] = MFMA32(frag_tr(lds + GL_K + (16 * ks) * GL_RSK + (32 * blk) * 2, trofs_k, GL_RSK), vf[ks], S[blk]);
#pragma unroll
            for (int g = 0; g < 4; ++g) { const f32x4 e4 = *(const LAS f32x4*)(sE + 32 * blk + 8 * g + 4 * hh);
#pragma unroll
                for (int e = 0; e < 4; ++e) S[blk][4 * g + e] *= e4[e]; } }
        __syncthreads();
    }
    if (!sample) {
        float* sp = a.out + OUT_GLA + sidx + 32 * wave + c32;
#pragma unroll
        for (int blk = 0; blk < 4; ++blk) {
#pragma unroll
            for (int r = 0; r < 16; ++r) sp[(size_t)(32 * blk + crow(r, hh)) * 256] = S[blk][r];
            asm volatile("" ::: "memory"); }
    }
    __syncthreads();
}
__device__ __forceinline__ void phase_scan_fast(const Ctx& a, int l, LAS unsigned char* lds) {
    for (int u = blockIdx.x; u < 640; u += gridDim.x) {
        int kind, sample, v;
        if (u < 64) { kind = 1; sample = 1; v = u; } else if (u < 128) { kind = 0; sample = 1; v = u - 64; } else if (u < 384) { kind = 1; sample = 0; v = u - 128; } else { kind = 0; sample = 0; v = u - 384; }
        const int dir = v & 1, h = (v >> 1) & 3, b = v >> 3;
        if (kind) scan_mlstm_fast(a, l, sample, b, h, dir, lds); else scan_gla_fast(a, l, sample, b, h, dir, lds);
    }
}
__device__ __forceinline__ void phase_prep(const Ctx& a, int l, LAS unsigned char* lds) {
    const int tid = otid(), lane = tid & 63, gw = blockIdx.x * NW + (tid >> 6), NGW = gridDim.x * NW;
    const bf16* ZA = (const bf16*)(a.ws + WS_ZA); const float* ZS = (const float*)(a.ws + WS_ZS);
    bf16* QKC = (bf16*)(a.ws + WS_QKC); float* LA = (float*)(a.ws + WS_LA);
    LAS float* wd = (LAS float*)lds; LAS float* bd = wd + 2 * 16 * 512;
    for (int i = tid; i < 2 * 16 * 512; i += NT) wd[i] = a.in(14)[(size_t)l * 2 * 16 * 512 + i];
    for (int i = tid; i < 2 * 512; i += NT) bd[i] = a.in(15)[(size_t)l * 2 * 512 + i];
    __syncthreads();
    const float* wc = a.in(16) + (size_t)l * 3 * 2048; const float* bc = a.in(17) + (size_t)l * 2048;
    for (int r = gw; r < M; r += NGW) {
        const int T = r < NPROMPT_ROWS ? 256 : 1024, t = r < NPROMPT_ROWS ? (r & 255) : ((r - NPROMPT_ROWS) & 1023);
#pragma unroll
        for (int j = 0; j < 4; ++j) { const int ch = 512 * j + 8 * lane; const bf16* zp = ZA + (size_t)r * ZA_W + 2048 + ch;
            const u32x4 zc = *(const u32x4*)zp; u32x4 zm = {0u, 0u, 0u, 0u}, zn = {0u, 0u, 0u, 0u};
            if (t > 0) zm = *(const u32x4*)(zp - ZA_W); if (t < T - 1) zn = *(const u32x4*)(zp + ZA_W);
            float o[8];
#pragma unroll
            for (int e = 0; e < 4; ++e) { const unsigned cw = zc[e], mw = zm[e], nw = zn[e];
#pragma unroll
                for (int q = 0; q < 2; ++q) { const int c = ch + 2 * e + q; const float xc = q ? bf_hi(cw) : bf_lo(cw), xm = q ? bf_hi(mw) : bf_lo(mw), xn = q ? bf_hi(nw) : bf_lo(nw);
                    const float x = wc[c] * xm + wc[2048 + c] * xc + wc[4096 + c] * xn + bc[c]; float s = x / (1.f + expf(-x)); if (c < 1024) s *= 0.0625f; o[2 * e + q] = s; } }
            u32x4 w; w.x = pk2(o[0], o[1]); w.y = pk2(o[2], o[3]); w.z = pk2(o[4], o[5]); w.w = pk2(o[6], o[7]);
            *(u32x4*)(QKC + (size_t)r * 2048 + ch) = w; }
        float av[32];
#pragma unroll
        for (int i = 0; i < 8; ++i) { const f32x4 t4 = *(const f32x4*)(ZS + (size_t)r * 64 + 4 * i); av[4 * i] = t4[0]; av[4 * i + 1] = t4[1]; av[4 * i + 2] = t4[2]; av[4 * i + 3] = t4[3]; }
#pragma unroll
        for (int dir = 0; dir < 2; ++dir)
#pragma unroll
            for (int j = 0; j < 2; ++j) { const int c0 = 256 * j + 4 * lane; f32x4 x = *(const LAS f32x4*)(bd + dir * 512 + c0);
#pragma unroll
                for (int k = 0; k < 16; ++k) x += *(const LAS f32x4*)(wd + (dir * 16 + k) * 512 + c0) * av[dir * 16 + k];
                f32x4 o; o[0] = log_sigmoid(x[0]) * 0.0625f; o[1] = log_sigmoid(x[1]) * 0.0625f; o[2] = log_sigmoid(x[2]) * 0.0625f; o[3] = log_sigmoid(x[3]) * 0.0625f;
                *(f32x4*)(LA + ((size_t)dir * M + r) * 512 + c0) = o; }
    }
    __syncthreads();
}

__device__ __forceinline__ void cmp_flush(const Ctx& a, int item, float nu, float de, LAS unsigned char* lds) {
    LAS float* red = (LAS float*)lds; const int tid = threadIdx.x, lane = tid & 63, wave = tid >> 6;
    nu = wave_sum(nu); de = wave_sum(de);
    __syncthreads(); if (lane == 0) { red[2 * wave] = nu; red[2 * wave + 1] = de; } __syncthreads();
    if (tid == 0) { float n2 = 0.f, d2 = 0.f; for (int w = 0; w < NW; ++w) { n2 += red[2 * w]; d2 += red[2 * w + 1]; }
        float* chk = (float*)(a.ws + WS_CTL) + 256; atomicAdd(chk + 2 * item, n2); atomicAdd(chk + 2 * item + 1, d2); }
}
__device__ __forceinline__ void phase_compare(const Ctx& a, int l, LAS unsigned char* lds) {
    const size_t gt = (size_t)blockIdx.x * NT + threadIdx.x, GT = (size_t)gridDim.x * NT;
    for (int ob = 0; ob < 4; ++ob) { const bf16* F = (const bf16*)(a.ws + WS_O + (size_t)ob * O_STRIDE); const bf16* R = (const bf16*)(a.ws + WS_O2 + (size_t)ob * O_STRIDE);
        float nu = 0.f, de = 0.f;
        for (size_t i = gt; i < (size_t)M * D / 2; i += GT) { const unsigned f = ((const unsigned*)F)[i], r = ((const unsigned*)R)[i];
            const float d0 = bf_lo(f) - bf_lo(r), d1 = bf_hi(f) - bf_hi(r); nu += d0 * d0 + d1 * d1; de += bf_lo(r) * bf_lo(r) + bf_hi(r) * bf_hi(r); }
        cmp_flush(a, ob, nu, de, lds); }
    const float* st = (const float*)(a.ws + WS_ST2);
    {   float nu = 0.f, de = 0.f;
        for (size_t c = gt; c < (size_t)32 * 2 * 4 * 32768; c += GT) { const size_t bh = c >> 15, rest = c & 32767, bb = bh >> 3, dh = bh & 7; const float f = a.out[OUT_GLA + (((bb * 2 + l) * 8) + dh) * 32768 + rest], r = st[c]; nu += (f - r) * (f - r); de += r * r; }
        cmp_flush(a, 4, nu, de, lds); }
    {   float nu = 0.f, de = 0.f;
        for (size_t c = gt; c < (size_t)32 * 2 * 4 * 65536; c += GT) { const size_t bh = c >> 16, rest = c & 65535, bb = bh >> 3, dh = bh & 7; const float f = a.out[OUT_MC + (((bb * 2 + l) * 8) + dh) * 65536 + rest], r = st[8388608 + c]; nu += (f - r) * (f - r); de += r * r; }
        cmp_flush(a, 5, nu, de, lds); }
    {   float nu = 0.f, de = 0.f;
        for (size_t c = gt; c < (size_t)32 * 2 * 4 * 256; c += GT) { const size_t bh = c >> 8, rest = c & 255, bb = bh >> 3, dh = bh & 7; const float f = a.out[OUT_MN + (((bb * 2 + l) * 8) + dh) * 256 + rest], r = st[8388608 + 16777216 + c]; nu += (f - r) * (f - r); de += r * r; }
        cmp_flush(a, 6, nu, de, lds); }
    {   float nu = 0.f, de = 0.f;
        for (size_t c = gt; c < (size_t)32 * 2 * 4; c += GT) { const size_t bb = c >> 3, dh = c & 7; const float f = a.out[OUT_MM + ((bb * 2 + l) * 8) + dh], r = st[8388608 + 16777216 + 65536 + c]; nu += (f - r) * (f - r); de += r * r; }
        cmp_flush(a, 7, nu, de, lds); }
}

template <class Epi> __device__ __forceinline__ void run_gemm(LAS unsigned char* lds, const bf16* A, const bf16* Bt, int N, int K, const Epi& E) {
    pg8::Gemm g{A, Bt, M, N, K}; pg8::StaticOrder S; S.init(M, N, (int)gridDim.x, (int)blockIdx.x);
    pg8::gemm_phase<Epi, pg8::StaticOrder, true, true>(lds, g, S, E);
}
#ifndef GSEL
#define GSEL 0x1ff
#endif
#ifndef MK_CHECK
#define MK_CHECK 0
#endif
#ifndef MK_FAST_SCAN
#define MK_FAST_SCAN 1
#endif
#ifndef MK_CHECK_TOL
#define MK_CHECK_TOL 3e-4f
#endif
constexpr int N_PHASES = 2 + 2 * (MK_CHECK ? 16 : 14);

template <bool COOP, int MASK> __global__ void __launch_bounds__(NT, 2) mk_fwd(Args ka) {
    extern __shared__ __attribute__((aligned(16))) unsigned char lds_raw[];
    LAS unsigned char* lds = (LAS unsigned char*)lds_raw;
    const int lo = ka.ph_lo, hi = ka.ph_hi;
    {
        LAS unsigned long long* tab = (LAS unsigned long long*)(lds + PTR_OFF);
        if (threadIdx.x == 0) {
#pragma unroll
            for (int i = 0; i < 29; ++i) tab[i] = (unsigned long long)ka.in[i];
        }
        __syncthreads();
    }
#define MISC (MASK & 1)
#define SCAN (MASK & 2)
#define GEMM (MASK & 4)
    constexpr int NQ = MK_CHECK ? 16 : 14;
#pragma unroll 1
    for (int ph = lo; ph < hi; ++ph) {
        unsigned char* ws = ka.ws; float* outp = ka.out;
        asm volatile("" : "+s"(ws), "+s"(outp));
        const Ctx a{lds, outp, ws};
        const float* ada = (const float*)(ws + WS_ADA);
        bf16* H = (bf16*)(ws + WS_H); bf16* ACT = (bf16*)(ws + WS_ACT); float* PRE = (float*)(ws + WS_PRE);
        bf16* ZA = (bf16*)(ws + WS_ZA); bf16* ZB = (bf16*)(ws + WS_ZB); float* ZS = (float*)(ws + WS_ZS);
        bf16* O0 = (bf16*)(ws + WS_O); bf16* O1 = (bf16*)(ws + WS_O + O_STRIDE); bf16* O2 = (bf16*)(ws + WS_O + 2 * O_STRIDE); bf16* O3 = (bf16*)(ws + WS_O + 3 * O_STRIDE);
        int l = 0, q = ph;
        if (ph >= 2) { l = (ph - 2) / NQ; const int k = (ph - 2) % NQ; q = 2 + k + ((!MK_CHECK && k >= 6) ? 2 : 0); }
        const unsigned char* wt = ws + WS_WT + (size_t)l * WT_LAYER;
        const float* adl = ada + (size_t)l * NCOND * NADA;
        const float* lng = a.in(27) + (size_t)l * 3 * D; const float* lnb = a.in(28) + (size_t)l * 3 * D;
        switch (q) {
        case 0: if (MISC) { phase_ada(a, lds); __syncthreads(); phase_wconv(a, 0, lds); phase_wconv(a, 1, lds); } break;
        case 1: if (MISC) { phase_xinit(a); } break;
        case 2: if (GEMM && (GSEL >> 0 & 1)) { pg8::EpiSwiglu E{ACT, FF}; run_gemm(lds, H, (const bf16*)(wt + WT_W1A), W1A_N, D, E); } break;
        case 3: if (GEMM && (GSEL >> 1 & 1)) { pg8::EpiPre E{a.out, PRE, adl + 2 * D, 0.5f}; run_gemm(lds, ACT, (const bf16*)(wt + WT_W1D), D, FF, E); } break;
        case 4: if (MISC) { phase_ln(a, lng, lnb, adl + 3 * D); } break;
        case 5: if (GEMM && (GSEL >> 2 & 1)) { pg8::EpiZ<0> E{ZA, ZA_W, ZS, 20}; run_gemm(lds, H, (const bf16*)(wt + WT_WINA), WINA_N, D, E); } break;
        case 6: if (GEMM && (GSEL >> 3 & 1)) { pg8::EpiZ<1> E{ZB, ZB_W, nullptr, 1 << 30}; run_gemm(lds, H, (const bf16*)(wt + WT_WINB), WINB_N, D, E); }
                if (MISC) { phase_prep(a, l, lds); } break;
        case 7: if (SCAN) {
#if MK_FAST_SCAN
                    phase_scan_fast(a, l, lds);
#else
                    const ScanOut so{ws + WS_O, a.out + OUT_GLA, a.out + OUT_MC, a.out + OUT_MN, a.out + OUT_MM, -1}; phase_scan_naive(a, so, l, lds);
#endif
                } break;
#if MK_CHECK
        case 8: if (MASK & 8) { float* st = (float*)(ws + WS_ST2); const ScanOut so{ws + WS_O2, st, st + 8388608, st + 8388608 + 16777216, st + 8388608 + 16777216 + 65536, 0}; phase_scan_naive(a, so, l, lds); } break;
        case 9: if (MASK & 16) { phase_compare(a, l, lds); } break;
#endif
        case 10: if (MISC) { phase_combine(a, l); } break;
        case 11: if (GEMM && (GSEL >> 4 & 1)) { pg8::EpiBranch<false> E{ZB + 2048, ZB_W, nullptr, O1}; run_gemm(lds, O0, (const bf16*)(wt + WT_WBG), D, D, E); } break;
        case 12: if (GEMM && (GSEL >> 5 & 1)) { pg8::EpiBranch<true> E{ZB + 3072, ZB_W, O1, O3}; run_gemm(lds, O2, (const bf16*)(wt + WT_WBM), D, D, E); } break;
        case 13: if (GEMM && (GSEL >> 1 & 1)) { pg8::EpiPre E{a.out, PRE, adl + 5 * D, 1.0f}; run_gemm(lds, O3, (const bf16*)(wt + WT_WO), D, D, E); } break;
        case 14: if (MISC) { phase_ln(a, lng + D, lnb + D, adl + 6 * D); } break;
        case 15: if (GEMM && (GSEL >> 0 & 1)) { pg8::EpiSwiglu E{ACT, FF}; run_gemm(lds, H, (const bf16*)(wt + WT_W2A), W1A_N, D, E); } break;
        case 16: if (GEMM && (GSEL >> 1 & 1)) { pg8::EpiPre E{a.out, PRE, adl + 8 * D, 0.5f}; run_gemm(lds, ACT, (const bf16*)(wt + WT_W2D), D, FF, E); } break;
        case 17: if (MISC) { phase_ln(a, lng + 2 * D, lnb + 2 * D, l == 0 ? ada + (size_t)NCOND * NADA : nullptr);
#if MK_CHECK
                    if (l == 1 && blockIdx.x == 0 && threadIdx.x == 0) { const float* chk = (const float*)(ws + WS_CTL) + 256; unsigned mask = 0;
                        for (int i = 0; i < 8; ++i) { const float nu = __hip_atomic_load(chk + 2 * i, __ATOMIC_RELAXED, __HIP_MEMORY_SCOPE_AGENT), de = __hip_atomic_load(chk + 2 * i + 1, __ATOMIC_RELAXED, __HIP_MEMORY_SCOPE_AGENT); if (!(nu <= MK_CHECK_TOL * de) || !(de > 0.f)) mask |= 1u << i; }
                        const unsigned long long t0 = __builtin_amdgcn_s_memrealtime(); while (__builtin_amdgcn_s_memrealtime() - t0 < (unsigned long long)mask * 400000ull) __builtin_amdgcn_s_sleep(32); }
#endif
                } break;
        default: break;
        }
        if (COOP && ph + 1 < hi) { __syncthreads(); cg::this_grid().sync(); }
    }
#undef MISC
#undef SCAN
#undef GEMM
}

#ifndef MK_ONE_LAUNCH
#define MK_ONE_LAUNCH 1
#endif
extern "C" void kernel_launch(void* const* d_in, const int* in_sizes, int n_in, void* d_out, int out_size, void* d_ws, size_t ws_size, hipStream_t stream) {
    static int grid = 0;
    if (grid == 0) {
        if (n_in != 29 || ws_size < WS_END) { fprintf(stderr, "kernel_launch: unexpected n_in %d or ws_size %zu (< %zu); nothing launched\n", n_in, ws_size, (size_t)WS_END); grid = -1; return; }
        int dev = 0, cus = 0;
        (void)hipGetDevice(&dev); (void)hipDeviceGetAttribute(&cus, hipDeviceAttributeMultiprocessorCount, dev);
        int per_cu = 0;
#if MK_ONE_LAUNCH && !MK_CHECK
        (void)hipFuncSetAttribute((const void*)mk_fwd<true, 7>, hipFuncAttributeMaxDynamicSharedMemorySize, LDS_BYTES);
        (void)hipOccupancyMaxActiveBlocksPerMultiprocessor(&per_cu, (const void*)mk_fwd<true, 7>, NT, LDS_BYTES);
#else
        (void)hipFuncSetAttribute((const void*)mk_fwd<false, 7>, hipFuncAttributeMaxDynamicSharedMemorySize, LDS_BYTES);
        (void)hipFuncSetAttribute((const void*)mk_fwd<false, 8>, hipFuncAttributeMaxDynamicSharedMemorySize, LDS_BYTES);
        (void)hipFuncSetAttribute((const void*)mk_fwd<false, 16>, hipFuncAttributeMaxDynamicSharedMemorySize, LDS_BYTES);
        per_cu = 1;
#endif
        (void)hipGetLastError();
        grid = cus > 0 ? cus : 256;
        if (per_cu < 1) fprintf(stderr, "kernel_launch: occupancy query says %d blocks per CU\n", per_cu);
    }
    if (grid < 0) return;
    (void)hipMemsetAsync((char*)d_ws + WS_CTL, 0, CTL_BYTES, stream);
    Args a{};
    for (int i = 0; i < 29; ++i) a.in[i] = (const float*)d_in[i];
    a.out = (float*)d_out; a.ws = (unsigned char*)d_ws;
#if MK_ONE_LAUNCH && !MK_CHECK
    a.ph_lo = 0; a.ph_hi = N_PHASES;
    void* args[] = {&a};
    hipError_t e = hipLaunchCooperativeKernel((const void*)mk_fwd<true, 7>, dim3(grid), dim3(NT), args, LDS_BYTES, stream);
    if (e != hipSuccess) fprintf(stderr, "cooperative launch failed: %s (grid %d)\n", hipGetErrorString(e), grid);
#else
    for (int p = 0; p < N_PHASES; ++p) {
        a.ph_lo = p; a.ph_hi = p + 1;
        if (MK_CHECK && p >= 2 && (p - 2) % 16 == 6) hipLaunchKernelGGL((mk_fwd<false, 8>), dim3(grid), dim3(NT), LDS_BYTES, stream, a);
        else if (MK_CHECK && p >= 2 && (p - 2) % 16 == 7) hipLaunchKernelGGL((mk_fwd<false, 16>), dim3(grid), dim3(NT), LDS_BYTES, stream, a);
        else hipLaunchKernelGGL((mk_fwd<false, 7>), dim3(grid), dim3(NT), LDS_BYTES, stream, a);
    }
#endif
}
```

```cpp
#include <hip/hip_runtime.h>
#include <hip/hip_cooperative_groups.h>
#include <cstdio>
#include <cstdint>
namespace cg = cooperative_groups;

#define GAS __attribute__((address_space(1)))
#define LAS __attribute__((address_space(3)))

constexpr int M = 16384, D = 1024, FF = 2816, NPROMPT_ROWS = 8192;
constexpr int NADA = 9216, NCOND = 9;
constexpr int ZA_W = 5120, ZB_W = 4096, ZS_W = 64;
constexpr int WINA_N = 5376, WINB_N = 4096, W1A_N = 5632;
constexpr int DIN = 9264;
constexpr float ALPHA = 1.4142135623730951f;
constexpr float LN_EPS = 1e-5f, NORM_EPS = 1e-6f;

constexpr size_t MiB = 1u << 20;
constexpr size_t WS_CTL = 0, CTL_BYTES = 65536;
constexpr size_t WS_ADA = 1 * MiB;
constexpr size_t WS_WT = 2 * MiB, WT_LAYER = 58 * MiB;
constexpr size_t WT_W1A = 0, WT_W1D = WT_W1A + (size_t)W1A_N * D * 2, WT_WINA = WT_W1D + (size_t)D * FF * 2, WT_WINB = WT_WINA + (size_t)WINA_N * D * 2,
                 WT_WBG = WT_WINB + (size_t)WINB_N * D * 2, WT_WBM = WT_WBG + (size_t)D * D * 2, WT_WO = WT_WBM + (size_t)D * D * 2,
                 WT_W2A = WT_WO + (size_t)D * D * 2, WT_W2D = WT_W2A + (size_t)W1A_N * D * 2, WT_END = WT_W2D + (size_t)D * FF * 2;
static_assert(WT_END <= WT_LAYER, "weights fit");
constexpr size_t WS_H = 118 * MiB;
constexpr size_t WS_ZS = 150 * MiB;
constexpr size_t WS_ZA = 154 * MiB;
constexpr size_t WS_ZB = 314 * MiB;
constexpr size_t WS_O = 442 * MiB;
constexpr size_t O_STRIDE = 32 * MiB;
constexpr size_t WS_ACT = 570 * MiB;
constexpr size_t WS_PRE = 658 * MiB;
constexpr size_t WS_QKC = 722 * MiB;
constexpr size_t WS_LA = 786 * MiB;
constexpr size_t WS_O2 = WS_ACT;
constexpr size_t WS_ST2 = 850 * MiB;
constexpr size_t WS_END = 960 * MiB;

constexpr size_t OUT_GLA = (size_t)M * D, OUT_MC = OUT_GLA + 16777216ull, OUT_MN = OUT_MC + 33554432ull, OUT_MM = OUT_MN + 131072ull;

typedef unsigned short bf16;
typedef float f32x4 __attribute__((ext_vector_type(4)));
typedef unsigned u32x4 __attribute__((ext_vector_type(4)));
typedef unsigned u32x2 __attribute__((ext_vector_type(2)));

__device__ __forceinline__ unsigned f2bf(float f) { unsigned u = __builtin_bit_cast(unsigned, f); return (u + 0x7fffu + ((u >> 16) & 1u)) >> 16; }
__device__ __forceinline__ unsigned pk2(float lo, float hi) { return f2bf(lo) | (f2bf(hi) << 16); }
__device__ __forceinline__ float bf_lo(unsigned w) { return __builtin_bit_cast(float, w << 16); }
__device__ __forceinline__ float bf_hi(unsigned w) { return __builtin_bit_cast(float, w & 0xffff0000u); }
__device__ __forceinline__ float bf2f(bf16 v) { return __builtin_bit_cast(float, (unsigned)v << 16); }
__device__ __forceinline__ float fast_sigmoid(float x) { return __builtin_amdgcn_rcpf(1.0f + __builtin_amdgcn_exp2f(-1.4426950408889634f * x)); }
__device__ __forceinline__ float fast_silu(float x) { return x * fast_sigmoid(x); }
__device__ __forceinline__ float log_sigmoid(float x) { return fminf(x, 0.f) - log1pf(expf(-fabsf(x))); }
__device__ __forceinline__ float wave_sum(float v) {
#pragma unroll
    for (int o = 1; o < 64; o <<= 1) v += __shfl_xor(v, o);
    return v;
}
__device__ __forceinline__ int cond_of_row(int r) { return r < NPROMPT_ROWS ? 0 : 1 + ((r - NPROMPT_ROWS) >> 10); }

__device__ __forceinline__ int otid() { int t = threadIdx.x; asm volatile("" : "+v"(t)); return t; }

namespace pg8 {
#define PG8_LAS __attribute__((address_space(3)))
typedef unsigned short bf16_t;
typedef short bf16x8 __attribute__((ext_vector_type(8)));
typedef float f32x4 __attribute__((ext_vector_type(4)));
typedef unsigned u32x4 __attribute__((ext_vector_type(4)));
constexpr int BM = 256, BK = 64, HALF = 128, HTB = HALF * BK * 2  , STAGE_BYTES = 8 * HTB, NXCD = 8, WGM = 8;

__host__ __device__ __forceinline__ int lds_byte(int r, int c) { const int st = (r >> 4) * 2 + (c >> 5), rr = r & 15, cc = c & 31, ob = rr * 64 + cc * 2; return st * 1024 + (ob ^ (((ob >> 9) & 1) << 5)); }
__host__ __device__ __forceinline__ void stage_rc(int b, int& R, int& C) { const int st = b / 1024, sb = b % 1024, swz = sb ^ (((sb >> 9) & 1) << 5); R = (st >> 1) * 16 + swz / 64; C = (st & 1) * 32 + (swz % 64) / 2; }
__host__ __device__ __forceinline__ int perm32(int rho) { const int n = rho >> 4, i = rho & 15; return 8 * (i >> 2) + 4 * n + (i & 3); }

struct Unit { int pm, pn; };
struct Gemm { const bf16_t* A; const bf16_t* Bt; int M, N, K; };

struct StaticOrder {
    int nM, nN, nwg, G, c;
    __host__ __device__ void init(int M, int N, int G_, int c_) { nM = M / BM; nN = N / BM; nwg = nM * nN; G = G_; c = c_; }
    __host__ __device__ bool next(int i, Unit& u) const {
        const long L = (long)i * G + c; if (L >= nwg) return false;
        int wgid = (int)L; { const int q = nwg / NXCD, r = nwg % NXCD, xcd = wgid % NXCD, off = wgid / NXCD; wgid = (xcd < r ? xcd * (q + 1) : r * (q + 1) + (xcd - r) * q) + off; }
        const int nig = WGM * nN, gid = wgid / nig, fm = gid * WGM, gsz = (nM - fm) < WGM ? (nM - fm) : WGM;
        u.pm = fm + ((wgid % nig) % gsz); u.pn = (wgid % nig) / gsz; return true;
    }
    __device__ __forceinline__ void a_ready(const Unit&) const {}
    __device__ __forceinline__ void done(const Unit&) const {}
};

__device__ __forceinline__ unsigned cvt_pk_bf16(float lo, float hi) { unsigned r; asm volatile("v_cvt_pk_bf16_f32 %0, %1, %2" : "=v"(r) : "v"(lo), "v"(hi)); return r; }
typedef float f32x2 __attribute__((ext_vector_type(2)));
__device__ __forceinline__ int unit_cond(const Unit& u) { return u.pm < 32 ? 0 : 1 + ((u.pm - 32) >> 2); }
__device__ __forceinline__ float esig(float x) { return __builtin_amdgcn_rcpf(1.0f + __builtin_amdgcn_exp2f(-1.4426950408889634f * x)); }

struct EpiSwiglu {
    static constexpr bool PERM = true, AFTER_DRAIN = false;
    bf16_t* O; int ldc;
    __device__ __forceinline__ void operator()(const f32x4 (&acc)[2][2][4][2], const Unit& u, int wr, int wc, int fr, int fq) const {
        const int row0 = u.pm * BM + wr * 64 + fr, col0 = u.pn * HALF + wc * 32 + 8 * fq;
#pragma unroll
        for (int ai = 0; ai < 2; ++ai)
#pragma unroll
            for (int m = 0; m < 4; ++m) { bf16_t* rowp = O + (size_t)(row0 + ai * HALF + m * 16) * ldc + col0;
                f32x4 v0, v1;
#pragma unroll
                for (int e = 0; e < 4; ++e) { const float g0 = acc[ai][0][m][0][e], g1 = acc[ai][0][m][1][e]; v0[e] = g0 * esig(g0) * acc[ai][1][m][0][e]; v1[e] = g1 * esig(g1) * acc[ai][1][m][1][e]; }
                u32x4 w; w.x = cvt_pk_bf16(v0[0], v0[1]); w.y = cvt_pk_bf16(v0[2], v0[3]); w.z = cvt_pk_bf16(v1[0], v1[1]); w.w = cvt_pk_bf16(v1[2], v1[3]);
                *(u32x4*)rowp = w; }
    }
};
struct EpiPre {
    static constexpr bool PERM = false, AFTER_DRAIN = false;
    const float* X; float* P; const float* gate; float coef;
    __device__ __forceinline__ void operator()(const f32x4 (&acc)[2][2][4][2], const Unit& u, int wr, int wc, int fr, int fq) const {
        const int row0 = u.pm * BM + wr * 64 + fr, col0 = u.pn * BM + wc * 32 + 4 * fq;
        const float* g = gate + (size_t)unit_cond(u) * 9216;
        f32x4 gv[2][2];
#pragma unroll
        for (int bj = 0; bj < 2; ++bj)
#pragma unroll
            for (int n = 0; n < 2; ++n) gv[bj][n] = *(const f32x4*)(g + col0 + bj * HALF + n * 16) * coef;
#pragma unroll
        for (int ai = 0; ai < 2; ++ai)
#pragma unroll
            for (int m = 0; m < 4; ++m) { const size_t off = (size_t)(row0 + ai * HALF + m * 16) * 1024 + col0;
#pragma unroll
                for (int bj = 0; bj < 2; ++bj)
#pragma unroll
                    for (int n = 0; n < 2; ++n) { const f32x4 x = *(const f32x4*)(X + off + bj * HALF + n * 16);
                        *(f32x4*)(P + off + bj * HALF + n * 16) = x * 1.4142135623730951f + gv[bj][n] * acc[ai][bj][m][n]; } }
    }
};
template <int ACTSEL> struct EpiZ {
    static constexpr bool PERM = true, AFTER_DRAIN = false;
    bf16_t* O; int ldc; float* ZS; int nmain;
    __device__ __forceinline__ void operator()(const f32x4 (&acc)[2][2][4][2], const Unit& u, int wr, int wc, int fr, int fq) const {
        const int row0 = u.pm * BM + wr * 64 + fr, col0 = u.pn * BM + wc * 32 + 8 * fq;
        if (ACTSEL == 0 && u.pn >= nmain) {
            if (wc < 2) {
#pragma unroll
                for (int ai = 0; ai < 2; ++ai)
#pragma unroll
                    for (int m = 0; m < 4; ++m) { float* rowp = ZS + (size_t)(row0 + ai * HALF + m * 16) * 64 + wc * 32 + 8 * fq;
                        *(f32x4*)rowp = acc[ai][0][m][0]; *(f32x4*)(rowp + 4) = acc[ai][0][m][1]; }
            }
            return;
        }
#pragma unroll
        for (int ai = 0; ai < 2; ++ai)
#pragma unroll
            for (int m = 0; m < 4; ++m) { bf16_t* rowp = O + (size_t)(row0 + ai * HALF + m * 16) * ldc + col0;
#pragma unroll
                for (int bj = 0; bj < 2; ++bj) { f32x4 v0 = acc[ai][bj][m][0], v1 = acc[ai][bj][m][1];
                    if (ACTSEL == 1) {
                        if (u.pn < 4) {
#pragma unroll
                            for (int e = 0; e < 4; ++e) { v0[e] = v0[e] * esig(v0[e]); v1[e] = v1[e] * esig(v1[e]); }
                        } else {
#pragma unroll
                            for (int e = 0; e < 4; ++e) { v0[e] = esig(v0[e]); v1[e] = esig(v1[e]); }
                        }
                    }
                    u32x4 w; w.x = cvt_pk_bf16(v0[0], v0[1]); w.y = cvt_pk_bf16(v0[2], v0[3]); w.z = cvt_pk_bf16(v1[0], v1[1]); w.w = cvt_pk_bf16(v1[2], v1[3]);
                    *(u32x4*)(rowp + bj * HALF) = w; } }
    }
};
template <bool ADD> struct EpiBranch {
    static constexpr bool PERM = true, AFTER_DRAIN = false;
    const bf16_t* G; int ldg; const bf16_t* T; bf16_t* O;
    __device__ __forceinline__ void operator()(const f32x4 (&acc)[2][2][4][2], const Unit& u, int wr, int wc, int fr, int fq) const {
        const int row0 = u.pm * BM + wr * 64 + fr, col0 = u.pn * BM + wc * 32 + 8 * fq;
#pragma unroll
        for (int ai = 0; ai < 2; ++ai)
#pragma unroll
            for (int m = 0; m < 4; ++m) { const size_t r = (size_t)(row0 + ai * HALF + m * 16);
#pragma unroll
                for (int bj = 0; bj < 2; ++bj) {
                    const u32x4 gw = *(const u32x4*)(G + r * ldg + col0 + bj * HALF);
                    f32x4 v0 = acc[ai][bj][m][0], v1 = acc[ai][bj][m][1];
                    v0[0] *= __builtin_bit_cast(float, gw.x << 16); v0[1] *= __builtin_bit_cast(float, gw.x & 0xffff0000u);
                    v0[2] *= __builtin_bit_cast(float, gw.y << 16); v0[3] *= __builtin_bit_cast(float, gw.y & 0xffff0000u);
                    v1[0] *= __builtin_bit_cast(float, gw.z << 16); v1[1] *= __builtin_bit_cast(float, gw.z & 0xffff0000u);
                    v1[2] *= __builtin_bit_cast(float, gw.w << 16); v1[3] *= __builtin_bit_cast(float, gw.w & 0xffff0000u);
                    if (ADD) { const u32x4 tw = *(const u32x4*)(T + r * 1024 + col0 + bj * HALF);
                        v0[0] += __builtin_bit_cast(float, tw.x << 16); v0[1] += __builtin_bit_cast(float, tw.x & 0xffff0000u);
                        v0[2] += __builtin_bit_cast(float, tw.y << 16); v0[3] += __builtin_bit_cast(float, tw.y & 0xffff0000u);
                        v1[0] += __builtin_bit_cast(float, tw.z << 16); v1[1] += __builtin_bit_cast(float, tw.z & 0xffff0000u);
                        v1[2] += __builtin_bit_cast(float, tw.w << 16); v1[3] += __builtin_bit_cast(float, tw.w & 0xffff0000u); }
                    u32x4 w; w.x = cvt_pk_bf16(v0[0], v0[1]); w.y = cvt_pk_bf16(v0[2], v0[3]); w.z = cvt_pk_bf16(v1[0], v1[1]); w.w = cvt_pk_bf16(v1[2], v1[3]);
                    *(u32x4*)(O + r * 1024 + col0 + bj * HALF) = w; } }
    }
};

template <class Epi, class Sched, bool ALIGN_EPI = false, bool SP2 = false>
__device__ __forceinline__ void gemm_phase(PG8_LAS unsigned char* lds, const Gemm g, const Sched& S, const Epi& E) {
    int tid_ = threadIdx.x; asm volatile("" : "+v"(tid_)); const int tid = tid_, wid = __builtin_amdgcn_readfirstlane(tid >> 6), lane = tid & 63, wr = wid >> 2, wc = wid & 3, fr = lane & 15, fq = lane >> 4;
    const int K = g.K, nt = K / BK;
    unsigned voffA[2], voffB[2];
#pragma unroll
    for (int i = 0; i < 2; ++i) { int R, C; stage_rc(tid * 16 + i * 8192, R, C); const int Rb = Epi::PERM ? ((R & ~31) + perm32(R & 31)) : R;
        voffA[i] = (unsigned)(R * K + C) * 2u; voffB[i] = (unsigned)(Rb * K + C) * 2u; }
    const size_t kstep = (size_t)(BK * 2);
    const size_t hstep = (size_t)HALF * K * 2;
    const size_t tstep = 2 * hstep;
    const unsigned ldsw = (unsigned)wid * 1024u;
    const int aoff = lds_byte(wr * 64 + fr, fq * 8), boff = lds_byte(wc * 32 + fr, fq * 8);
#define PG8_SA(b, h) (((b) * 2 + (h)) * HTB)
#define PG8_SB(b, h) ((4 + (b) * 2 + (h)) * HTB)
#define PG8_STAGE(bufoff, gbase, voff) do { _Pragma("unroll") for (int _i = 0; _i < 2; ++_i) \
        __builtin_amdgcn_global_load_lds((const unsigned*)((const char*)(gbase) + (voff)[_i]), (PG8_LAS unsigned*)(lds + (bufoff) + ldsw + _i * 8192), 16, 0, 0); } while (0)
#define PG8_LDA(dst, b, h) do { _Pragma("unroll") for (int m = 0; m < 4; ++m) _Pragma("unroll") for (int k = 0; k < 2; ++k) dst[m][k] = *(const PG8_LAS bf16x8*)(lds + PG8_SA(b, h) + aoff + m * 2048 + k * 1024); } while (0)
#define PG8_LDB(dst, b, h) do { _Pragma("unroll") for (int n = 0; n < 2; ++n) _Pragma("unroll") for (int k = 0; k < 2; ++k) dst[n][k] = *(const PG8_LAS bf16x8*)(lds + PG8_SB(b, h) + boff + n * 2048 + k * 1024); } while (0)
#define PG8_MMA(ai, bj, At, Bt) do { __builtin_amdgcn_s_setprio(1); _Pragma("unroll") for (int m = 0; m < 4; ++m) _Pragma("unroll") for (int n = 0; n < 2; ++n) _Pragma("unroll") for (int k = 0; k < 2; ++k) \
        acc[ai][bj][m][n] = __builtin_amdgcn_mfma_f32_16x16x32_bf16(Bt[n][k], At[m][k], acc[ai][bj][m][n], 0, 0, 0); __builtin_amdgcn_s_setprio(0); } while (0)
#define PG8_WAIT_V(n) asm volatile("s_waitcnt vmcnt(" #n ")" ::: "memory")
#define PG8_WAIT_L(n) asm volatile("s_waitcnt lgkmcnt(" #n ")" ::: "memory")
#define PG8_BAR __builtin_amdgcn_s_barrier()
#define PG8_SCHED __builtin_amdgcn_sched_barrier(0)
    Unit cur, nxt; int ui = 0;
    if (!S.next(0, cur)) return;
    f32x4 acc[2][2][4][2];
#pragma unroll
    for (int a = 0; a < 2; ++a)
#pragma unroll
        for (int b = 0; b < 2; ++b)
#pragma unroll
            for (int m = 0; m < 4; ++m)
#pragma unroll
                for (int n = 0; n < 2; ++n) acc[a][b][m][n] = (f32x4){0.f, 0.f, 0.f, 0.f};
    bf16x8 At[4][2], B0[2][2], B1[2][2];
    const char* cA = (const char*)g.A + (size_t)cur.pm * tstep; const char* cB = (const char*)g.Bt + (size_t)cur.pn * tstep;
    S.a_ready(cur);
    if constexpr (SP2) {
        PG8_STAGE(PG8_SB(0, 0), cB, voffB); PG8_STAGE(PG8_SB(0, 1), cB + hstep, voffB); PG8_STAGE(PG8_SA(0, 0), cA, voffA); PG8_STAGE(PG8_SA(0, 1), cA + hstep, voffA);
        if (wr == 1) PG8_BAR;
        PG8_WAIT_V(2); PG8_BAR;
        PG8_STAGE(PG8_SB(1, 0), cB + kstep, voffB); PG8_STAGE(PG8_SA(1, 0), cA + kstep, voffA); PG8_STAGE(PG8_SB(1, 1), cB + hstep + kstep, voffB);
        PG8_WAIT_V(6); PG8_BAR;
    } else {
        PG8_STAGE(PG8_SB(0, 0), cB, voffB); PG8_STAGE(PG8_SA(0, 0), cA, voffA); PG8_STAGE(PG8_SB(0, 1), cB + hstep, voffB); PG8_STAGE(PG8_SA(0, 1), cA + hstep, voffA);
        if (wr == 1) PG8_BAR;
        PG8_WAIT_V(4); PG8_BAR;
        PG8_STAGE(PG8_SB(1, 0), cB + kstep, voffB); PG8_STAGE(PG8_SA(1, 0), cA + kstep, voffA); PG8_STAGE(PG8_SB(1, 1), cB + hstep + kstep, voffB);
        PG8_WAIT_V(6); PG8_BAR;
    }
    for (;;) {
        const bool has_next = S.next(ui + 1, nxt);
        const char* nA = has_next ? (const char*)g.A + (size_t)nxt.pm * tstep : cA; const char* nB = has_next ? (const char*)g.Bt + (size_t)nxt.pn * tstep : cB;
        for (int t = 0; t < nt; t += 2) {
            const bool last = (t == nt - 2);
            const char* a1 = cA + (size_t)(t + 1) * kstep;
            const char* a2 = last ? nA : cA + (size_t)(t + 2) * kstep; const char* b2 = last ? nB : cB + (size_t)(t + 2) * kstep;
            const char* a3 = a2 + kstep; const char* b3 = b2 + kstep;
            if (last && has_next) S.a_ready(nxt);
            if constexpr (SP2) {
            PG8_LDB(B0, 0, 0); PG8_LDB(B1, 0, 1); PG8_SCHED; PG8_LDA(At, 0, 0); PG8_STAGE(PG8_SA(1, 1), a1 + hstep, voffA);
            PG8_WAIT_V(8); PG8_WAIT_L(0); PG8_BAR; PG8_MMA(0, 0, At, B0); PG8_MMA(0, 1, At, B1); PG8_BAR; PG8_SCHED;
            PG8_LDA(At, 0, 1); PG8_STAGE(PG8_SB(0, 0), b2, voffB); PG8_STAGE(PG8_SB(0, 1), b2 + hstep, voffB); PG8_STAGE(PG8_SA(0, 0), a2, voffA);
            PG8_WAIT_V(8); PG8_WAIT_L(0); PG8_BAR; PG8_MMA(1, 0, At, B0); PG8_MMA(1, 1, At, B1); PG8_BAR; PG8_SCHED;
            PG8_LDB(B0, 1, 0); PG8_LDB(B1, 1, 1); PG8_SCHED; PG8_LDA(At, 1, 0); PG8_STAGE(PG8_SA(0, 1), a2 + hstep, voffA);
            PG8_WAIT_V(8); PG8_WAIT_L(0); PG8_BAR; PG8_MMA(0, 0, At, B0); PG8_MMA(0, 1, At, B1); PG8_BAR; PG8_SCHED;
            PG8_LDA(At, 1, 1); PG8_STAGE(PG8_SB(1, 0), b3, voffB); PG8_STAGE(PG8_SB(1, 1), b3 + hstep, voffB); PG8_STAGE(PG8_SA(1, 0), a3, voffA);
            PG8_WAIT_V(8); PG8_WAIT_L(0); PG8_BAR; PG8_MMA(1, 0, At, B0); PG8_MMA(1, 1, At, B1); PG8_BAR; PG8_SCHED;
            } else {
            PG8_LDB(B0, 0, 0); PG8_SCHED; PG8_LDA(At, 0, 0); PG8_STAGE(PG8_SA(1, 1), a1 + hstep, voffA);
            PG8_WAIT_L(8); PG8_BAR; PG8_WAIT_L(0); PG8_MMA(0, 0, At, B0); PG8_BAR; PG8_SCHED;
            PG8_LDB(B1, 0, 1); PG8_STAGE(PG8_SB(0, 0), b2, voffB);
            PG8_BAR; PG8_WAIT_L(0); PG8_MMA(0, 1, At, B1); PG8_BAR;
            PG8_LDA(At, 0, 1); PG8_STAGE(PG8_SA(0, 0), a2, voffA);
            PG8_BAR; PG8_WAIT_L(0); PG8_MMA(1, 0, At, B0); PG8_BAR; PG8_SCHED;
            PG8_STAGE(PG8_SB(0, 1), b2 + hstep, voffB);
            PG8_WAIT_V(6); PG8_BAR; PG8_MMA(1, 1, At, B1); PG8_BAR;
            PG8_LDB(B0, 1, 0); PG8_SCHED; PG8_LDA(At, 1, 0); PG8_STAGE(PG8_SA(0, 1), a2 + hstep, voffA);
            PG8_WAIT_L(8); PG8_BAR; PG8_WAIT_L(0); PG8_MMA(0, 0, At, B0); PG8_BAR; PG8_SCHED;
            PG8_LDB(B1, 1, 1); PG8_STAGE(PG8_SB(1, 0), b3, voffB);
            PG8_BAR; PG8_WAIT_L(0); PG8_MMA(0, 1, At, B1); PG8_BAR;
            PG8_LDA(At, 1, 1); PG8_STAGE(PG8_SA(1, 0), a3, voffA);
            PG8_BAR; PG8_WAIT_L(0); PG8_MMA(1, 0, At, B0); PG8_BAR; PG8_SCHED;
            PG8_STAGE(PG8_SB(1, 1), b3 + hstep, voffB);
            PG8_WAIT_V(6); PG8_BAR; PG8_MMA(1, 1, At, B1); PG8_BAR;
            }
        }
        if constexpr (ALIGN_EPI) { if (wr == 0) PG8_BAR; }
        if constexpr (!Epi::AFTER_DRAIN) { E(acc, cur, wr, wc, fr, fq); S.done(cur); }
        if (!has_next) break;
#pragma unroll
        for (int a = 0; a < 2; ++a)
#pragma unroll
            for (int b = 0; b < 2; ++b)
#pragma unroll
                for (int m = 0; m < 4; ++m)
#pragma unroll
                    for (int n = 0; n < 2; ++n) acc[a][b][m][n] = (f32x4){0.f, 0.f, 0.f, 0.f};
        cur = nxt; cA = nA; cB = nB; ++ui;
        if constexpr (ALIGN_EPI) { if (wr == 1) PG8_BAR; }
    }
    PG8_WAIT_V(0);
    if constexpr (!ALIGN_EPI) { if (wr == 0) PG8_BAR; }
    PG8_BAR;
    if constexpr (Epi::AFTER_DRAIN) { E.fused(acc, cur, wr, wc, fr, fq, lds, wid, lane); S.done(cur); }
#undef PG8_SA
#undef PG8_SB
#undef PG8_STAGE
#undef PG8_LDA
#undef PG8_LDB
#undef PG8_MMA
#undef PG8_WAIT_V
#undef PG8_WAIT_L
#undef PG8_BAR
#undef PG8_SCHED
}
}

#ifndef SSEL
#define SSEL 3
#endif
struct Args { const float* in[29]; float* out; unsigned char* ws; int ph_lo, ph_hi; };
constexpr int PTR_OFF = 131072 + 1024, XBST_OFF = 131072 + 2048;
struct Ctx { LAS unsigned char* lds; float* out; unsigned char* ws;
    __device__ __forceinline__ const float* in(int i) const { const LAS unsigned* p = (const LAS unsigned*)(lds + PTR_OFF) + 2 * i;
        const unsigned lo = __builtin_amdgcn_readfirstlane(p[0]), hi = __builtin_amdgcn_readfirstlane(p[1]); return (const float*)(((unsigned long long)hi << 32) | lo); } };
constexpr int NW = 8, NT = NW * 64;
constexpr int LDS_BYTES = 147456;

__device__ __forceinline__ void transpose_item(const float* src, int srcN, int k0, int n0, int ncols, bf16* dst, int dstK, int dstrow, LAS float* scr, int lane) {
#pragma unroll 8
    for (int i = 0; i < 32; ++i) { const int kk = 2 * i + (lane >> 5), c = lane & 31; scr[kk * 33 + c] = (c < ncols) ? src[(size_t)(k0 + kk) * srcN + n0 + c] : 0.f; }
    asm volatile("s_waitcnt lgkmcnt(0)" ::: "memory");
    const int c = lane & 7;
#pragma unroll
    for (int j = 0; j < 4; ++j) { const int n = (lane >> 3) + 8 * j; const LAS float* s = scr + (8 * c) * 33 + n;
        u32x4 o; o.x = pk2(s[0 * 33], s[1 * 33]); o.y = pk2(s[2 * 33], s[3 * 33]); o.z = pk2(s[4 * 33], s[5 * 33]); o.w = pk2(s[6 * 33], s[7 * 33]);
        if (n < ncols) *(u32x4*)(dst + (size_t)(dstrow + n) * dstK + k0 + 8 * c) = o; }
    asm volatile("s_waitcnt lgkmcnt(0)" ::: "memory");
}
__device__ __forceinline__ void phase_wconv(const Ctx& a, int l, LAS unsigned char* lds) {
    const int tid = otid(), lane = tid & 63, wave = tid >> 6;
    LAS float* scr = (LAS float*)(lds + wave * 16384);
    unsigned char* wt = a.ws + WS_WT + (size_t)l * WT_LAYER;
    const int gw = blockIdx.x * NW + wave, NGW = gridDim.x * NW;
    constexpr int I_1A = 16 * 176, I_1D = 44 * 32, I_INA = 16 * 162, I_INB = 16 * 128, I_SQ = 16 * 32;
    constexpr int NITEMS = 2 * I_1A + 2 * I_1D + I_INA + I_INB + 3 * I_SQ;
    for (int it = gw; it < NITEMS; it += NGW) {
        int r = it;
        if (r < 2 * I_1A) {
            const int f = r / I_1A; r -= f * I_1A; const int kb = r / 176, nb = r % 176, up = nb >= 88, c0 = 32 * (nb - 88 * up);
            const float* src = a.in(f == 0 ? (up ? 11 : 10) : (up ? 25 : 24)) + (size_t)l * D * FF;
            transpose_item(src, FF, 64 * kb, c0, 32, (bf16*)(wt + (f == 0 ? WT_W1A : WT_W2A)), D, 256 * (c0 >> 7) + (c0 & 127) + 128 * up, scr, lane); continue; }
        r -= 2 * I_1A;
        if (r < 2 * I_1D) {
            const int f = r / I_1D; r -= f * I_1D; const int kb = r / 32, nb = r % 32;
            transpose_item(a.in(f == 0 ? 12 : 26) + (size_t)l * FF * D, D, 64 * kb, 32 * nb, 32, (bf16*)(wt + (f == 0 ? WT_W1D : WT_W2D)), FF, 32 * nb, scr, lane); continue; }
        r -= 2 * I_1D;
        if (r < I_INA) { const int kb = r / 162, nb = r % 162; const float* src = a.in(13) + (size_t)l * D * DIN;
            int dr = 32 * nb, sc, nc = 32;
            if (nb < 160) sc = dr < 2048 ? dr : dr + 1056; else if (nb == 160) sc = 3072; else { sc = 7200; nc = 16; }
            transpose_item(src, DIN, 64 * kb, sc, nc, (bf16*)(wt + WT_WINA), D, dr, scr, lane); continue; }
        r -= I_INA;
        if (r < I_INB) { const int kb = r / 128, nb = r % 128; const float* src = a.in(13) + (size_t)l * D * DIN;
            const int dr = 32 * nb, sc = dr < 1024 ? dr + 2048 : (dr < 2048 ? dr + 5152 : dr + 5168);
            transpose_item(src, DIN, 64 * kb, sc, 32, (bf16*)(wt + WT_WINB), D, dr, scr, lane); continue; }
        r -= I_INB;
        { const int f = r / I_SQ; r -= f * I_SQ; const int kb = r / 32, nb = r % 32;
          transpose_item(a.in(21 + f) + (size_t)l * D * D, D, 64 * kb, 32 * nb, 32, (bf16*)(wt + (f == 0 ? WT_WBG : f == 1 ? WT_WBM : WT_WO)), D, 32 * nb, scr, lane); }
    }
}
__device__ __forceinline__ void phase_ada(const Ctx& a, LAS unsigned char* lds) {
    LAS float* sil = (LAS float*)lds;
    LAS float* red = (LAS float*)(lds + 36864);
    const int tid = otid();
    for (int i = tid; i < NCOND * D; i += NT) { const int ci = i >> 10, k = i & 1023; const float v = ci == 0 ? a.in(7)[k] : a.in(2)[(ci - 1) * D + k]; sil[i] = v / (1.f + expf(-v)); }
    __syncthreads();
    float* ada = (float*)(a.ws + WS_ADA);
    const int c = tid & 63, s = tid >> 6;
    for (int it = blockIdx.x; it < 2 * 144; it += gridDim.x) {
        const int l = it / 144, g = it % 144; const float* W = a.in(8) + (size_t)l * D * NADA + 64 * g + c;
        float acc[NCOND];
#pragma unroll
        for (int ci = 0; ci < NCOND; ++ci) acc[ci] = 0.f;
#pragma unroll 4
        for (int k = s; k < D; k += 8) { const float w = W[(size_t)k * NADA];
#pragma unroll
            for (int ci = 0; ci < NCOND; ++ci) acc[ci] += sil[ci * D + k] * w; }
#pragma unroll
        for (int ci = 0; ci < NCOND; ++ci) red[(s * NCOND + ci) * 64 + c] = acc[ci];
        __syncthreads();
        for (int i = tid; i < NCOND * 64; i += NT) { const int ci = i >> 6, cc = i & 63; float sum = a.in(9)[(size_t)l * NADA + 64 * g + cc];
#pragma unroll
            for (int ss = 0; ss < 8; ++ss) sum += red[(ss * NCOND + ci) * 64 + cc];
            ada[((size_t)l * NCOND + ci) * NADA + 64 * g + cc] = sum; }
        __syncthreads();
    }
}
__device__ __forceinline__ void store_mod_row(bf16* hrow, const f32x4 (&v)[4], const float* sh, const float* sc, int lane) {
#pragma unroll
    for (int j = 0; j < 4; ++j) { const f32x4 s = *(const f32x4*)(sc + 256 * j + 4 * lane), t = *(const f32x4*)(sh + 256 * j + 4 * lane);
        const f32x4 h = v[j] * (s + 1.0f) + t; u32x2 w; w.x = pk2(h[0], h[1]); w.y = pk2(h[2], h[3]); *(u32x2*)(hrow + 256 * j + 4 * lane) = w; }
}
__device__ __forceinline__ void phase_xinit(const Ctx& a) {
    const int tid = otid(), lane = tid & 63, gw = blockIdx.x * NW + (tid >> 6), NGW = gridDim.x * NW;
    const float* ada = (const float*)(a.ws + WS_ADA);
    bf16* H = (bf16*)(a.ws + WS_H);
    for (int r = gw; r < M; r += NGW) {
        f32x4 v[4];
        if (r < NPROMPT_ROWS) {
#pragma unroll
            for (int j = 0; j < 4; ++j) v[j] = *(const f32x4*)(a.in(0) + (size_t)r * D + 256 * j + 4 * lane);
        } else {
            const int rs = r - NPROMPT_ROWS, t = rs & 1023; const float gr = (float)(t >> 6), gc = (float)(t & 63);
#pragma unroll
            for (int j = 0; j < 4; ++j) { v[j] = *(const f32x4*)(a.in(1) + (size_t)rs * D + 256 * j + 4 * lane);
#pragma unroll
                for (int e = 0; e < 4; ++e) { const float om = 1.0f / powf(10000.0f, (float)(4 * lane + e) * (1.0f / 256.0f)); const float ang = (j < 2 ? gr : gc) * om;
                    v[j][e] += (j & 1) ? cosf(ang) : sinf(ang); } }
        }
#pragma unroll
        for (int j = 0; j < 4; ++j) *(f32x4*)(a.out + (size_t)r * D + 256 * j + 4 * lane) = v[j];
        const float* ad = ada + (size_t)cond_of_row(r) * NADA;
        store_mod_row(H + (size_t)r * D, v, ad, ad + 1024, lane);
    }
}
__device__ __forceinline__ void phase_ln(const Ctx& a, const float* lng, const float* lnb, const float* mod) {
    const int tid = otid(), lane = tid & 63, gw = blockIdx.x * NW + (tid >> 6), NGW = gridDim.x * NW;
    const float* P = (const float*)(a.ws + WS_PRE);
    bf16* H = (bf16*)(a.ws + WS_H);
    for (int r = gw; r < M; r += NGW) {
        f32x4 v[4]; float s = 0.f;
#pragma unroll
        for (int j = 0; j < 4; ++j) { v[j] = *(const f32x4*)(P + (size_t)r * D + 256 * j + 4 * lane); s += (v[j][0] + v[j][1]) + (v[j][2] + v[j][3]); }
        const float mean = wave_sum(s) * (1.f / D); float s2 = 0.f;
#pragma unroll
        for (int j = 0; j < 4; ++j) { v[j] = v[j] - mean; s2 += (v[j][0] * v[j][0] + v[j][1] * v[j][1]) + (v[j][2] * v[j][2] + v[j][3] * v[j][3]); }
        const float rstd = 1.0f / sqrtf(wave_sum(s2) * (1.f / D) + LN_EPS);
#pragma unroll
        for (int j = 0; j < 4; ++j) { const f32x4 g = *(const f32x4*)(lng + 256 * j + 4 * lane), b = *(const f32x4*)(lnb + 256 * j + 4 * lane);
            v[j] = v[j] * rstd * g + b; *(f32x4*)(a.out + (size_t)r * D + 256 * j + 4 * lane) = v[j]; }
        if (mod) { const float* ad = mod + (size_t)cond_of_row(r) * NADA; store_mod_row(H + (size_t)r * D, v, ad, ad + 1024, lane); }
    }
}
__device__ __forceinline__ void phase_combine(const Ctx& a, int l) {
    const int tid = otid(), lane = tid & 63, gw = blockIdx.x * NW + (tid >> 6), NGW = gridDim.x * NW;
    const bf16* ZB = (const bf16*)(a.ws + WS_ZB);
    for (int r = gw; r < M; r += NGW) {
#pragma unroll
        for (int br = 0; br < 2; ++br) {
            bf16* OF = (bf16*)(a.ws + WS_O + (size_t)(2 * br) * O_STRIDE) + (size_t)r * D; const bf16* OB = (const bf16*)(a.ws + WS_O + (size_t)(2 * br + 1) * O_STRIDE) + (size_t)r * D;
            const float* gam = a.in(19 + br) + l * 256 + 4 * lane; const f32x4 gv = *(const f32x4*)gam;
            const bf16* gate = ZB + (size_t)r * ZB_W + br * 1024;
#pragma unroll
            for (int h = 0; h < 4; ++h) {
                const u32x2 wf = *(const u32x2*)(OF + 256 * h + 4 * lane), wb = *(const u32x2*)(OB + 256 * h + 4 * lane), wg = *(const u32x2*)(gate + 256 * h + 4 * lane);
                f32x4 s; s[0] = bf_lo(wf.x) + bf_lo(wb.x); s[1] = bf_hi(wf.x) + bf_hi(wb.x); s[2] = bf_lo(wf.y) + bf_lo(wb.y); s[3] = bf_hi(wf.y) + bf_hi(wb.y);
                const float ss = wave_sum((s[0] * s[0] + s[1] * s[1]) + (s[2] * s[2] + s[3] * s[3]));
                const float rs = 1.0f / sqrtf(ss * (1.f / 256.f) + NORM_EPS);
                f32x4 o = s * rs * gv; o[0] *= bf_lo(wg.x); o[1] *= bf_hi(wg.x); o[2] *= bf_lo(wg.y); o[3] *= bf_hi(wg.y);
                u32x2 w; w.x = pk2(o[0], o[1]); w.y = pk2(o[2], o[3]); *(u32x2*)(OF + 256 * h + 4 * lane) = w;
            }
        }
    }
}
struct ScanOut { unsigned char* obase; float* gla; float* mc; float* mn; float* mm; int lsel; };
__device__ __forceinline__ void scan_gla_naive(const Ctx& a, const ScanOut& so, int l, int sample, int b, int h, int dir, LAS unsigned char* lds) {
    const int tid = otid(), dv = tid & 255, half = tid >> 8;
    const int T = sample ? 1024 : 256, row0 = sample ? NPROMPT_ROWS + b * 1024 : b * 256;
    const bf16* ZA = (const bf16*)(a.ws + WS_ZA); const float* ZS = (const float*)(a.ws + WS_ZS);
    bf16* OG = (bf16*)(so.obase + (size_t)dir * O_STRIDE);
    LAS float* qs = (LAS float*)lds; LAS float* ks = qs + 16 * 128; LAS float* es = ks + 16 * 128; LAS float* op = es + 16 * 128; LAS float* vs = op + 32 * 256;
    float S[64];
    const size_t sidx = ((((size_t)b * 2 + l) * 2 + dir) * 4 + h) * (128 * 256), sidx2 = (so.lsel < 0 ? ((((size_t)b * 2 + l) * 2 + dir) * 4 + h) : (((size_t)b * 2 + dir) * 4 + h)) * (128 * 256);
    if (sample) {
#pragma unroll
        for (int i = 0; i < 64; ++i) { S[i] = a.in(3)[sidx + (size_t)(half * 64 + i) * 256 + dv]; if ((i & 7) == 7) asm volatile("" ::: "memory"); }
    } else {
#pragma unroll
        for (int i = 0; i < 64; ++i) S[i] = 0.f;
    }
    const int d = tid & 127, jq = tid >> 7;
    float wd[16];
#pragma unroll
    for (int r = 0; r < 16; ++r) wd[r] = a.in(14)[(((size_t)l * 2 + dir) * 16 + r) * 512 + h * 128 + d];
    const float bd = a.in(15)[((size_t)l * 2 + dir) * 512 + h * 128 + d];
#pragma unroll 1
    for (int t0 = 0; t0 < T; t0 += 16) {
        __syncthreads();
#pragma unroll 1
        for (int i = 0; i < 4; ++i) { const int j = jq + 4 * i, tok = dir ? T - 1 - (t0 + j) : t0 + j; const size_t r = (size_t)(row0 + tok);
            float x = bd;
#pragma unroll
            for (int q4 = 0; q4 < 4; ++q4) { const f32x4 av = *(const f32x4*)(ZS + r * 64 + dir * 16 + 4 * q4); x += av[0] * wd[4 * q4] + av[1] * wd[4 * q4 + 1] + av[2] * wd[4 * q4 + 2] + av[3] * wd[4 * q4 + 3]; }
            es[j * 128 + d] = expf(log_sigmoid(x) * (1.f / 16.f));
            qs[j * 128 + d] = bf2f(ZA[r * ZA_W + h * 128 + d]) * 0.08838834764831845f;
            ks[j * 128 + d] = bf2f(ZA[r * ZA_W + 512 + h * 128 + d]); }
#pragma unroll 2
        for (int jj = 0; jj < 8; ++jj) { const int j = half * 8 + jj; const int tok = dir ? T - 1 - (t0 + j) : t0 + j; vs[j * 256 + dv] = bf2f(ZA[(size_t)(row0 + tok) * ZA_W + 1024 + h * 256 + dv]); }
        __syncthreads();
#pragma unroll 1
        for (int j = 0; j < 16; ++j) { float acc = 0.f; const float vj = vs[j * 256 + dv];
#pragma unroll
            for (int i4 = 0; i4 < 16; ++i4) { const int dk = half * 64 + 4 * i4; const f32x4 e4 = *(const LAS f32x4*)(es + j * 128 + dk), k4 = *(const LAS f32x4*)(ks + j * 128 + dk), q4 = *(const LAS f32x4*)(qs + j * 128 + dk);
#pragma unroll
                for (int e = 0; e < 4; ++e) { S[4 * i4 + e] = e4[e] * S[4 * i4 + e] + k4[e] * vj; acc += q4[e] * S[4 * i4 + e]; }
                asm volatile("" ::: "memory"); }
            op[(half * 16 + j) * 256 + dv] = acc; }
        __syncthreads();
#pragma unroll 2
        for (int jj = 0; jj < 8; ++jj) { const int j = half * 8 + jj; const int tok = dir ? T - 1 - (t0 + j) : t0 + j; OG[(size_t)(row0 + tok) * D + h * 256 + dv] = (bf16)f2bf(op[j * 256 + dv] + op[(16 + j) * 256 + dv]); }
    }
    if (!sample) {
#pragma unroll
        for (int i = 0; i < 64; ++i) { so.gla[sidx2 + (size_t)(half * 64 + i) * 256 + dv] = S[i]; if ((i & 7) == 7) asm volatile("" ::: "memory"); }
    }
}
__device__ __forceinline__ void scan_mlstm_naive(const Ctx& a, const ScanOut& so, int l, int sample, int b, int h, int dir, LAS unsigned char* lds) {
    const int tid = otid(), dv = tid & 255, half = tid >> 8, lane = tid & 63, wave = tid >> 6;
    const int T = sample ? 1024 : 256, row0 = sample ? NPROMPT_ROWS + b * 1024 : b * 256;
    const bf16* ZA = (const bf16*)(a.ws + WS_ZA); const float* ZS = (const float*)(a.ws + WS_ZS);
    bf16* OM = (bf16*)(so.obase + (size_t)(2 + dir) * O_STRIDE);
    LAS float* qs = (LAS float*)lds; LAS float* ks = qs + 16 * 256; LAS float* op = ks + 16 * 256; LAS float* qnp = op + 32 * 256; LAS float* gt = qnp + 16 * 256; LAS float* vs = gt + 128;
    float C[128];
    const size_t hidx = (((size_t)b * 2 + l) * 2 + dir) * 4 + h, hidx2 = so.lsel < 0 ? ((((size_t)b * 2 + l) * 2 + dir) * 4 + h) : (((size_t)b * 2 + dir) * 4 + h);
    float n = 0.f, m = 0.f;
    if (sample) {
#pragma unroll
        for (int i = 0; i < 128; ++i) { C[i] = a.in(4)[hidx * 65536 + (size_t)(half * 128 + i) * 256 + dv]; if ((i & 7) == 7) asm volatile("" ::: "memory"); }
        if (tid < 256) n = a.in(5)[hidx * 256 + tid];
        m = a.in(6)[hidx];
    } else {
#pragma unroll
        for (int i = 0; i < 128; ++i) C[i] = 0.f;
    }
    const int chan = (tid < 256) ? h * 256 + tid : 1024 + h * 256 + (tid - 256);
    const float w0 = a.in(16)[((size_t)l * 3 + 0) * 2048 + chan], w1 = a.in(16)[((size_t)l * 3 + 1) * 2048 + chan], w2 = a.in(16)[((size_t)l * 3 + 2) * 2048 + chan], bc = a.in(17)[(size_t)l * 2048 + chan];
    const float fb = a.in(18)[((size_t)l * 2 + dir) * 4 + h];
#pragma unroll 1
    for (int t0 = 0; t0 < T; t0 += 16) {
        __syncthreads();
#pragma unroll 2
        for (int j = 0; j < 16; ++j) { const int tok = dir ? T - 1 - (t0 + j) : t0 + j; const bf16* zp = ZA + (size_t)(row0 + tok) * ZA_W + 2048 + chan;
            const float zc = bf2f(zp[0]), zm = tok > 0 ? bf2f(zp[-ZA_W]) : 0.f, zn = tok < T - 1 ? bf2f(zp[ZA_W]) : 0.f;
            const float x = w0 * zm + w1 * zc + w2 * zn + bc; const float sv = x / (1.f + expf(-x));
            if (tid < 256) qs[j * 256 + tid] = sv * 0.0625f; else ks[j * 256 + tid - 256] = sv; }
        if (tid == 0) { float mm = m;
            for (int j = 0; j < 16; ++j) { const int tok = dir ? T - 1 - (t0 + j) : t0 + j; const float* zr = ZS + (size_t)(row0 + tok) * 64 + 32 + dir * 8 + h;
                const float ig = zr[0], lf = log_sigmoid(zr[4] + fb); const float mn = fmaxf(lf + mm, ig);
                gt[j] = expf(lf + mm - mn); gt[16 + j] = expf(ig - mn); gt[32 + j] = expf(-mn); mm = mn; }
            gt[64] = mm; }
#pragma unroll 2
        for (int jj = 0; jj < 8; ++jj) { const int j = half * 8 + jj; const int tok = dir ? T - 1 - (t0 + j) : t0 + j; vs[j * 256 + dv] = bf2f(ZA[(size_t)(row0 + tok) * ZA_W + 4096 + h * 256 + dv]); }
        __syncthreads();
        m = gt[64];
#pragma unroll 1
        for (int j = 0; j < 16; ++j) { const float f = gt[j], w = gt[16 + j]; const float kv = w * vs[j * 256 + dv]; float acc = 0.f;
#pragma unroll
            for (int i4 = 0; i4 < 32; ++i4) { const int dk = half * 128 + 4 * i4; const f32x4 k4 = *(const LAS f32x4*)(ks + j * 256 + dk), q4 = *(const LAS f32x4*)(qs + j * 256 + dk);
#pragma unroll
                for (int e = 0; e < 4; ++e) { C[4 * i4 + e] = f * C[4 * i4 + e] + k4[e] * kv; acc += q4[e] * C[4 * i4 + e]; }
                asm volatile("" ::: "memory"); }
            op[(half * 16 + j) * 256 + dv] = acc;
            if (tid < 256) { n = f * n + w * ks[j * 256 + tid]; qnp[j * 256 + tid] = qs[j * 256 + tid] * n; } }
        __syncthreads();
#pragma unroll
        for (int jj = 0; jj < 2; ++jj) { const int j = 2 * wave + jj; const f32x4 p = *(const LAS f32x4*)(qnp + j * 256 + 4 * lane); const float s = wave_sum((p[0] + p[1]) + (p[2] + p[3])); if (lane == 0) gt[48 + j] = s; }
        __syncthreads();
#pragma unroll 2
        for (int jj = 0; jj < 8; ++jj) { const int j = half * 8 + jj; const int tok = dir ? T - 1 - (t0 + j) : t0 + j; const float den = fmaxf(fabsf(gt[48 + j]), gt[32 + j]);
            OM[(size_t)(row0 + tok) * D + h * 256 + dv] = (bf16)f2bf((op[j * 256 + dv] + op[(16 + j) * 256 + dv]) / den); }
    }
    if (!sample) {
#pragma unroll
        for (int i = 0; i < 128; ++i) { so.mc[hidx2 * 65536 + (size_t)(half * 128 + i) * 256 + dv] = C[i]; if ((i & 7) == 7) asm volatile("" ::: "memory"); }
        if (tid < 256) so.mn[hidx2 * 256 + tid] = n;
        if (tid == 0) so.mm[hidx2] = m;
    }
}
__device__ __forceinline__ void phase_scan_naive(const Ctx& a, const ScanOut& so, int l, LAS unsigned char* lds) {
    for (int u = blockIdx.x; u < 640; u += gridDim.x) {
        int kind, sample, v;
        if (u < 64) { kind = 1; sample = 1; v = u; } else if (u < 128) { kind = 0; sample = 1; v = u - 64; } else if (u < 384) { kind = 1; sample = 0; v = u - 128; } else { kind = 0; sample = 0; v = u - 384; }
        const int dir = v & 1, h = (v >> 1) & 3, b = v >> 3;
        if (kind) { if (SSEL & 2) scan_mlstm_naive(a, so, l, sample, b, h, dir, lds); } else { if (SSEL & 1) scan_gla_naive(a, so, l, sample, b, h, dir, lds); }
        __syncthreads();
    }
}


typedef float f32x16 __attribute__((ext_vector_type(16)));
typedef short s16x8 __attribute__((ext_vector_type(8)));
typedef short s16x4 __attribute__((ext_vector_type(4)));
typedef float f32x2_t __attribute__((ext_vector_type(2)));
typedef __bf16 bf16x2_t __attribute__((ext_vector_type(2)));
#define MFMA32(a, b, c) __builtin_amdgcn_mfma_f32_32x32x16_bf16((a), (b), (c), 0, 0, 0)
#define MFMA16(a, b, c) __builtin_amdgcn_mfma_f32_16x16x32_bf16((a), (b), (c), 0, 0, 0)
__device__ __forceinline__ unsigned cvtpk(float lo, float hi) { f32x2_t v = {lo, hi}; bf16x2_t b = __builtin_convertvector(v, bf16x2_t); return __builtin_bit_cast(unsigned, b); }
__device__ __forceinline__ s16x4 vtr(const LAS unsigned char* p) { typedef short v4i16_t __attribute__((ext_vector_type(4))); return __builtin_bit_cast(s16x4, __builtin_amdgcn_ds_read_tr16_b64_v4i16((LAS v4i16_t*)p)); }
__device__ __forceinline__ s16x8 cat8(s16x4 lo, s16x4 hi) { return __builtin_shufflevector(lo, hi, 0, 1, 2, 3, 4, 5, 6, 7); }
__device__ __forceinline__ int crow(int r, int h) { return (r & 3) + 8 * (r >> 2) + 4 * h; }
__device__ __forceinline__ s16x8 pack_step(const f32x16& x, int s) {
    u32x4 p; p.x = cvtpk(x[8 * s + 0], x[8 * s + 1]); p.y = cvtpk(x[8 * s + 2], x[8 * s + 3]); p.z = cvtpk(x[8 * s + 4], x[8 * s + 5]); p.w = cvtpk(x[8 * s + 6], x[8 * s + 7]);
    return __builtin_bit_cast(s16x8, p);
}
__device__ __forceinline__ s16x8 frag_tr(const LAS unsigned char* base, int trofs, int RS) { return cat8(vtr(base + trofs), vtr(base + trofs + 4 * RS)); }
__device__ __forceinline__ s16x8 frag_perm(const LAS unsigned char* p) { return cat8(*(const LAS s16x4*)p, *(const LAS s16x4*)(p + 16)); }

constexpr int SC_CHUNK = 64;
constexpr int ML_RSQ = 528, ML_RSK = 576, ML_RSV = 576, RSP = 144;
constexpr int ML_Q = 0, ML_K = ML_Q + 64 * ML_RSQ, ML_V = ML_K + 64 * ML_RSK, ML_P = ML_V + 64 * ML_RSV, ML_SC = ML_P + 64 * RSP, ML_N = ML_SC + 2048, ML_END = ML_N + 1024;
static_assert(ML_END <= 131072, "mLSTM LDS");
__device__ __forceinline__ void scan_mlstm_fast(const Ctx& a, int l, int sample, int b, int h, int dir, LAS unsigned char* lds) {
    const int tid = otid(), lane = tid & 63, wave = __builtin_amdgcn_readfirstlane(tid >> 6);
    const int T = sample ? 1024 : 256, row0 = sample ? NPROMPT_ROWS + b * 1024 : b * 256;
    const bf16* QKC = (const bf16*)(a.ws + WS_QKC); const bf16* ZA = (const bf16*)(a.ws + WS_ZA); const float* ZS = (const float*)(a.ws + WS_ZS);
    bf16* OM = (bf16*)(a.ws + WS_O + (size_t)(2 + dir) * O_STRIDE);
    LAS float* SC = (LAS float*)(lds + ML_SC); LAS float* NV = (LAS float*)(lds + ML_N);
    LAS float* sR = SC, *sIR = SC + 64, *sEM = SC + 128, *sW = SC + 192, *sDEN = SC + 256, *sQN = SC + 320, *sINT = SC + 384, *sMISC = SC + 448;
    const int hh = lane >> 5, c32 = lane & 31;
    const size_t hidx = (((size_t)b * 2 + l) * 2 + dir) * 4 + h;
    f32x16 C[8];
    if (sample) {
        const float* cp = a.in(4) + hidx * 65536 + 32 * wave + c32;
#pragma unroll
        for (int blk = 0; blk < 8; ++blk) {
#pragma unroll
            for (int r = 0; r < 16; ++r) C[blk][r] = cp[(size_t)(32 * blk + crow(r, hh)) * 256];
            asm volatile("" ::: "memory"); }
        if (tid < 256) NV[tid] = a.in(5)[hidx * 256 + tid];
        if (tid == 0) sMISC[0] = a.in(6)[hidx];
    } else {
#pragma unroll
        for (int blk = 0; blk < 8; ++blk)
#pragma unroll
            for (int r = 0; r < 16; ++r) C[blk][r] = 0.f;
        if (tid < 256) NV[tid] = 0.f;
        if (tid == 0) sMISC[0] = 0.f;
    }
    for (int i = tid; i < 64 * RSP / 4; i += NT) ((LAS unsigned*)(lds + ML_P))[i] = 0u;
    const float fb = a.in(18)[((size_t)l * 2 + dir) * 4 + h];
    __syncthreads();
#pragma unroll 1
    for (int t0 = 0; t0 < T; t0 += SC_CHUNK) {
        int tid_l = tid; asm volatile("" : "+v"(tid_l));
        const int tid = tid_l, lane = tid & 63, hh = lane >> 5, c32 = lane & 31;
        const int i16 = lane & 15, tq = i16 >> 2, tp = i16 & 3, tblk = (lane >> 4) & 1;
        const int trofs_k = (8 * hh + tq) * ML_RSK + (16 * tblk + 4 * tp) * 2;
        const int g16 = lane >> 4;
        {
            u32x4 qv[4], kv[4];
#pragma unroll
            for (int i = 0; i < 4; ++i) { const int idx = tid + NT * i, j = idx >> 5, pc = idx & 31; const int tok = dir ? T - 1 - (t0 + j) : t0 + j; const size_t r = (size_t)(row0 + tok);
                qv[i] = *(const u32x4*)(QKC + r * 2048 + h * 256 + pc * 8); kv[i] = *(const u32x4*)(QKC + r * 2048 + 1024 + h * 256 + pc * 8); }
            if (wave == 0) {
                const int tok = dir ? T - 1 - (t0 + lane) : t0 + lane; const float* zr = ZS + (size_t)(row0 + tok) * 64 + 32 + dir * 8 + h;
                const float ig = zr[0], lf = log_sigmoid(zr[4] + fb); const float mprev = sMISC[0];
                float cum = lf;
#pragma unroll
                for (int o = 1; o < 64; o <<= 1) { const float t = __shfl_up(cum, o); if (lane >= o) cum += t; }
                const float g = ig - cum; float pm = g;
#pragma unroll
                for (int o = 1; o < 64; o <<= 1) { const float t = __shfl_up(pm, o); if (lane >= o) pm = fmaxf(pm, t); }
                const float mj = cum + fmaxf(mprev, pm); const float mnew = __shfl(mj, 63), c63 = __shfl(cum, 63);
                const float r = expf(cum - mj - c63 + mnew), inter = expf(cum + mprev - mj);
                sR[lane] = r; sIR[lane] = inter / r; sINT[lane] = inter; sEM[lane] = expf(-mj); sW[lane] = expf(c63 + g - mnew); sDEN[lane] = 0.f;
                if (lane == 0) { sMISC[1] = expf(c63 + mprev - mnew); sMISC[2] = mnew; }
            }
#pragma unroll
            for (int i = 0; i < 4; ++i) { const int idx = tid + NT * i, j = idx >> 5, pc = idx & 31;
                *(LAS u32x4*)(lds + ML_Q + j * ML_RSQ + pc * 16) = qv[i]; *(LAS u32x4*)(lds + ML_K + j * ML_RSK + pc * 16) = kv[i]; }
        }
        __syncthreads();
        {
#pragma unroll
            for (int i = 0; i < 4; ++i) { const int idx = tid + NT * i, j = idx >> 5, pc = idx & 31; const int tok = dir ? T - 1 - (t0 + j) : t0 + j; const size_t r = (size_t)(row0 + tok);
                const u32x4 v = *(const u32x4*)(ZA + r * ZA_W + 4096 + h * 256 + pc * 8); const float w = sW[j];
                u32x4 o; o.x = cvtpk(bf_lo(v.x) * w, bf_hi(v.x) * w); o.y = cvtpk(bf_lo(v.y) * w, bf_hi(v.y) * w); o.z = cvtpk(bf_lo(v.z) * w, bf_hi(v.z) * w); o.w = cvtpk(bf_lo(v.w) * w, bf_hi(v.w) * w);
                *(LAS u32x4*)(lds + ML_V + j * ML_RSV + pc * 16) = o; }
        }
        {
            const int t = tid >> 3, part = tid & 7; float s = 0.f;
#pragma unroll
            for (int i = 0; i < 4; ++i) { const u32x4 qv = *(const LAS u32x4*)(lds + ML_Q + t * ML_RSQ + part * 64 + i * 16); const f32x4 n0 = *(const LAS f32x4*)(NV + part * 32 + i * 8), n1 = *(const LAS f32x4*)(NV + part * 32 + i * 8 + 4);
                s += bf_lo(qv.x) * n0[0] + bf_hi(qv.x) * n0[1] + bf_lo(qv.y) * n0[2] + bf_hi(qv.y) * n0[3] + bf_lo(qv.z) * n1[0] + bf_hi(qv.z) * n1[1] + bf_lo(qv.w) * n1[2] + bf_hi(qv.w) * n1[3]; }
            s += __shfl_xor(s, 1); s += __shfl_xor(s, 2); s += __shfl_xor(s, 4);
            if (part == 0) sQN[t] = s;
        }
#pragma unroll 1
        for (int bi = wave; bi < 10; bi += 8) {
            int ti, si;
            if (bi < 1) { ti = 0; si = 0; } else if (bi < 3) { ti = 1; si = bi - 1; } else if (bi < 6) { ti = 2; si = bi - 3; } else { ti = 3; si = bi - 6; }
            pg8::f32x4 acc = {0.f, 0.f, 0.f, 0.f};
            const LAS unsigned char* ka = lds + ML_K + (16 * si + i16) * ML_RSK + g16 * 16; const LAS unsigned char* qb = lds + ML_Q + (16 * ti + i16) * ML_RSQ + g16 * 16;
#pragma unroll
            for (int ks = 0; ks < 8; ++ks) acc = MFMA16(*(const LAS s16x8*)(ka + ks * 64), *(const LAS s16x8*)(qb + ks * 64), acc);
            const int t = 16 * ti + i16, s0 = 16 * si + 4 * g16; float dsum = 0.f;
#pragma unroll
            for (int i = 0; i < 4; ++i) { if (s0 + i > t) acc[i] = 0.f; dsum += acc[i] * sW[s0 + i]; }
            u32x2 pw; pw.x = cvtpk(acc[0], acc[1]); pw.y = cvtpk(acc[2], acc[3]);
            *(LAS u32x2*)(lds + ML_P + t * RSP + s0 * 2) = pw;
            __hip_atomic_fetch_add(sDEN + t, dsum, __ATOMIC_RELAXED, __HIP_MEMORY_SCOPE_WORKGROUP);
        }
        f32x16 Z[2];
#pragma unroll
        for (int r = 0; r < 16; ++r) { Z[0][r] = 0.f; Z[1][r] = 0.f; }
#pragma unroll
        for (int blk = 0; blk < 8; ++blk)
#pragma unroll
            for (int s = 0; s < 2; ++s) { const s16x8 cf = pack_step(C[blk], s);
#pragma unroll
                for (int tb = 0; tb < 2; ++tb) Z[tb] = MFMA32(cf, frag_perm(lds + ML_Q + (32 * tb + c32) * ML_RSQ + (32 * blk + 16 * s + 4 * hh) * 2), Z[tb]);
                asm volatile("" ::: "memory"); }
#pragma unroll
        for (int tb = 0; tb < 2; ++tb) { const float ir = sIR[32 * tb + c32];
#pragma unroll
            for (int r = 0; r < 16; ++r) Z[tb][r] *= ir; }
        __syncthreads();
        s16x8 vf[4];
#pragma unroll
        for (int ks = 0; ks < 4; ++ks) vf[ks] = frag_tr(lds + ML_V + (16 * ks) * ML_RSV + (32 * wave) * 2, trofs_k, ML_RSV);
#pragma unroll
        for (int tb = 0; tb < 2; ++tb)
#pragma unroll
            for (int ks = 0; ks < 2 + 2 * tb; ++ks) Z[tb] = MFMA32(vf[ks], *(const LAS s16x8*)(lds + ML_P + (32 * tb + c32) * RSP + (16 * ks + 8 * hh) * 2), Z[tb]);
#pragma unroll
        for (int tb = 0; tb < 2; ++tb) { const int j = 32 * tb + c32; const float r = sR[j]; const float den = fmaxf(fabsf(r * sDEN[j] + sINT[j] * sQN[j]), sEM[j]); const float sc = r / den;
            const int tok = dir ? T - 1 - (t0 + j) : t0 + j; bf16* op = OM + (size_t)(row0 + tok) * D + h * 256 + 32 * wave + 4 * hh;
#pragma unroll
            for (int g = 0; g < 4; ++g) { u32x2 w; w.x = cvtpk(Z[tb][4 * g] * sc, Z[tb][4 * g + 1] * sc); w.y = cvtpk(Z[tb][4 * g + 2] * sc, Z[tb][4 * g + 3] * sc); *(u32x2*)(op + 8 * g) = w; } }
        {
            const float decay = sMISC[1];
#pragma unroll
            for (int blk = 0; blk < 8; ++blk) {
#pragma unroll
                for (int r = 0; r < 16; ++r) C[blk][r] *= decay;
#pragma unroll
                for (int ks = 0; ks < 4; ++ks) C[blk] = MFMA32(frag_tr(lds + ML_K + (16 * ks) * ML_RSK + (32 * blk) * 2, trofs_k, ML_RSK), vf[ks], C[blk]);
                asm volatile("" ::: "memory"); }
            if (tid < 256) { float n = NV[tid] * decay;
#pragma unroll 8
                for (int s = 0; s < 64; ++s) n += sW[s] * bf2f(*(const LAS bf16*)(lds + ML_K + s * ML_RSK + tid * 2));
                NV[tid] = n; }
            if (tid == 0) sMISC[0] = sMISC[2];
        }
        __syncthreads();
    }
    if (!sample) {
        float* cp = a.out + OUT_MC + hidx * 65536 + 32 * wave + c32;
#pragma unroll
        for (int blk = 0; blk < 8; ++blk) {
#pragma unroll
            for (int r = 0; r < 16; ++r) cp[(size_t)(32 * blk + crow(r, hh)) * 256] = C[blk][r];
            asm volatile("" ::: "memory"); }
        if (tid < 256) a.out[OUT_MN + hidx * 256 + tid] = NV[tid];
        if (tid == 0) a.out[OUT_MM + hidx] = sMISC[0];
    }
    __syncthreads();
}
constexpr int GL_RSQ = 272, GL_RSK = 320, GL_RSV = 576;
constexpr int GL_Q = 0, GL_K = GL_Q + 64 * GL_RSQ, GL_V = GL_K + 64 * GL_RSK, GL_P = GL_V + 64 * GL_RSV, GL_E = GL_P + 64 * RSP, GL_TOT = GL_E + 512, GL_END = GL_TOT + 2048;
__device__ __forceinline__ void scan_gla_fast(const Ctx& a, int l, int sample, int b, int h, int dir, LAS unsigned char* lds) {
    const int tid = otid(), lane = tid & 63, wave = __builtin_amdgcn_readfirstlane(tid >> 6);
    const int T = sample ? 1024 : 256, row0 = sample ? NPROMPT_ROWS + b * 1024 : b * 256;
    const bf16* ZA = (const bf16*)(a.ws + WS_ZA); const float* LA = (const float*)(a.ws + WS_LA) + (size_t)dir * M * 512;
    bf16* OG = (bf16*)(a.ws + WS_O + (size_t)dir * O_STRIDE);
    LAS float* sE = (LAS float*)(lds + GL_E); LAS float* sTOT = (LAS float*)(lds + GL_TOT);
    const int hh = lane >> 5, c32 = lane & 31;
    const size_t sidx = ((((size_t)b * 2 + l) * 2 + dir) * 4 + h) * (128 * 256);
    f32x16 S[4];
    if (sample) {
        const float* sp = a.in(3) + sidx + 32 * wave + c32;
#pragma unroll
        for (int blk = 0; blk < 4; ++blk) {
#pragma unroll
            for (int r = 0; r < 16; ++r) S[blk][r] = sp[(size_t)(32 * blk + crow(r, hh)) * 256];
            asm volatile("" ::: "memory"); }
    } else {
#pragma unroll
        for (int blk = 0; blk < 4; ++blk)
#pragma unroll
            for (int r = 0; r < 16; ++r) S[blk][r] = 0.f;
    }
    for (int i = tid; i < 64 * RSP / 4; i += NT) ((LAS unsigned*)(lds + GL_P))[i] = 0u;
    __syncthreads();
#pragma unroll 1
    for (int t0 = 0; t0 < T; t0 += SC_CHUNK) {
        int tid_l = tid; asm volatile("" : "+v"(tid_l));
        const int tid = tid_l, lane = tid & 63, hh = lane >> 5, c32 = lane & 31;
        const int i16 = lane & 15, tq = i16 >> 2, tp = i16 & 3, tblk = (lane >> 4) & 1;
        const int trofs_k = (8 * hh + tq) * GL_RSK + (16 * tblk + 4 * tp) * 2, trofs_v = (8 * hh + tq) * GL_RSV + (16 * tblk + 4 * tp) * 2;
        const int g16 = lane >> 4;
        const int d = tid & 127, seg = tid >> 7;
        u32x4 vv[4];
#pragma unroll
        for (int i = 0; i < 4; ++i) { const int idx = tid + NT * i, j = idx >> 5, pc = idx & 31; const int tok = dir ? T - 1 - (t0 + j) : t0 + j;
            vv[i] = *(const u32x4*)(ZA + (size_t)(row0 + tok) * ZA_W + 1024 + h * 256 + pc * 8); }
        float cum[16]; float run = 0.f;
#pragma unroll
        for (int i = 0; i < 16; ++i) { const int j = 16 * seg + i; const int tok = dir ? T - 1 - (t0 + j) : t0 + j; run += LA[(size_t)(row0 + tok) * 512 + h * 128 + d]; cum[i] = run; }
        sTOT[seg * 128 + d] = run;
#pragma unroll
        for (int i = 0; i < 4; ++i) { const int idx = tid + NT * i, j = idx >> 5, pc = idx & 31; *(LAS u32x4*)(lds + GL_V + j * GL_RSV + pc * 16) = vv[i]; }
        __syncthreads();
        float offs = 0.f;
#pragma unroll
        for (int s2 = 0; s2 < 3; ++s2) if (s2 < seg) offs += sTOT[s2 * 128 + d];
        if (seg == 3) sE[d] = expf(offs + run);
#pragma unroll
        for (int i = 0; i < 16; ++i) { const int j = 16 * seg + i; const int tok = dir ? T - 1 - (t0 + j) : t0 + j; const bf16* zp = ZA + (size_t)(row0 + tok) * ZA_W + h * 128 + d;
            const float cu = offs + cum[i]; const float e = expf(cu);
            *(LAS bf16*)(lds + GL_Q + j * GL_RSQ + d * 2) = (bf16)f2bf(bf2f(zp[0]) * 0.08838834764831845f * e);
            *(LAS bf16*)(lds + GL_K + j * GL_RSK + d * 2) = (bf16)f2bf(bf2f(zp[512]) / e); }
        __syncthreads();
#pragma unroll 1
        for (int bi = wave; bi < 10; bi += 8) {
            int ti, si;
            if (bi < 1) { ti = 0; si = 0; } else if (bi < 3) { ti = 1; si = bi - 1; } else if (bi < 6) { ti = 2; si = bi - 3; } else { ti = 3; si = bi - 6; }
            pg8::f32x4 acc = {0.f, 0.f, 0.f, 0.f};
            const LAS unsigned char* ka = lds + GL_K + (16 * si + i16) * GL_RSK + g16 * 16; const LAS unsigned char* qb = lds + GL_Q + (16 * ti + i16) * GL_RSQ + g16 * 16;
#pragma unroll
            for (int ks = 0; ks < 4; ++ks) acc = MFMA16(*(const LAS s16x8*)(ka + ks * 64), *(const LAS s16x8*)(qb + ks * 64), acc);
            const int t = 16 * ti + i16, s0 = 16 * si + 4 * g16;
#pragma unroll
            for (int i = 0; i < 4; ++i) if (s0 + i > t) acc[i] = 0.f;
            u32x2 pw; pw.x = cvtpk(acc[0], acc[1]); pw.y = cvtpk(acc[2], acc[3]);
            *(LAS u32x2*)(lds + GL_P + t * RSP + s0 * 2) = pw;
        }
        f32x16 Z[2];
#pragma unroll
        for (int r = 0; r < 16; ++r) { Z[0][r] = 0.f; Z[1][r] = 0.f; }
#pragma unroll
        for (int blk = 0; blk < 4; ++blk)
#pragma unroll
            for (int s = 0; s < 2; ++s) { const s16x8 cf = pack_step(S[blk], s);
#pragma unroll
                for (int tb = 0; tb < 2; ++tb) Z[tb] = MFMA32(cf, frag_perm(lds + GL_Q + (32 * tb + c32) * GL_RSQ + (32 * blk + 16 * s + 4 * hh) * 2), Z[tb]); }
        __syncthreads();
        s16x8 vf[4];
#pragma unroll
        for (int ks = 0; ks < 4; ++ks) vf[ks] = frag_tr(lds + GL_V + (16 * ks) * GL_RSV + (32 * wave) * 2, trofs_v, GL_RSV);
#pragma unroll
        for (int tb = 0; tb < 2; ++tb)
#pragma unroll
            for (int ks = 0; ks < 2 + 2 * tb; ++ks) Z[tb] = MFMA32(vf[ks], *(const LAS s16x8*)(lds + GL_P + (32 * tb + c32) * RSP + (16 * ks + 8 * hh) * 2), Z[tb]);
#pragma unroll
        for (int tb = 0; tb < 2; ++tb) { const int j = 32 * tb + c32; const int tok = dir ? T - 1 - (t0 + j) : t0 + j; bf16* op = OG + (size_t)(row0 + tok) * D + h * 256 + 32 * wave + 4 * hh;
#pragma unroll
            for (int g = 0; g < 4; ++g) { u32x2 w; w.x = cvtpk(Z[tb][4 * g], Z[tb][4 * g + 1]); w.y = cvtpk(Z[tb][4 * g + 2], Z[tb][4 * g + 3]); *(u32x2*)(op + 8 * g) = w; } }
#pragma unroll
        for (int blk = 0; blk < 4; ++blk) {
#pragma unroll
            for (int ks = 0; ks < 4; ++ks) S[blk] = MFMA32(frag_tr(lds + GL_K + (16 * ks) * GL_RSK + (32 * blk) * 2, trofs_k, GL_RSK), vf[ks], S[blk]);
#pragma unroll
            for (int g = 0; g < 4; ++g) { const f32x4 e4 = *(const LAS f32x4*)(sE + 32 * blk + 8 * g + 4 * hh);
#pragma unroll
                for (int e = 0; e < 4; ++e) S[blk][4 * g + e] *= e4[e]; } }
        __syncthreads();
    }
    if (!sample) {
        float* sp = a.out + OUT_GLA + sidx + 32 * wave + c32;
#pragma unroll
        for (int blk = 0; blk < 4; ++blk) {
#pragma unroll
            for (int r = 0; r < 16; ++r) sp[(size_t)(32 * blk + crow(r, hh)) * 256] = S[blk][r];
            asm volatile("" ::: "memory"); }
    }
    __syncthreads();
}
__device__ __forceinline__ void phase_scan_fast(const Ctx& a, int l, LAS unsigned char* lds) {
    for (int u = blockIdx.x; u < 640; u += gridDim.x) {
        int kind, sample, v;
        if (u < 64) { kind = 1; sample = 1; v = u; } else if (u < 128) { kind = 0; sample = 1; v = u - 64; } else if (u < 384) { kind = 1; sample = 0; v = u - 128; } else { kind = 0; sample = 0; v = u - 384; }
        const int dir = v & 1, h = (v >> 1) & 3, b = v >> 3;
        if (kind) scan_mlstm_fast(a, l, sample, b, h, dir, lds); else scan_gla_fast(a, l, sample, b, h, dir, lds);
    }
}
__device__ __forceinline__ void phase_prep(const Ctx& a, int l, LAS unsigned char* lds) {
    const int tid = otid(), lane = tid & 63, gw = blockIdx.x * NW + (tid >> 6), NGW = gridDim.x * NW;
    const bf16* ZA = (const bf16*)(a.ws + WS_ZA); const float* ZS = (const float*)(a.ws + WS_ZS);
    bf16* QKC = (bf16*)(a.ws + WS_QKC); float* LA = (float*)(a.ws + WS_LA);
    LAS float* wd = (LAS float*)lds; LAS float* bd = wd + 2 * 16 * 512;
    for (int i = tid; i < 2 * 16 * 512; i += NT) wd[i] = a.in(14)[(size_t)l * 2 * 16 * 512 + i];
    for (int i = tid; i < 2 * 512; i += NT) bd[i] = a.in(15)[(size_t)l * 2 * 512 + i];
    __syncthreads();
    const float* wc = a.in(16) + (size_t)l * 3 * 2048; const float* bc = a.in(17) + (size_t)l * 2048;
    for (int r = gw; r < M; r += NGW) {
        const int T = r < NPROMPT_ROWS ? 256 : 1024, t = r < NPROMPT_ROWS ? (r & 255) : ((r - NPROMPT_ROWS) & 1023);
#pragma unroll
        for (int j = 0; j < 4; ++j) { const int ch = 512 * j + 8 * lane; const bf16* zp = ZA + (size_t)r * ZA_W + 2048 + ch;
            const u32x4 zc = *(const u32x4*)zp; u32x4 zm = {0u, 0u, 0u, 0u}, zn = {0u, 0u, 0u, 0u};
            if (t > 0) zm = *(const u32x4*)(zp - ZA_W); if (t < T - 1) zn = *(const u32x4*)(zp + ZA_W);
            float o[8];
#pragma unroll
            for (int e = 0; e < 4; ++e) { const unsigned cw = zc[e], mw = zm[e], nw = zn[e];
#pragma unroll
                for (int q = 0; q < 2; ++q) { const int c = ch + 2 * e + q; const float xc = q ? bf_hi(cw) : bf_lo(cw), xm = q ? bf_hi(mw) : bf_lo(mw), xn = q ? bf_hi(nw) : bf_lo(nw);
                    const float x = wc[c] * xm + wc[2048 + c] * xc + wc[4096 + c] * xn + bc[c]; float s = x / (1.f + expf(-x)); if (c < 1024) s *= 0.0625f; o[2 * e + q] = s; } }
            u32x4 w; w.x = pk2(o[0], o[1]); w.y = pk2(o[2], o[3]); w.z = pk2(o[4], o[5]); w.w = pk2(o[6], o[7]);
            *(u32x4*)(QKC + (size_t)r * 2048 + ch) = w; }
        float av[32];
#pragma unroll
        for (int i = 0; i < 8; ++i) { const f32x4 t4 = *(const f32x4*)(ZS + (size_t)r * 64 + 4 * i); av[4 * i] = t4[0]; av[4 * i + 1] = t4[1]; av[4 * i + 2] = t4[2]; av[4 * i + 3] = t4[3]; }
#pragma unroll
        for (int dir = 0; dir < 2; ++dir)
#pragma unroll
            for (int j = 0; j < 2; ++j) { const int c0 = 256 * j + 4 * lane; f32x4 x = *(const LAS f32x4*)(bd + dir * 512 + c0);
#pragma unroll
                for (int k = 0; k < 16; ++k) x += *(const LAS f32x4*)(wd + (dir * 16 + k) * 512 + c0) * av[dir * 16 + k];
                f32x4 o; o[0] = log_sigmoid(x[0]) * 0.0625f; o[1] = log_sigmoid(x[1]) * 0.0625f; o[2] = log_sigmoid(x[2]) * 0.0625f; o[3] = log_sigmoid(x[3]) * 0.0625f;
                *(f32x4*)(LA + ((size_t)dir * M + r) * 512 + c0) = o; }
    }
    __syncthreads();
}

__device__ __forceinline__ void cmp_flush(const Ctx& a, int item, float nu, float de, LAS unsigned char* lds) {
    LAS float* red = (LAS float*)lds; const int tid = threadIdx.x, lane = tid & 63, wave = tid >> 6;
    nu = wave_sum(nu); de = wave_sum(de);
    __syncthreads(); if (lane == 0) { red[2 * wave] = nu; red[2 * wave + 1] = de; } __syncthreads();
    if (tid == 0) { float n2 = 0.f, d2 = 0.f; for (int w = 0; w < NW; ++w) { n2 += red[2 * w]; d2 += red[2 * w + 1]; }
        float* chk = (float*)(a.ws + WS_CTL) + 256; atomicAdd(chk + 2 * item, n2); atomicAdd(chk + 2 * item + 1, d2); }
}
__device__ __forceinline__ void phase_compare(const Ctx& a, int l, LAS unsigned char* lds) {
    const size_t gt = (size_t)blockIdx.x * NT + threadIdx.x, GT = (size_t)gridDim.x * NT;
    for (int ob = 0; ob < 4; ++ob) { const bf16* F = (const bf16*)(a.ws + WS_O + (size_t)ob * O_STRIDE); const bf16* R = (const bf16*)(a.ws + WS_O2 + (size_t)ob * O_STRIDE);
        float nu = 0.f, de = 0.f;
        for (size_t i = gt; i < (size_t)M * D / 2; i += GT) { const unsigned f = ((const unsigned*)F)[i], r = ((const unsigned*)R)[i];
            const float d0 = bf_lo(f) - bf_lo(r), d1 = bf_hi(f) - bf_hi(r); nu += d0 * d0 + d1 * d1; de += bf_lo(r) * bf_lo(r) + bf_hi(r) * bf_hi(r); }
        cmp_flush(a, ob, nu, de, lds); }
    const float* st = (const float*)(a.ws + WS_ST2);
    {   float nu = 0.f, de = 0.f;
        for (size_t c = gt; c < (size_t)32 * 2 * 4 * 32768; c += GT) { const size_t bh = c >> 15, rest = c & 32767, bb = bh >> 3, dh = bh & 7; const float f = a.out[OUT_GLA + (((bb * 2 + l) * 8) + dh) * 32768 + rest], r = st[c]; nu += (f - r) * (f - r); de += r * r; }
        cmp_flush(a, 4, nu, de, lds); }
    {   float nu = 0.f, de = 0.f;
        for (size_t c = gt; c < (size_t)32 * 2 * 4 * 65536; c += GT) { const size_t bh = c >> 16, rest = c & 65535, bb = bh >> 3, dh = bh & 7; const float f = a.out[OUT_MC + (((bb * 2 + l) * 8) + dh) * 65536 + rest], r = st[8388608 + c]; nu += (f - r) * (f - r); de += r * r; }
        cmp_flush(a, 5, nu, de, lds); }
    {   float nu = 0.f, de = 0.f;
        for (size_t c = gt; c < (size_t)32 * 2 * 4 * 256; c += GT) { const size_t bh = c >> 8, rest = c & 255, bb = bh >> 3, dh = bh & 7; const float f = a.out[OUT_MN + (((bb * 2 + l) * 8) + dh) * 256 + rest], r = st[8388608 + 16777216 + c]; nu += (f - r) * (f - r); de += r * r; }
        cmp_flush(a, 6, nu, de, lds); }
    {   float nu = 0.f, de = 0.f;
        for (size_t c = gt; c < (size_t)32 * 2 * 4; c += GT) { const size_t bb = c >> 3, dh = c & 7; const float f = a.out[OUT_MM + ((bb * 2 + l) * 8) + dh], r = st[8388608 + 16777216 + 65536 + c]; nu += (f - r) * (f - r); de += r * r; }
        cmp_flush(a, 7, nu, de, lds); }
}


#define XB_TMO      128
#define XB_XCNT(j)  (256  + 64 * (j))
#define XB_XSUB(j)  (1280 + 64 * (j))
#define XB_XGEN(j)  (2304 + 64 * (j))
#define XB_TOP      3328
#define XB_TOPGEN   3392
#define XCD_BAR_WORDS 3456
#define XB_SPIN_CAP (1u << 18)

__device__ __forceinline__ unsigned xb_ld(unsigned* p)              { return __hip_atomic_load(p, __ATOMIC_RELAXED, __HIP_MEMORY_SCOPE_AGENT); }
__device__ __forceinline__ unsigned xb_add(unsigned* p, unsigned v) { return __hip_atomic_fetch_add(p, v, __ATOMIC_RELAXED, __HIP_MEMORY_SCOPE_AGENT); }
__device__ __forceinline__ unsigned xb_xcc_id() { return (unsigned)__builtin_amdgcn_s_getreg((3 << 11) | 20) & 0xFu; }
#define XB_SPIN(cond, bar) do { unsigned _sp = 0; while (cond) { __builtin_amdgcn_s_sleep(1); \
    if ((++_sp & 255u) == 0u) { if (xb_ld(&(bar)[XB_TMO])) break; if (_sp > XB_SPIN_CAP) { atomicAdd(&(bar)[XB_TMO], 1u); break; } } } } while (0)

struct XcdBarrier {
    unsigned* bar; unsigned x;
    volatile LAS unsigned* st;
};

__device__ __forceinline__ XcdBarrier xcd_barrier_post(unsigned* bar, volatile LAS unsigned* st) {
    XcdBarrier b; b.bar = bar; b.x = xb_xcc_id(); b.st = st;
    if (threadIdx.x == 0) (void)xb_add(&bar[XB_XCNT(b.x)], 1u);
    return b;
}
__device__ __forceinline__ void xcd_barrier_complete(unsigned* bar, unsigned x, unsigned& nloc, unsigned& nx) {
    const unsigned G = gridDim.x * gridDim.y * gridDim.z;
    unsigned sum, cnt, mine, sp = 0u;
    for (;;) {
        sum = 0u; cnt = 0u; mine = 0u;
#pragma unroll
        for (unsigned j = 0; j < 16; ++j) { const unsigned c = xb_ld(&bar[XB_XCNT(j)]); sum += c; cnt += (c > 0u) ? 1u : 0u; mine = (j == x) ? c : mine; }
        if (sum == G) break;
        __builtin_amdgcn_s_sleep(1);
        if ((++sp & 255u) == 0u) { if (xb_ld(&bar[XB_TMO])) break; if (sp > XB_SPIN_CAP) { atomicAdd(&bar[XB_TMO], 1u); break; } }
    }
    nloc = mine > 0u ? mine : 1u; nx = cnt > 0u ? cnt : 1u;
}

__device__ __forceinline__ void xcd_barrier(const XcdBarrier& b) {
    asm volatile("s_waitcnt vmcnt(0)" ::: "memory");
    __syncthreads();
    if (threadIdx.x == 0) {
        unsigned* bar = b.bar;
        __builtin_amdgcn_s_waitcnt(0);
        unsigned nloc = b.st[0], nx = b.st[1];
        if (nloc == 0u) { xcd_barrier_complete(bar, b.x, nloc, nx); b.st[0] = nloc; b.st[1] = nx; }
        const unsigned old = xb_add(&bar[XB_XSUB(b.x)], 1u);
        const unsigned gen = old / nloc;
        if (old + 1u == (gen + 1u) * nloc) {
            __builtin_amdgcn_fence(__ATOMIC_RELEASE, "agent");
            asm volatile("s_waitcnt vmcnt(0)" ::: "memory");
            const unsigned og = xb_add(&bar[XB_TOP], 1u);
            const unsigned tg = og / nx;
            if (og + 1u == (tg + 1u) * nx) xb_add(&bar[XB_TOPGEN], 1u);
            else XB_SPIN(xb_ld(&bar[XB_TOPGEN]) == tg, bar);
            __builtin_amdgcn_fence(__ATOMIC_ACQUIRE, "agent");
            xb_add(&bar[XB_XGEN(b.x)], 1u);
            asm volatile("s_waitcnt vmcnt(0)" ::: "memory");
        } else {
            XB_SPIN(xb_ld(&bar[XB_XGEN(b.x)]) == gen, bar);
            __builtin_amdgcn_fence(__ATOMIC_ACQUIRE, "agent");
            asm volatile("s_waitcnt vmcnt(0)" ::: "memory");
        }
    }
    __syncthreads();
}


template <class Epi> __device__ __forceinline__ void run_gemm(LAS unsigned char* lds, const bf16* A, const bf16* Bt, int N, int K, const Epi& E) {
    pg8::Gemm g{A, Bt, M, N, K}; pg8::StaticOrder S; S.init(M, N, (int)gridDim.x, (int)blockIdx.x);
    pg8::gemm_phase<Epi, pg8::StaticOrder, true, true>(lds, g, S, E);
}
#ifndef GSEL
#define GSEL 0x1ff
#endif
#ifndef MK_CHECK
#define MK_CHECK 0
#endif
#ifndef MK_FAST_SCAN
#define MK_FAST_SCAN 1
#endif
#ifndef MK_CHECK_TOL
#define MK_CHECK_TOL 3e-4f
#endif
constexpr int N_PHASES = 2 + 2 * (MK_CHECK ? 16 : 14);

template <bool COOP, int MASK> __global__ void __launch_bounds__(NT, 2) mk_fwd(Args ka) {
    extern __shared__ __attribute__((aligned(16))) unsigned char lds_raw[];
    LAS unsigned char* lds = (LAS unsigned char*)lds_raw;
    const int lo = ka.ph_lo, hi = ka.ph_hi;
    {
        LAS unsigned long long* tab = (LAS unsigned long long*)(lds + PTR_OFF);
        if (threadIdx.x == 0) {
#pragma unroll
            for (int i = 0; i < 29; ++i) tab[i] = (unsigned long long)ka.in[i];
            ((LAS unsigned*)(lds + XBST_OFF))[0] = 0u; ((LAS unsigned*)(lds + XBST_OFF))[1] = 0u;
        }
        __syncthreads();
    }
    XcdBarrier xbar; xbar.bar = nullptr; xbar.x = 0; xbar.st = nullptr;
    if (COOP) xbar = xcd_barrier_post((unsigned*)(ka.ws + WS_CTL + 4096), (volatile LAS unsigned*)(lds + XBST_OFF));
#define MISC (MASK & 1)
#define SCAN (MASK & 2)
#define GEMM (MASK & 4)
    constexpr int NQ = MK_CHECK ? 16 : 14;
#pragma unroll 1
    for (int ph = lo; ph < hi; ++ph) {
        unsigned char* ws = ka.ws; float* outp = ka.out;
        asm volatile("" : "+s"(ws), "+s"(outp));
        const Ctx a{lds, outp, ws};
        const float* ada = (const float*)(ws + WS_ADA);
        bf16* H = (bf16*)(ws + WS_H); bf16* ACT = (bf16*)(ws + WS_ACT); float* PRE = (float*)(ws + WS_PRE);
        bf16* ZA = (bf16*)(ws + WS_ZA); bf16* ZB = (bf16*)(ws + WS_ZB); float* ZS = (float*)(ws + WS_ZS);
        bf16* O0 = (bf16*)(ws + WS_O); bf16* O1 = (bf16*)(ws + WS_O + O_STRIDE); bf16* O2 = (bf16*)(ws + WS_O + 2 * O_STRIDE); bf16* O3 = (bf16*)(ws + WS_O + 3 * O_STRIDE);
        int l = 0, q = ph;
        if (ph >= 2) { l = (ph - 2) / NQ; const int k = (ph - 2) % NQ; q = 2 + k + ((!MK_CHECK && k >= 6) ? 2 : 0); }
        const unsigned char* wt = ws + WS_WT + (size_t)l * WT_LAYER;
        const float* adl = ada + (size_t)l * NCOND * NADA;
        const float* lng = a.in(27) + (size_t)l * 3 * D; const float* lnb = a.in(28) + (size_t)l * 3 * D;
        switch (q) {
        case 0: if (MISC) { phase_ada(a, lds); __syncthreads(); phase_wconv(a, 0, lds); phase_wconv(a, 1, lds); } break;
        case 1: if (MISC) { phase_xinit(a); } break;
        case 2: if (GEMM && (GSEL >> 0 & 1)) { pg8::EpiSwiglu E{ACT, FF}; run_gemm(lds, H, (const bf16*)(wt + WT_W1A), W1A_N, D, E); } break;
        case 3: if (GEMM && (GSEL >> 1 & 1)) { pg8::EpiPre E{a.out, PRE, adl + 2 * D, 0.5f}; run_gemm(lds, ACT, (const bf16*)(wt + WT_W1D), D, FF, E); } break;
        case 4: if (MISC) { phase_ln(a, lng, lnb, adl + 3 * D); } break;
        case 5: if (GEMM && (GSEL >> 2 & 1)) { pg8::EpiZ<0> E{ZA, ZA_W, ZS, 20}; run_gemm(lds, H, (const bf16*)(wt + WT_WINA), WINA_N, D, E); } break;
        case 6: if (GEMM && (GSEL >> 3 & 1)) { pg8::EpiZ<1> E{ZB, ZB_W, nullptr, 1 << 30}; run_gemm(lds, H, (const bf16*)(wt + WT_WINB), WINB_N, D, E); }
                if (MISC) { phase_prep(a, l, lds); } break;
        case 7: if (SCAN) {
#if MK_FAST_SCAN
                    phase_scan_fast(a, l, lds);
#else
                    const ScanOut so{ws + WS_O, a.out + OUT_GLA, a.out + OUT_MC, a.out + OUT_MN, a.out + OUT_MM, -1}; phase_scan_naive(a, so, l, lds);
#endif
                } break;
#if MK_CHECK
        case 8: if (MASK & 8) { float* st = (float*)(ws + WS_ST2); const ScanOut so{ws + WS_O2, st, st + 8388608, st + 8388608 + 16777216, st + 8388608 + 16777216 + 65536, 0}; phase_scan_naive(a, so, l, lds); } break;
        case 9: if (MASK & 16) { phase_compare(a, l, lds); } break;
#endif
        case 10: if (MISC) { phase_combine(a, l); } break;
        case 11: if (GEMM && (GSEL >> 4 & 1)) { pg8::EpiBranch<false> E{ZB + 2048, ZB_W, nullptr, O1}; run_gemm(lds, O0, (const bf16*)(wt + WT_WBG), D, D, E); } break;
        case 12: if (GEMM && (GSEL >> 5 & 1)) { pg8::EpiBranch<true> E{ZB + 3072, ZB_W, O1, O3}; run_gemm(lds, O2, (const bf16*)(wt + WT_WBM), D, D, E); } break;
        case 13: if (GEMM && (GSEL >> 1 & 1)) { pg8::EpiPre E{a.out, PRE, adl + 5 * D, 1.0f}; run_gemm(lds, O3, (const bf16*)(wt + WT_WO), D, D, E); } break;
        case 14: if (MISC) { phase_ln(a, lng + D, lnb + D, adl + 6 * D); } break;
        case 15: if (GEMM && (GSEL >> 0 & 1)) { pg8::EpiSwiglu E{ACT, FF}; run_gemm(lds, H, (const bf16*)(wt + WT_W2A), W1A_N, D, E); } break;
        case 16: if (GEMM && (GSEL >> 1 & 1)) { pg8::EpiPre E{a.out, PRE, adl + 8 * D, 0.5f}; run_gemm(lds, ACT, (const bf16*)(wt + WT_W2D), D, FF, E); } break;
        case 17: if (MISC) { phase_ln(a, lng + 2 * D, lnb + 2 * D, l == 0 ? ada + (size_t)NCOND * NADA : nullptr);
#if MK_CHECK
                    if (l == 1 && blockIdx.x == 0 && threadIdx.x == 0) { const float* chk = (const float*)(ws + WS_CTL) + 256; unsigned mask = 0;
                        for (int i = 0; i < 8; ++i) { const float nu = __hip_atomic_load(chk + 2 * i, __ATOMIC_RELAXED, __HIP_MEMORY_SCOPE_AGENT), de = __hip_atomic_load(chk + 2 * i + 1, __ATOMIC_RELAXED, __HIP_MEMORY_SCOPE_AGENT); if (!(nu <= MK_CHECK_TOL * de) || !(de > 0.f)) mask |= 1u << i; }
                        const unsigned long long t0 = __builtin_amdgcn_s_memrealtime(); while (__builtin_amdgcn_s_memrealtime() - t0 < (unsigned long long)mask * 400000ull) __builtin_amdgcn_s_sleep(32); }
#endif
                } break;
        default: break;
        }
        if (COOP && ph + 1 < hi) { if (ph == lo) { __syncthreads(); cg::this_grid().sync(); } else xcd_barrier(xbar); }
    }
#undef MISC
#undef SCAN
#undef GEMM
}

#ifndef MK_ONE_LAUNCH
#define MK_ONE_LAUNCH 1
#endif
extern "C" void kernel_launch(void* const* d_in, const int* in_sizes, int n_in, void* d_out, int out_size, void* d_ws, size_t ws_size, hipStream_t stream) {
    static int grid = 0;
    if (grid == 0) {
        if (n_in != 29 || ws_size < WS_END) { fprintf(stderr, "kernel_launch: unexpected n_in %d or ws_size %zu (< %zu); nothing launched\n", n_in, ws_size, (size_t)WS_END); grid = -1; return; }
        int dev = 0, cus = 0;
        (void)hipGetDevice(&dev); (void)hipDeviceGetAttribute(&cus, hipDeviceAttributeMultiprocessorCount, dev);
        int per_cu = 0;
#if MK_ONE_LAUNCH && !MK_CHECK
        (void)hipFuncSetAttribute((const void*)mk_fwd<true, 7>, hipFuncAttributeMaxDynamicSharedMemorySize, LDS_BYTES);
        (void)hipOccupancyMaxActiveBlocksPerMultiprocessor(&per_cu, (const void*)mk_fwd<true, 7>, NT, LDS_BYTES);
#else
        (void)hipFuncSetAttribute((const void*)mk_fwd<false, 7>, hipFuncAttributeMaxDynamicSharedMemorySize, LDS_BYTES);
        (void)hipFuncSetAttribute((const void*)mk_fwd<false, 8>, hipFuncAttributeMaxDynamicSharedMemorySize, LDS_BYTES);
        (void)hipFuncSetAttribute((const void*)mk_fwd<false, 16>, hipFuncAttributeMaxDynamicSharedMemorySize, LDS_BYTES);
        per_cu = 1;
#endif
        (void)hipGetLastError();
        grid = cus > 0 ? cus : 256;
        if (per_cu < 1) fprintf(stderr, "kernel_launch: occupancy query says %d blocks per CU\n", per_cu);
    }
    if (grid < 0) return;
    (void)hipMemsetAsync((char*)d_ws + WS_CTL, 0, CTL_BYTES, stream);
    Args a{};
    for (int i = 0; i < 29; ++i) a.in[i] = (const float*)d_in[i];
    a.out = (float*)d_out; a.ws = (unsigned char*)d_ws;
#if MK_ONE_LAUNCH && !MK_CHECK
    a.ph_lo = 0; a.ph_hi = N_PHASES;
    void* args[] = {&a};
    hipError_t e = hipLaunchCooperativeKernel((const void*)mk_fwd<true, 7>, dim3(grid), dim3(NT), args, LDS_BYTES, stream);
    if (e != hipSuccess) fprintf(stderr, "cooperative launch failed: %s (grid %d)\n", hipGetErrorString(e), grid);
#else
    for (int p = 0; p < N_PHASES; ++p) {
        a.ph_lo = p; a.ph_hi = p + 1;
        if (MK_CHECK && p >= 2 && (p - 2) % 16 == 6) hipLaunchKernelGGL((mk_fwd<false, 8>), dim3(grid), dim3(NT), LDS_BYTES, stream, a);
        else if (MK_CHECK && p >= 2 && (p - 2) % 16 == 7) hipLaunchKernelGGL((mk_fwd<false, 16>), dim3(grid), dim3(NT), LDS_BYTES, stream, a);
        else hipLaunchKernelGGL((mk_fwd<false, 7>), dim3(grid), dim3(NT), LDS_BYTES, stream, a);
    }
#endif
}
```

```cpp
#include <hip/hip_runtime.h>
#include <hip/hip_cooperative_groups.h>
#include <cstdio>
#include <cstdint>
namespace cg = cooperative_groups;

#define GAS __attribute__((address_space(1)))
#define LAS __attribute__((address_space(3)))

constexpr int M = 16384, D = 1024, FF = 2816, NPROMPT_ROWS = 8192;
constexpr int NADA = 9216, NCOND = 9;
constexpr int ZA_W = 5120, ZB_W = 4096, ZS_W = 64;
constexpr int WINA_N = 5376, WINB_N = 4096, W1A_N = 5632;
constexpr int DIN = 9264;
constexpr float ALPHA = 1.4142135623730951f;
constexpr float LN_EPS = 1e-5f, NORM_EPS = 1e-6f;

constexpr size_t MiB = 1u << 20;
constexpr size_t WS_CTL = 0, CTL_BYTES = 65536;
constexpr size_t WS_ADA = 1 * MiB;
constexpr size_t WS_WT = 2 * MiB, WT_LAYER = 58 * MiB;
constexpr size_t WT_W1A = 0, WT_W1D = WT_W1A + (size_t)W1A_N * D * 2, WT_WINA = WT_W1D + (size_t)D * FF * 2, WT_WINB = WT_WINA + (size_t)WINA_N * D * 2,
                 WT_WBG = WT_WINB + (size_t)WINB_N * D * 2, WT_WBM = WT_WBG + (size_t)D * D * 2, WT_WO = WT_WBM + (size_t)D * D * 2,
                 WT_W2A = WT_WO + (size_t)D * D * 2, WT_W2D = WT_W2A + (size_t)W1A_N * D * 2, WT_END = WT_W2D + (size_t)D * FF * 2;
static_assert(WT_END <= WT_LAYER, "weights fit");
constexpr size_t WS_H = 118 * MiB;
constexpr size_t WS_ZS = 150 * MiB;
constexpr size_t WS_ZA = 154 * MiB;
constexpr size_t WS_ZB = 314 * MiB;
constexpr size_t WS_O = 442 * MiB;
constexpr size_t O_STRIDE = 32 * MiB;
constexpr size_t WS_ACT = 570 * MiB;
constexpr size_t WS_PRE = 658 * MiB;
constexpr size_t WS_QKC = 722 * MiB;
constexpr size_t WS_QT = 786 * MiB;
constexpr size_t WS_KT = 818 * MiB;
constexpr size_t WS_O2 = WS_ACT;
constexpr size_t WS_ST2 = 852 * MiB;
constexpr size_t WS_EE = 850 * MiB;
constexpr size_t WS_END = 960 * MiB;

constexpr size_t OUT_GLA = (size_t)M * D, OUT_MC = OUT_GLA + 16777216ull, OUT_MN = OUT_MC + 33554432ull, OUT_MM = OUT_MN + 131072ull;

typedef unsigned short bf16;
typedef float f32x4 __attribute__((ext_vector_type(4)));
typedef unsigned u32x4 __attribute__((ext_vector_type(4)));
typedef unsigned u32x2 __attribute__((ext_vector_type(2)));

__device__ __forceinline__ unsigned f2bf(float f) { unsigned u = __builtin_bit_cast(unsigned, f); return (u + 0x7fffu + ((u >> 16) & 1u)) >> 16; }
__device__ __forceinline__ unsigned pk2(float lo, float hi) { return f2bf(lo) | (f2bf(hi) << 16); }
__device__ __forceinline__ float bf_lo(unsigned w) { return __builtin_bit_cast(float, w << 16); }
__device__ __forceinline__ float bf_hi(unsigned w) { return __builtin_bit_cast(float, w & 0xffff0000u); }
__device__ __forceinline__ float bf2f(bf16 v) { return __builtin_bit_cast(float, (unsigned)v << 16); }
__device__ __forceinline__ float fast_sigmoid(float x) { return __builtin_amdgcn_rcpf(1.0f + __builtin_amdgcn_exp2f(-1.4426950408889634f * x)); }
__device__ __forceinline__ float fast_silu(float x) { return x * fast_sigmoid(x); }
__device__ __forceinline__ float log_sigmoid(float x) { return fminf(x, 0.f) - log1pf(expf(-fabsf(x))); }
__device__ __forceinline__ float wave_sum(float v) {
#pragma unroll
    for (int o = 1; o < 64; o <<= 1) v += __shfl_xor(v, o);
    return v;
}
__device__ __forceinline__ int cond_of_row(int r) { return r < NPROMPT_ROWS ? 0 : 1 + ((r - NPROMPT_ROWS) >> 10); }

__device__ __forceinline__ int otid() { int t = threadIdx.x; asm volatile("" : "+v"(t)); return t; }

namespace pg8 {
#define PG8_LAS __attribute__((address_space(3)))
typedef unsigned short bf16_t;
typedef short bf16x8 __attribute__((ext_vector_type(8)));
typedef float f32x4 __attribute__((ext_vector_type(4)));
typedef unsigned u32x4 __attribute__((ext_vector_type(4)));
constexpr int BM = 256, BK = 64, HALF = 128, HTB = HALF * BK * 2  , STAGE_BYTES = 8 * HTB, NXCD = 8, WGM = 8;

__host__ __device__ __forceinline__ int lds_byte(int r, int c) { const int st = (r >> 4) * 2 + (c >> 5), rr = r & 15, cc = c & 31, ob = rr * 64 + cc * 2; return st * 1024 + (ob ^ (((ob >> 9) & 1) << 5)); }
__host__ __device__ __forceinline__ void stage_rc(int b, int& R, int& C) { const int st = b / 1024, sb = b % 1024, swz = sb ^ (((sb >> 9) & 1) << 5); R = (st >> 1) * 16 + swz / 64; C = (st & 1) * 32 + (swz % 64) / 2; }
__host__ __device__ __forceinline__ int perm32(int rho) { const int n = rho >> 4, i = rho & 15; return 8 * (i >> 2) + 4 * n + (i & 3); }

struct Unit { int pm, pn; };
struct Gemm { const bf16_t* A; const bf16_t* Bt; int M, N, K; };

struct StaticOrder {
    int nM, nN, nwg, G, c;
    __host__ __device__ void init(int M, int N, int G_, int c_) { nM = M / BM; nN = N / BM; nwg = nM * nN; G = G_; c = c_; }
    __host__ __device__ bool next(int i, Unit& u) const {
        const long L = (long)i * G + c; if (L >= nwg) return false;
        int wgid = (int)L; { const int q = nwg / NXCD, r = nwg % NXCD, xcd = wgid % NXCD, off = wgid / NXCD; wgid = (xcd < r ? xcd * (q + 1) : r * (q + 1) + (xcd - r) * q) + off; }
        const int nig = WGM * nN, gid = wgid / nig, fm = gid * WGM, gsz = (nM - fm) < WGM ? (nM - fm) : WGM;
        u.pm = fm + ((wgid % nig) % gsz); u.pn = (wgid % nig) / gsz; return true;
    }
    __device__ __forceinline__ void a_ready(const Unit&) const {}
    __device__ __forceinline__ void done(const Unit&) const {}
};

__device__ __forceinline__ unsigned cvt_pk_bf16(float lo, float hi) { unsigned r; asm volatile("v_cvt_pk_bf16_f32 %0, %1, %2" : "=v"(r) : "v"(lo), "v"(hi)); return r; }
typedef float f32x2 __attribute__((ext_vector_type(2)));
__device__ __forceinline__ int unit_cond(const Unit& u) { return u.pm < 32 ? 0 : 1 + ((u.pm - 32) >> 2); }
__device__ __forceinline__ float esig(float x) { return __builtin_amdgcn_rcpf(1.0f + __builtin_amdgcn_exp2f(-1.4426950408889634f * x)); }

struct EpiSwiglu {
    static constexpr bool PERM = true, AFTER_DRAIN = false;
    bf16_t* O; int ldc;
    __device__ __forceinline__ void operator()(const f32x4 (&acc)[2][2][4][2], const Unit& u, int wr, int wc, int fr, int fq) const {
        const int row0 = u.pm * BM + wr * 64 + fr, col0 = u.pn * HALF + wc * 32 + 8 * fq;
#pragma unroll
        for (int ai = 0; ai < 2; ++ai)
#pragma unroll
            for (int m = 0; m < 4; ++m) { bf16_t* rowp = O + (size_t)(row0 + ai * HALF + m * 16) * ldc + col0;
                f32x4 v0, v1;
#pragma unroll
                for (int e = 0; e < 4; ++e) { const float g0 = acc[ai][0][m][0][e], g1 = acc[ai][0][m][1][e]; v0[e] = g0 * esig(g0) * acc[ai][1][m][0][e]; v1[e] = g1 * esig(g1) * acc[ai][1][m][1][e]; }
                u32x4 w; w.x = cvt_pk_bf16(v0[0], v0[1]); w.y = cvt_pk_bf16(v0[2], v0[3]); w.z = cvt_pk_bf16(v1[0], v1[1]); w.w = cvt_pk_bf16(v1[2], v1[3]);
                *(u32x4*)rowp = w; }
    }
};
struct EpiPre {
    static constexpr bool PERM = false, AFTER_DRAIN = false;
    const float* X; float* P; const float* gate; float coef;
    __device__ __forceinline__ void operator()(const f32x4 (&acc)[2][2][4][2], const Unit& u, int wr, int wc, int fr, int fq) const {
        const int row0 = u.pm * BM + wr * 64 + fr, col0 = u.pn * BM + wc * 32 + 4 * fq;
        const float* g = gate + (size_t)unit_cond(u) * 9216;
        f32x4 gv[2][2];
#pragma unroll
        for (int bj = 0; bj < 2; ++bj)
#pragma unroll
            for (int n = 0; n < 2; ++n) gv[bj][n] = *(const f32x4*)(g + col0 + bj * HALF + n * 16) * coef;
#pragma unroll
        for (int ai = 0; ai < 2; ++ai)
#pragma unroll
            for (int m = 0; m < 4; ++m) { const size_t off = (size_t)(row0 + ai * HALF + m * 16) * 1024 + col0;
#pragma unroll
                for (int bj = 0; bj < 2; ++bj)
#pragma unroll
                    for (int n = 0; n < 2; ++n) { const f32x4 x = *(const f32x4*)(X + off + bj * HALF + n * 16);
                        *(f32x4*)(P + off + bj * HALF + n * 16) = x * 1.4142135623730951f + gv[bj][n] * acc[ai][bj][m][n]; } }
    }
};
template <int ACTSEL> struct EpiZ {
    static constexpr bool PERM = true, AFTER_DRAIN = false;
    bf16_t* O; int ldc; float* ZS; int nmain;
    __device__ __forceinline__ void operator()(const f32x4 (&acc)[2][2][4][2], const Unit& u, int wr, int wc, int fr, int fq) const {
        const int row0 = u.pm * BM + wr * 64 + fr, col0 = u.pn * BM + wc * 32 + 8 * fq;
        if (ACTSEL == 0 && u.pn >= nmain) {
            if (wc < 2) {
#pragma unroll
                for (int ai = 0; ai < 2; ++ai)
#pragma unroll
                    for (int m = 0; m < 4; ++m) { float* rowp = ZS + (size_t)(row0 + ai * HALF + m * 16) * 64 + wc * 32 + 8 * fq;
                        *(f32x4*)rowp = acc[ai][0][m][0]; *(f32x4*)(rowp + 4) = acc[ai][0][m][1]; }
            }
            return;
        }
#pragma unroll
        for (int ai = 0; ai < 2; ++ai)
#pragma unroll
            for (int m = 0; m < 4; ++m) { bf16_t* rowp = O + (size_t)(row0 + ai * HALF + m * 16) * ldc + col0;
#pragma unroll
                for (int bj = 0; bj < 2; ++bj) { f32x4 v0 = acc[ai][bj][m][0], v1 = acc[ai][bj][m][1];
                    if (ACTSEL == 1) {
                        if (u.pn < 4) {
#pragma unroll
                            for (int e = 0; e < 4; ++e) { v0[e] = v0[e] * esig(v0[e]); v1[e] = v1[e] * esig(v1[e]); }
                        } else {
#pragma unroll
                            for (int e = 0; e < 4; ++e) { v0[e] = esig(v0[e]); v1[e] = esig(v1[e]); }
                        }
                    }
                    u32x4 w; w.x = cvt_pk_bf16(v0[0], v0[1]); w.y = cvt_pk_bf16(v0[2], v0[3]); w.z = cvt_pk_bf16(v1[0], v1[1]); w.w = cvt_pk_bf16(v1[2], v1[3]);
                    *(u32x4*)(rowp + bj * HALF) = w; } }
    }
};
template <bool ADD> struct EpiBranch {
    static constexpr bool PERM = true, AFTER_DRAIN = false;
    const bf16_t* G; int ldg; const bf16_t* T; bf16_t* O;
    __device__ __forceinline__ void operator()(const f32x4 (&acc)[2][2][4][2], const Unit& u, int wr, int wc, int fr, int fq) const {
        const int row0 = u.pm * BM + wr * 64 + fr, col0 = u.pn * BM + wc * 32 + 8 * fq;
#pragma unroll
        for (int ai = 0; ai < 2; ++ai)
#pragma unroll
            for (int m = 0; m < 4; ++m) { const size_t r = (size_t)(row0 + ai * HALF + m * 16);
#pragma unroll
                for (int bj = 0; bj < 2; ++bj) {
                    const u32x4 gw = *(const u32x4*)(G + r * ldg + col0 + bj * HALF);
                    f32x4 v0 = acc[ai][bj][m][0], v1 = acc[ai][bj][m][1];
                    v0[0] *= __builtin_bit_cast(float, gw.x << 16); v0[1] *= __builtin_bit_cast(float, gw.x & 0xffff0000u);
                    v0[2] *= __builtin_bit_cast(float, gw.y << 16); v0[3] *= __builtin_bit_cast(float, gw.y & 0xffff0000u);
                    v1[0] *= __builtin_bit_cast(float, gw.z << 16); v1[1] *= __builtin_bit_cast(float, gw.z & 0xffff0000u);
                    v1[2] *= __builtin_bit_cast(float, gw.w << 16); v1[3] *= __builtin_bit_cast(float, gw.w & 0xffff0000u);
                    if (ADD) { const u32x4 tw = *(const u32x4*)(T + r * 1024 + col0 + bj * HALF);
                        v0[0] += __builtin_bit_cast(float, tw.x << 16); v0[1] += __builtin_bit_cast(float, tw.x & 0xffff0000u);
                        v0[2] += __builtin_bit_cast(float, tw.y << 16); v0[3] += __builtin_bit_cast(float, tw.y & 0xffff0000u);
                        v1[0] += __builtin_bit_cast(float, tw.z << 16); v1[1] += __builtin_bit_cast(float, tw.z & 0xffff0000u);
                        v1[2] += __builtin_bit_cast(float, tw.w << 16); v1[3] += __builtin_bit_cast(float, tw.w & 0xffff0000u); }
                    u32x4 w; w.x = cvt_pk_bf16(v0[0], v0[1]); w.y = cvt_pk_bf16(v0[2], v0[3]); w.z = cvt_pk_bf16(v1[0], v1[1]); w.w = cvt_pk_bf16(v1[2], v1[3]);
                    *(u32x4*)(O + r * 1024 + col0 + bj * HALF) = w; } }
    }
};

template <class Epi, class Sched, bool ALIGN_EPI = false, bool SP2 = false>
__device__ __forceinline__ void gemm_phase(PG8_LAS unsigned char* lds, const Gemm g, const Sched& S, const Epi& E) {
    int tid_ = threadIdx.x; asm volatile("" : "+v"(tid_)); const int tid = tid_, wid = __builtin_amdgcn_readfirstlane(tid >> 6), lane = tid & 63, wr = wid >> 2, wc = wid & 3, fr = lane & 15, fq = lane >> 4;
    const int K = g.K, nt = K / BK;
    unsigned voffA[2], voffB[2];
#pragma unroll
    for (int i = 0; i < 2; ++i) { int R, C; stage_rc(tid * 16 + i * 8192, R, C); const int Rb = Epi::PERM ? ((R & ~31) + perm32(R & 31)) : R;
        voffA[i] = (unsigned)(R * K + C) * 2u; voffB[i] = (unsigned)(Rb * K + C) * 2u; }
    const size_t kstep = (size_t)(BK * 2);
    const size_t hstep = (size_t)HALF * K * 2;
    const size_t tstep = 2 * hstep;
    const unsigned ldsw = (unsigned)wid * 1024u;
    const int aoff = lds_byte(wr * 64 + fr, fq * 8), boff = lds_byte(wc * 32 + fr, fq * 8);
#define PG8_SA(b, h) (((b) * 2 + (h)) * HTB)
#define PG8_SB(b, h) ((4 + (b) * 2 + (h)) * HTB)
#define PG8_STAGE(bufoff, gbase, voff) do { _Pragma("unroll") for (int _i = 0; _i < 2; ++_i) \
        __builtin_amdgcn_global_load_lds((const unsigned*)((const char*)(gbase) + (voff)[_i]), (PG8_LAS unsigned*)(lds + (bufoff) + ldsw + _i * 8192), 16, 0, 0); } while (0)
#define PG8_LDA(dst, b, h) do { _Pragma("unroll") for (int m = 0; m < 4; ++m) _Pragma("unroll") for (int k = 0; k < 2; ++k) dst[m][k] = *(const PG8_LAS bf16x8*)(lds + PG8_SA(b, h) + aoff + m * 2048 + k * 1024); } while (0)
#define PG8_LDB(dst, b, h) do { _Pragma("unroll") for (int n = 0; n < 2; ++n) _Pragma("unroll") for (int k = 0; k < 2; ++k) dst[n][k] = *(const PG8_LAS bf16x8*)(lds + PG8_SB(b, h) + boff + n * 2048 + k * 1024); } while (0)
#define PG8_MMA(ai, bj, At, Bt) do { __builtin_amdgcn_s_setprio(1); _Pragma("unroll") for (int m = 0; m < 4; ++m) _Pragma("unroll") for (int n = 0; n < 2; ++n) _Pragma("unroll") for (int k = 0; k < 2; ++k) \
        acc[ai][bj][m][n] = __builtin_amdgcn_mfma_f32_16x16x32_bf16(Bt[n][k], At[m][k], acc[ai][bj][m][n], 0, 0, 0); __builtin_amdgcn_s_setprio(0); } while (0)
#define PG8_WAIT_V(n) asm volatile("s_waitcnt vmcnt(" #n ")" ::: "memory")
#define PG8_WAIT_L(n) asm volatile("s_waitcnt lgkmcnt(" #n ")" ::: "memory")
#define PG8_BAR __builtin_amdgcn_s_barrier()
#define PG8_SCHED __builtin_amdgcn_sched_barrier(0)
    Unit cur, nxt; int ui = 0;
    if (!S.next(0, cur)) return;
    f32x4 acc[2][2][4][2];
#pragma unroll
    for (int a = 0; a < 2; ++a)
#pragma unroll
        for (int b = 0; b < 2; ++b)
#pragma unroll
            for (int m = 0; m < 4; ++m)
#pragma unroll
                for (int n = 0; n < 2; ++n) acc[a][b][m][n] = (f32x4){0.f, 0.f, 0.f, 0.f};
    bf16x8 At[4][2], B0[2][2], B1[2][2];
    const char* cA = (const char*)g.A + (size_t)cur.pm * tstep; const char* cB = (const char*)g.Bt + (size_t)cur.pn * tstep;
    S.a_ready(cur);
    if constexpr (SP2) {
        PG8_STAGE(PG8_SB(0, 0), cB, voffB); PG8_STAGE(PG8_SB(0, 1), cB + hstep, voffB); PG8_STAGE(PG8_SA(0, 0), cA, voffA); PG8_STAGE(PG8_SA(0, 1), cA + hstep, voffA);
        if (wr == 1) PG8_BAR;
        PG8_WAIT_V(2); PG8_BAR;
        PG8_STAGE(PG8_SB(1, 0), cB + kstep, voffB); PG8_STAGE(PG8_SA(1, 0), cA + kstep, voffA); PG8_STAGE(PG8_SB(1, 1), cB + hstep + kstep, voffB);
        PG8_WAIT_V(6); PG8_BAR;
    } else {
        PG8_STAGE(PG8_SB(0, 0), cB, voffB); PG8_STAGE(PG8_SA(0, 0), cA, voffA); PG8_STAGE(PG8_SB(0, 1), cB + hstep, voffB); PG8_STAGE(PG8_SA(0, 1), cA + hstep, voffA);
        if (wr == 1) PG8_BAR;
        PG8_WAIT_V(4); PG8_BAR;
        PG8_STAGE(PG8_SB(1, 0), cB + kstep, voffB); PG8_STAGE(PG8_SA(1, 0), cA + kstep, voffA); PG8_STAGE(PG8_SB(1, 1), cB + hstep + kstep, voffB);
        PG8_WAIT_V(6); PG8_BAR;
    }
    for (;;) {
        const bool has_next = S.next(ui + 1, nxt);
        const char* nA = has_next ? (const char*)g.A + (size_t)nxt.pm * tstep : cA; const char* nB = has_next ? (const char*)g.Bt + (size_t)nxt.pn * tstep : cB;
        for (int t = 0; t < nt; t += 2) {
            const bool last = (t == nt - 2);
            const char* a1 = cA + (size_t)(t + 1) * kstep;
            const char* a2 = last ? nA : cA + (size_t)(t + 2) * kstep; const char* b2 = last ? nB : cB + (size_t)(t + 2) * kstep;
            const char* a3 = a2 + kstep; const char* b3 = b2 + kstep;
            if (last && has_next) S.a_ready(nxt);
            if constexpr (SP2) {
            PG8_LDB(B0, 0, 0); PG8_LDB(B1, 0, 1); PG8_SCHED; PG8_LDA(At, 0, 0); PG8_STAGE(PG8_SA(1, 1), a1 + hstep, voffA);
            PG8_WAIT_V(8); PG8_WAIT_L(0); PG8_BAR; PG8_MMA(0, 0, At, B0); PG8_MMA(0, 1, At, B1); PG8_BAR; PG8_SCHED;
            PG8_LDA(At, 0, 1); PG8_STAGE(PG8_SB(0, 0), b2, voffB); PG8_STAGE(PG8_SB(0, 1), b2 + hstep, voffB); PG8_STAGE(PG8_SA(0, 0), a2, voffA);
            PG8_WAIT_V(8); PG8_WAIT_L(0); PG8_BAR; PG8_MMA(1, 0, At, B0); PG8_MMA(1, 1, At, B1); PG8_BAR; PG8_SCHED;
            PG8_LDB(B0, 1, 0); PG8_LDB(B1, 1, 1); PG8_SCHED; PG8_LDA(At, 1, 0); PG8_STAGE(PG8_SA(0, 1), a2 + hstep, voffA);
            PG8_WAIT_V(8); PG8_WAIT_L(0); PG8_BAR; PG8_MMA(0, 0, At, B0); PG8_MMA(0, 1, At, B1); PG8_BAR; PG8_SCHED;
            PG8_LDA(At, 1, 1); PG8_STAGE(PG8_SB(1, 0), b3, voffB); PG8_STAGE(PG8_SB(1, 1), b3 + hstep, voffB); PG8_STAGE(PG8_SA(1, 0), a3, voffA);
            PG8_WAIT_V(8); PG8_WAIT_L(0); PG8_BAR; PG8_MMA(1, 0, At, B0); PG8_MMA(1, 1, At, B1); PG8_BAR; PG8_SCHED;
            } else {
            PG8_LDB(B0, 0, 0); PG8_SCHED; PG8_LDA(At, 0, 0); PG8_STAGE(PG8_SA(1, 1), a1 + hstep, voffA);
            PG8_WAIT_L(8); PG8_BAR; PG8_WAIT_L(0); PG8_MMA(0, 0, At, B0); PG8_BAR; PG8_SCHED;
            PG8_LDB(B1, 0, 1); PG8_STAGE(PG8_SB(0, 0), b2, voffB);
            PG8_BAR; PG8_WAIT_L(0); PG8_MMA(0, 1, At, B1); PG8_BAR;
            PG8_LDA(At, 0, 1); PG8_STAGE(PG8_SA(0, 0), a2, voffA);
            PG8_BAR; PG8_WAIT_L(0); PG8_MMA(1, 0, At, B0); PG8_BAR; PG8_SCHED;
            PG8_STAGE(PG8_SB(0, 1), b2 + hstep, voffB);
            PG8_WAIT_V(6); PG8_BAR; PG8_MMA(1, 1, At, B1); PG8_BAR;
            PG8_LDB(B0, 1, 0); PG8_SCHED; PG8_LDA(At, 1, 0); PG8_STAGE(PG8_SA(0, 1), a2 + hstep, voffA);
            PG8_WAIT_L(8); PG8_BAR; PG8_WAIT_L(0); PG8_MMA(0, 0, At, B0); PG8_BAR; PG8_SCHED;
            PG8_LDB(B1, 1, 1); PG8_STAGE(PG8_SB(1, 0), b3, voffB);
            PG8_BAR; PG8_WAIT_L(0); PG8_MMA(0, 1, At, B1); PG8_BAR;
            PG8_LDA(At, 1, 1); PG8_STAGE(PG8_SA(1, 0), a3, voffA);
            PG8_BAR; PG8_WAIT_L(0); PG8_MMA(1, 0, At, B0); PG8_BAR; PG8_SCHED;
            PG8_STAGE(PG8_SB(1, 1), b3 + hstep, voffB);
            PG8_WAIT_V(6); PG8_BAR; PG8_MMA(1, 1, At, B1); PG8_BAR;
            }
        }
        if constexpr (ALIGN_EPI) { if (wr == 0) PG8_BAR; }
        if constexpr (!Epi::AFTER_DRAIN) { E(acc, cur, wr, wc, fr, fq); S.done(cur); }
        if (!has_next) break;
#pragma unroll
        for (int a = 0; a < 2; ++a)
#pragma unroll
            for (int b = 0; b < 2; ++b)
#pragma unroll
                for (int m = 0; m < 4; ++m)
#pragma unroll
                    for (int n = 0; n < 2; ++n) acc[a][b][m][n] = (f32x4){0.f, 0.f, 0.f, 0.f};
        cur = nxt; cA = nA; cB = nB; ++ui;
        if constexpr (ALIGN_EPI) { if (wr == 1) PG8_BAR; }
    }
    PG8_WAIT_V(0);
    if constexpr (!ALIGN_EPI) { if (wr == 0) PG8_BAR; }
    PG8_BAR;
    if constexpr (Epi::AFTER_DRAIN) { E.fused(acc, cur, wr, wc, fr, fq, lds, wid, lane); S.done(cur); }
#undef PG8_SA
#undef PG8_SB
#undef PG8_STAGE
#undef PG8_LDA
#undef PG8_LDB
#undef PG8_MMA
#undef PG8_WAIT_V
#undef PG8_WAIT_L
#undef PG8_BAR
#undef PG8_SCHED
}
}

#ifndef SSEL
#define SSEL 3
#endif
struct Args { const float* in[29]; float* out; unsigned char* ws; int ph_lo, ph_hi; unsigned reps, pad; };
constexpr int PTR_OFF = 131072 + 1024, XBST_OFF = 131072 + 2048;
struct Ctx { LAS unsigned char* lds; float* out; unsigned char* ws;
    __device__ __forceinline__ const float* in(int i) const { const LAS unsigned* p = (const LAS unsigned*)(lds + PTR_OFF) + 2 * i;
        const unsigned lo = __builtin_amdgcn_readfirstlane(p[0]), hi = __builtin_amdgcn_readfirstlane(p[1]); return (const float*)(((unsigned long long)hi << 32) | lo); } };
constexpr int NW = 8, NT = NW * 64;
constexpr int LDS_BYTES = 147456;

__device__ __forceinline__ void transpose_item(const float* src, int srcN, int k0, int n0, int ncols, bf16* dst, int dstK, int dstrow, LAS float* scr, int lane) {
    float tv[32];
#pragma unroll
    for (int i = 0; i < 32; ++i) { const int kk = 2 * i + (lane >> 5), c = lane & 31; tv[i] = (c < ncols) ? src[(size_t)(k0 + kk) * srcN + n0 + c] : 0.f; }
#pragma unroll
    for (int i = 0; i < 32; ++i) { const int kk = 2 * i + (lane >> 5), c = lane & 31; scr[kk * 33 + c] = tv[i]; }
    asm volatile("s_waitcnt lgkmcnt(0)" ::: "memory");
    const int c = lane & 7;
#pragma unroll
    for (int j = 0; j < 4; ++j) { const int n = (lane >> 3) + 8 * j; const LAS float* s = scr + (8 * c) * 33 + n;
        u32x4 o; o.x = pk2(s[0 * 33], s[1 * 33]); o.y = pk2(s[2 * 33], s[3 * 33]); o.z = pk2(s[4 * 33], s[5 * 33]); o.w = pk2(s[6 * 33], s[7 * 33]);
        if (n < ncols) *(u32x4*)(dst + (size_t)(dstrow + n) * dstK + k0 + 8 * c) = o; }
    asm volatile("s_waitcnt lgkmcnt(0)" ::: "memory");
}
__device__ __forceinline__ void phase_wconv(const Ctx& a, int l, LAS unsigned char* lds) {
    const int tid = otid(), lane = tid & 63, wave = tid >> 6;
    LAS float* scr = (LAS float*)(lds + wave * 16384);
    unsigned char* wt = a.ws + WS_WT + (size_t)l * WT_LAYER;
    const int gw = blockIdx.x * NW + wave, NGW = gridDim.x * NW;
    constexpr int I_1A = 16 * 176, I_1D = 44 * 32, I_INA = 16 * 162, I_INB = 16 * 128, I_SQ = 16 * 32;
    constexpr int NITEMS = 2 * I_1A + 2 * I_1D + I_INA + I_INB + 3 * I_SQ;
    for (int it = gw; it < NITEMS; it += NGW) {
        int r = it;
        if (r < 2 * I_1A) {
            const int f = r / I_1A; r -= f * I_1A; const int kb = r / 176, nb = r % 176, up = nb >= 88, c0 = 32 * (nb - 88 * up);
            const float* src = a.in(f == 0 ? (up ? 11 : 10) : (up ? 25 : 24)) + (size_t)l * D * FF;
            transpose_item(src, FF, 64 * kb, c0, 32, (bf16*)(wt + (f == 0 ? WT_W1A : WT_W2A)), D, 256 * (c0 >> 7) + (c0 & 127) + 128 * up, scr, lane); continue; }
        r -= 2 * I_1A;
        if (r < 2 * I_1D) {
            const int f = r / I_1D; r -= f * I_1D; const int kb = r / 32, nb = r % 32;
            transpose_item(a.in(f == 0 ? 12 : 26) + (size_t)l * FF * D, D, 64 * kb, 32 * nb, 32, (bf16*)(wt + (f == 0 ? WT_W1D : WT_W2D)), FF, 32 * nb, scr, lane); continue; }
        r -= 2 * I_1D;
        if (r < I_INA) { const int kb = r / 162, nb = r % 162; const float* src = a.in(13) + (size_t)l * D * DIN;
            int dr = 32 * nb, sc, nc = 32;
            if (nb < 160) sc = dr < 2048 ? dr : dr + 1056; else if (nb == 160) sc = 3072; else { sc = 7200; nc = 16; }
            transpose_item(src, DIN, 64 * kb, sc, nc, (bf16*)(wt + WT_WINA), D, dr, scr, lane); continue; }
        r -= I_INA;
        if (r < I_INB) { const int kb = r / 128, nb = r % 128; const float* src = a.in(13) + (size_t)l * D * DIN;
            const int dr = 32 * nb, sc = dr < 1024 ? dr + 2048 : (dr < 2048 ? dr + 5152 : dr + 5168);
            transpose_item(src, DIN, 64 * kb, sc, 32, (bf16*)(wt + WT_WINB), D, dr, scr, lane); continue; }
        r -= I_INB;
        { const int f = r / I_SQ; r -= f * I_SQ; const int kb = r / 32, nb = r % 32;
          transpose_item(a.in(21 + f) + (size_t)l * D * D, D, 64 * kb, 32 * nb, 32, (bf16*)(wt + (f == 0 ? WT_WBG : f == 1 ? WT_WBM : WT_WO)), D, 32 * nb, scr, lane); }
    }
}
__device__ __forceinline__ void phase_ada(const Ctx& a, LAS unsigned char* lds) {
    LAS float* sil = (LAS float*)lds;
    LAS float* red = (LAS float*)(lds + 36864);
    const int tid = otid();
    for (int i = tid; i < NCOND * D; i += NT) { const int ci = i >> 10, k = i & 1023; const float v = ci == 0 ? a.in(7)[k] : a.in(2)[(ci - 1) * D + k]; sil[i] = v / (1.f + expf(-v)); }
    __syncthreads();
    float* ada = (float*)(a.ws + WS_ADA);
    const int c = tid & 63, s = tid >> 6;
    for (int it = blockIdx.x; it < 2 * 144; it += gridDim.x) {
        const int l = it / 144, g = it % 144; const float* W = a.in(8) + (size_t)l * D * NADA + 64 * g + c;
        float acc[NCOND];
#pragma unroll
        for (int ci = 0; ci < NCOND; ++ci) acc[ci] = 0.f;
#pragma unroll 1
        for (int k0 = s; k0 < D; k0 += 8 * 16) { float wv[16];
#pragma unroll
            for (int u = 0; u < 16; ++u) wv[u] = W[(size_t)(k0 + 8 * u) * NADA];
#pragma unroll
            for (int u = 0; u < 16; ++u)
#pragma unroll
                for (int ci = 0; ci < NCOND; ++ci) acc[ci] += sil[ci * D + k0 + 8 * u] * wv[u]; }
#pragma unroll
        for (int ci = 0; ci < NCOND; ++ci) red[(s * NCOND + ci) * 64 + c] = acc[ci];
        __syncthreads();
        for (int i = tid; i < NCOND * 64; i += NT) { const int ci = i >> 6, cc = i & 63; float sum = a.in(9)[(size_t)l * NADA + 64 * g + cc];
#pragma unroll
            for (int ss = 0; ss < 8; ++ss) sum += red[(ss * NCOND + ci) * 64 + cc];
            ada[((size_t)l * NCOND + ci) * NADA + 64 * g + cc] = sum; }
        __syncthreads();
    }
}
__device__ __forceinline__ void store_mod_row(bf16* hrow, const f32x4 (&v)[4], const float* sh, const float* sc, int lane) {
#pragma unroll
    for (int j = 0; j < 4; ++j) { const f32x4 s = *(const f32x4*)(sc + 256 * j + 4 * lane), t = *(const f32x4*)(sh + 256 * j + 4 * lane);
        const f32x4 h = v[j] * (s + 1.0f) + t; u32x2 w; w.x = pk2(h[0], h[1]); w.y = pk2(h[2], h[3]); *(u32x2*)(hrow + 256 * j + 4 * lane) = w; }
}
__device__ __forceinline__ void phase_xinit(const Ctx& a) {
    const int tid = otid(), lane = tid & 63, gw = blockIdx.x * NW + (tid >> 6), NGW = gridDim.x * NW;
    const float* ada = (const float*)(a.ws + WS_ADA);
    bf16* H = (bf16*)(a.ws + WS_H);
    for (int r = gw; r < M; r += NGW) {
        f32x4 v[4];
        if (r < NPROMPT_ROWS) {
#pragma unroll
            for (int j = 0; j < 4; ++j) v[j] = *(const f32x4*)(a.in(0) + (size_t)r * D + 256 * j + 4 * lane);
        } else {
            const int rs = r - NPROMPT_ROWS, t = rs & 1023; const float gr = (float)(t >> 6), gc = (float)(t & 63);
#pragma unroll
            for (int j = 0; j < 4; ++j) { v[j] = *(const f32x4*)(a.in(1) + (size_t)rs * D + 256 * j + 4 * lane);
#pragma unroll
                for (int e = 0; e < 4; ++e) { const float om = 1.0f / powf(10000.0f, (float)(4 * lane + e) * (1.0f / 256.0f)); const float ang = (j < 2 ? gr : gc) * om;
                    v[j][e] += (j & 1) ? cosf(ang) : sinf(ang); } }
        }
#pragma unroll
        for (int j = 0; j < 4; ++j) *(f32x4*)(a.out + (size_t)r * D + 256 * j + 4 * lane) = v[j];
        const float* ad = ada + (size_t)cond_of_row(r) * NADA;
        store_mod_row(H + (size_t)r * D, v, ad, ad + 1024, lane);
    }
}
__device__ __forceinline__ void phase_ln(const Ctx& a, const float* lng, const float* lnb, const float* mod) {
    const int tid = otid(), lane = tid & 63, gw = blockIdx.x * NW + (tid >> 6), NGW = gridDim.x * NW;
    const float* P = (const float*)(a.ws + WS_PRE);
    bf16* H = (bf16*)(a.ws + WS_H);
    for (int r = gw; r < M; r += NGW) {
        f32x4 v[4]; float s = 0.f;
#pragma unroll
        for (int j = 0; j < 4; ++j) { v[j] = *(const f32x4*)(P + (size_t)r * D + 256 * j + 4 * lane); s += (v[j][0] + v[j][1]) + (v[j][2] + v[j][3]); }
        const float mean = wave_sum(s) * (1.f / D); float s2 = 0.f;
#pragma unroll
        for (int j = 0; j < 4; ++j) { v[j] = v[j] - mean; s2 += (v[j][0] * v[j][0] + v[j][1] * v[j][1]) + (v[j][2] * v[j][2] + v[j][3] * v[j][3]); }
        const float rstd = 1.0f / sqrtf(wave_sum(s2) * (1.f / D) + LN_EPS);
#pragma unroll
        for (int j = 0; j < 4; ++j) { const f32x4 g = *(const f32x4*)(lng + 256 * j + 4 * lane), b = *(const f32x4*)(lnb + 256 * j + 4 * lane);
            v[j] = v[j] * rstd * g + b; *(f32x4*)(a.out + (size_t)r * D + 256 * j + 4 * lane) = v[j]; }
        if (mod) { const float* ad = mod + (size_t)cond_of_row(r) * NADA; store_mod_row(H + (size_t)r * D, v, ad, ad + 1024, lane); }
    }
}
__device__ __forceinline__ void phase_combine(const Ctx& a, int l) {
    const int tid = otid(), lane = tid & 63, gw = blockIdx.x * NW + (tid >> 6), NGW = gridDim.x * NW;
    const bf16* ZB = (const bf16*)(a.ws + WS_ZB);
    for (int r = gw; r < M; r += NGW) {
#pragma unroll
        for (int br = 0; br < 2; ++br) {
            bf16* OF = (bf16*)(a.ws + WS_O + (size_t)(2 * br) * O_STRIDE) + (size_t)r * D; const bf16* OB = (const bf16*)(a.ws + WS_O + (size_t)(2 * br + 1) * O_STRIDE) + (size_t)r * D;
            const float* gam = a.in(19 + br) + l * 256 + 4 * lane; const f32x4 gv = *(const f32x4*)gam;
            const bf16* gate = ZB + (size_t)r * ZB_W + br * 1024;
#pragma unroll
            for (int h = 0; h < 4; ++h) {
                const u32x2 wf = *(const u32x2*)(OF + 256 * h + 4 * lane), wb = *(const u32x2*)(OB + 256 * h + 4 * lane), wg = *(const u32x2*)(gate + 256 * h + 4 * lane);
                f32x4 s; s[0] = bf_lo(wf.x) + bf_lo(wb.x); s[1] = bf_hi(wf.x) + bf_hi(wb.x); s[2] = bf_lo(wf.y) + bf_lo(wb.y); s[3] = bf_hi(wf.y) + bf_hi(wb.y);
                const float ss = wave_sum((s[0] * s[0] + s[1] * s[1]) + (s[2] * s[2] + s[3] * s[3]));
                const float rs = 1.0f / sqrtf(ss * (1.f / 256.f) + NORM_EPS);
                f32x4 o = s * rs * gv; o[0] *= bf_lo(wg.x); o[1] *= bf_hi(wg.x); o[2] *= bf_lo(wg.y); o[3] *= bf_hi(wg.y);
                u32x2 w; w.x = pk2(o[0], o[1]); w.y = pk2(o[2], o[3]); *(u32x2*)(OF + 256 * h + 4 * lane) = w;
            }
        }
    }
}
struct ScanOut { unsigned char* obase; float* gla; float* mc; float* mn; float* mm; int lsel; };
__device__ __forceinline__ void scan_gla_naive(const Ctx& a, const ScanOut& so, int l, int sample, int b, int h, int dir, LAS unsigned char* lds) {
    const int tid = otid(), dv = tid & 255, half = tid >> 8;
    const int T = sample ? 1024 : 256, row0 = sample ? NPROMPT_ROWS + b * 1024 : b * 256;
    const bf16* ZA = (const bf16*)(a.ws + WS_ZA); const float* ZS = (const float*)(a.ws + WS_ZS);
    bf16* OG = (bf16*)(so.obase + (size_t)dir * O_STRIDE);
    LAS float* qs = (LAS float*)lds; LAS float* ks = qs + 16 * 128; LAS float* es = ks + 16 * 128; LAS float* op = es + 16 * 128; LAS float* vs = op + 32 * 256;
    float S[64];
    const size_t sidx = ((((size_t)b * 2 + l) * 2 + dir) * 4 + h) * (128 * 256), sidx2 = (so.lsel < 0 ? ((((size_t)b * 2 + l) * 2 + dir) * 4 + h) : (((size_t)b * 2 + dir) * 4 + h)) * (128 * 256);
    if (sample) {
#pragma unroll
        for (int i = 0; i < 64; ++i) { S[i] = a.in(3)[sidx + (size_t)(half * 64 + i) * 256 + dv]; if ((i & 7) == 7) asm volatile("" ::: "memory"); }
    } else {
#pragma unroll
        for (int i = 0; i < 64; ++i) S[i] = 0.f;
    }
    const int d = tid & 127, jq = tid >> 7;
    float wd[16];
#pragma unroll
    for (int r = 0; r < 16; ++r) wd[r] = a.in(14)[(((size_t)l * 2 + dir) * 16 + r) * 512 + h * 128 + d];
    const float bd = a.in(15)[((size_t)l * 2 + dir) * 512 + h * 128 + d];
#pragma unroll 1
    for (int t0 = 0; t0 < T; t0 += 16) {
        __syncthreads();
#pragma unroll 1
        for (int i = 0; i < 4; ++i) { const int j = jq + 4 * i, tok = dir ? T - 1 - (t0 + j) : t0 + j; const size_t r = (size_t)(row0 + tok);
            float x = bd;
#pragma unroll
            for (int q4 = 0; q4 < 4; ++q4) { const f32x4 av = *(const f32x4*)(ZS + r * 64 + dir * 16 + 4 * q4); x += av[0] * wd[4 * q4] + av[1] * wd[4 * q4 + 1] + av[2] * wd[4 * q4 + 2] + av[3] * wd[4 * q4 + 3]; }
            es[j * 128 + d] = expf(log_sigmoid(x) * (1.f / 16.f));
            qs[j * 128 + d] = bf2f(ZA[r * ZA_W + h * 128 + d]) * 0.08838834764831845f;
            ks[j * 128 + d] = bf2f(ZA[r * ZA_W + 512 + h * 128 + d]); }
#pragma unroll 2
        for (int jj = 0; jj < 8; ++jj) { const int j = half * 8 + jj; const int tok = dir ? T - 1 - (t0 + j) : t0 + j; vs[j * 256 + dv] = bf2f(ZA[(size_t)(row0 + tok) * ZA_W + 1024 + h * 256 + dv]); }
        __syncthreads();
#pragma unroll 1
        for (int j = 0; j < 16; ++j) { float acc = 0.f; const float vj = vs[j * 256 + dv];
#pragma unroll
            for (int i4 = 0; i4 < 16; ++i4) { const int dk = half * 64 + 4 * i4; const f32x4 e4 = *(const LAS f32x4*)(es + j * 128 + dk), k4 = *(const LAS f32x4*)(ks + j * 128 + dk), q4 = *(const LAS f32x4*)(qs + j * 128 + dk);
#pragma unroll
                for (int e = 0; e < 4; ++e) { S[4 * i4 + e] = e4[e] * S[4 * i4 + e] + k4[e] * vj; acc += q4[e] * S[4 * i4 + e]; }
                asm volatile("" ::: "memory"); }
            op[(half * 16 + j) * 256 + dv] = acc; }
        __syncthreads();
#pragma unroll 2
        for (int jj = 0; jj < 8; ++jj) { const int j = half * 8 + jj; const int tok = dir ? T - 1 - (t0 + j) : t0 + j; OG[(size_t)(row0 + tok) * D + h * 256 + dv] = (bf16)f2bf(op[j * 256 + dv] + op[(16 + j) * 256 + dv]); }
    }
    if (!sample) {
#pragma unroll
        for (int i = 0; i < 64; ++i) { so.gla[sidx2 + (size_t)(half * 64 + i) * 256 + dv] = S[i]; if ((i & 7) == 7) asm volatile("" ::: "memory"); }
    }
}
__device__ __forceinline__ void scan_mlstm_naive(const Ctx& a, const ScanOut& so, int l, int sample, int b, int h, int dir, LAS unsigned char* lds) {
    const int tid = otid(), dv = tid & 255, half = tid >> 8, lane = tid & 63, wave = tid >> 6;
    const int T = sample ? 1024 : 256, row0 = sample ? NPROMPT_ROWS + b * 1024 : b * 256;
    const bf16* ZA = (const bf16*)(a.ws + WS_ZA); const float* ZS = (const float*)(a.ws + WS_ZS);
    bf16* OM = (bf16*)(so.obase + (size_t)(2 + dir) * O_STRIDE);
    LAS float* qs = (LAS float*)lds; LAS float* ks = qs + 16 * 256; LAS float* op = ks + 16 * 256; LAS float* qnp = op + 32 * 256; LAS float* gt = qnp + 16 * 256; LAS float* vs = gt + 128;
    float C[128];
    const size_t hidx = (((size_t)b * 2 + l) * 2 + dir) * 4 + h, hidx2 = so.lsel < 0 ? ((((size_t)b * 2 + l) * 2 + dir) * 4 + h) : (((size_t)b * 2 + dir) * 4 + h);
    float n = 0.f, m = 0.f;
    if (sample) {
#pragma unroll
        for (int i = 0; i < 128; ++i) { C[i] = a.in(4)[hidx * 65536 + (size_t)(half * 128 + i) * 256 + dv]; if ((i & 7) == 7) asm volatile("" ::: "memory"); }
        if (tid < 256) n = a.in(5)[hidx * 256 + tid];
        m = a.in(6)[hidx];
    } else {
#pragma unroll
        for (int i = 0; i < 128; ++i) C[i] = 0.f;
    }
    const int chan = (tid < 256) ? h * 256 + tid : 1024 + h * 256 + (tid - 256);
    const float w0 = a.in(16)[((size_t)l * 3 + 0) * 2048 + chan], w1 = a.in(16)[((size_t)l * 3 + 1) * 2048 + chan], w2 = a.in(16)[((size_t)l * 3 + 2) * 2048 + chan], bc = a.in(17)[(size_t)l * 2048 + chan];
    const float fb = a.in(18)[((size_t)l * 2 + dir) * 4 + h];
#pragma unroll 1
    for (int t0 = 0; t0 < T; t0 += 16) {
        __syncthreads();
#pragma unroll 2
        for (int j = 0; j < 16; ++j) { const int tok = dir ? T - 1 - (t0 + j) : t0 + j; const bf16* zp = ZA + (size_t)(row0 + tok) * ZA_W + 2048 + chan;
            const float zc = bf2f(zp[0]), zm = tok > 0 ? bf2f(zp[-ZA_W]) : 0.f, zn = tok < T - 1 ? bf2f(zp[ZA_W]) : 0.f;
            const float x = w0 * zm + w1 * zc + w2 * zn + bc; const float sv = x / (1.f + expf(-x));
            if (tid < 256) qs[j * 256 + tid] = sv * 0.0625f; else ks[j * 256 + tid - 256] = sv; }
        if (tid == 0) { float mm = m;
            for (int j = 0; j < 16; ++j) { const int tok = dir ? T - 1 - (t0 + j) : t0 + j; const float* zr = ZS + (size_t)(row0 + tok) * 64 + 32 + dir * 8 + h;
                const float ig = zr[0], lf = log_sigmoid(zr[4] + fb); const float mn = fmaxf(lf + mm, ig);
                gt[j] = expf(lf + mm - mn); gt[16 + j] = expf(ig - mn); gt[32 + j] = expf(-mn); mm = mn; }
            gt[64] = mm; }
#pragma unroll 2
        for (int jj = 0; jj < 8; ++jj) { const int j = half * 8 + jj; const int tok = dir ? T - 1 - (t0 + j) : t0 + j; vs[j * 256 + dv] = bf2f(ZA[(size_t)(row0 + tok) * ZA_W + 4096 + h * 256 + dv]); }
        __syncthreads();
        m = gt[64];
#pragma unroll 1
        for (int j = 0; j < 16; ++j) { const float f = gt[j], w = gt[16 + j]; const float kv = w * vs[j * 256 + dv]; float acc = 0.f;
#pragma unroll
            for (int i4 = 0; i4 < 32; ++i4) { const int dk = half * 128 + 4 * i4; const f32x4 k4 = *(const LAS f32x4*)(ks + j * 256 + dk), q4 = *(const LAS f32x4*)(qs + j * 256 + dk);
#pragma unroll
                for (int e = 0; e < 4; ++e) { C[4 * i4 + e] = f * C[4 * i4 + e] + k4[e] * kv; acc += q4[e] * C[4 * i4 + e]; }
                asm volatile("" ::: "memory"); }
            op[(half * 16 + j) * 256 + dv] = acc;
            if (tid < 256) { n = f * n + w * ks[j * 256 + tid]; qnp[j * 256 + tid] = qs[j * 256 + tid] * n; } }
        __syncthreads();
#pragma unroll
        for (int jj = 0; jj < 2; ++jj) { const int j = 2 * wave + jj; const f32x4 p = *(const LAS f32x4*)(qnp + j * 256 + 4 * lane); const float s = wave_sum((p[0] + p[1]) + (p[2] + p[3])); if (lane == 0) gt[48 + j] = s; }
        __syncthreads();
#pragma unroll 2
        for (int jj = 0; jj < 8; ++jj) { const int j = half * 8 + jj; const int tok = dir ? T - 1 - (t0 + j) : t0 + j; const float den = fmaxf(fabsf(gt[48 + j]), gt[32 + j]);
            OM[(size_t)(row0 + tok) * D + h * 256 + dv] = (bf16)f2bf((op[j * 256 + dv] + op[(16 + j) * 256 + dv]) / den); }
    }
    if (!sample) {
#pragma unroll
        for (int i = 0; i < 128; ++i) { so.mc[hidx2 * 65536 + (size_t)(half * 128 + i) * 256 + dv] = C[i]; if ((i & 7) == 7) asm volatile("" ::: "memory"); }
        if (tid < 256) so.mn[hidx2 * 256 + tid] = n;
        if (tid == 0) so.mm[hidx2] = m;
    }
}
__device__ __forceinline__ void phase_scan_naive(const Ctx& a, const ScanOut& so, int l, LAS unsigned char* lds) {
    for (int u = blockIdx.x; u < 640; u += gridDim.x) {
        int kind, sample, v;
        if (u < 64) { kind = 1; sample = 1; v = u; } else if (u < 128) { kind = 0; sample = 1; v = u - 64; } else if (u < 384) { kind = 1; sample = 0; v = u - 128; } else { kind = 0; sample = 0; v = u - 384; }
        const int dir = v & 1, h = (v >> 1) & 3, b = v >> 3;
        if (kind) { if (SSEL & 2) scan_mlstm_naive(a, so, l, sample, b, h, dir, lds); } else { if (SSEL & 1) scan_gla_naive(a, so, l, sample, b, h, dir, lds); }
        __syncthreads();
    }
}


typedef float f32x16 __attribute__((ext_vector_type(16)));
typedef short s16x8 __attribute__((ext_vector_type(8)));
typedef short s16x4 __attribute__((ext_vector_type(4)));
typedef float f32x2_t __attribute__((ext_vector_type(2)));
typedef __bf16 bf16x2_t __attribute__((ext_vector_type(2)));
#define MFMA32(a, b, c) ((VAR & 2) ? (c) : __builtin_amdgcn_mfma_f32_32x32x16_bf16((a), (b), (c), 0, 0, 0))
#define MFMA16(a, b, c) ((VAR & 2) ? (c) : __builtin_amdgcn_mfma_f32_16x16x32_bf16((a), (b), (c), 0, 0, 0))
__device__ __forceinline__ unsigned cvtpk(float lo, float hi) { f32x2_t v = {lo, hi}; bf16x2_t b = __builtin_convertvector(v, bf16x2_t); return __builtin_bit_cast(unsigned, b); }
__device__ __forceinline__ s16x4 vtr(const LAS unsigned char* p) { typedef short v4i16_t __attribute__((ext_vector_type(4))); return __builtin_bit_cast(s16x4, __builtin_amdgcn_ds_read_tr16_b64_v4i16((LAS v4i16_t*)p)); }
__device__ __forceinline__ s16x8 cat8(s16x4 lo, s16x4 hi) { return __builtin_shufflevector(lo, hi, 0, 1, 2, 3, 4, 5, 6, 7); }
__device__ __forceinline__ int crow(int r, int h) { return (r & 3) + 8 * (r >> 2) + 4 * h; }
__device__ __forceinline__ s16x8 pack_step(const f32x16& x, int s) {
    u32x4 p; p.x = cvtpk(x[8 * s + 0], x[8 * s + 1]); p.y = cvtpk(x[8 * s + 2], x[8 * s + 3]); p.z = cvtpk(x[8 * s + 4], x[8 * s + 5]); p.w = cvtpk(x[8 * s + 6], x[8 * s + 7]);
    return __builtin_bit_cast(s16x8, p);
}
__device__ __forceinline__ s16x8 frag_tr(const LAS unsigned char* base, int trofs, int RS) { return cat8(vtr(base + trofs), vtr(base + trofs + 4 * RS)); }
__device__ __forceinline__ s16x8 frag_perm(const LAS unsigned char* p) { return cat8(*(const LAS s16x4*)p, *(const LAS s16x4*)(p + 16)); }

#ifndef MK_VAR_SSEL
#define MK_VAR_SSEL 3
#endif
constexpr int SC_CHUNK = 64;
constexpr int ML_RSQ = 528, ML_RSK = 576, ML_RSV = 576, RSP = 144;
constexpr int ML_Q = 0, ML_K = ML_Q + 64 * ML_RSQ, ML_V = ML_K + 64 * ML_RSK, ML_P = ML_V + 64 * ML_RSV, ML_SC = ML_P + 64 * RSP, ML_N = ML_SC + 2048, ML_END = ML_N + 1024;
static_assert(ML_END <= 131072, "mLSTM LDS");
template <int VAR> __device__ __forceinline__ void scan_mlstm_fast(const Ctx& a, int l, int sample, int b, int h, int dir, LAS unsigned char* lds) {
    const int tid = otid(), lane = tid & 63, wave = __builtin_amdgcn_readfirstlane(tid >> 6);
    const int T = sample ? 1024 : 256, row0 = sample ? NPROMPT_ROWS + b * 1024 : b * 256;
    const bf16* QKC = (const bf16*)(a.ws + WS_QKC); const bf16* ZA = (const bf16*)(a.ws + WS_ZA); const float* ZS = (const float*)(a.ws + WS_ZS);
    bf16* OM = (bf16*)(a.ws + (VAR ? WS_O2 : WS_O) + (size_t)(2 + dir) * O_STRIDE);
    LAS float* SC = (LAS float*)(lds + ML_SC); LAS float* NV = (LAS float*)(lds + ML_N);
    LAS float* sR = SC, *sIR = SC + 64, *sEM = SC + 128, *sW = SC + 192, *sDEN = SC + 256, *sQN = SC + 320, *sINT = SC + 384, *sMISC = SC + 448;
    const int hh = lane >> 5, c32 = lane & 31;
    const size_t hidx = (((size_t)b * 2 + l) * 2 + dir) * 4 + h;
    f32x16 C[8];
    if (sample) {
        const float* cp = a.in(4) + hidx * 65536 + 32 * wave + c32;
#pragma unroll
        for (int blk = 0; blk < 8; ++blk) {
#pragma unroll
            for (int r = 0; r < 16; ++r) C[blk][r] = cp[(size_t)(32 * blk + crow(r, hh)) * 256];
            asm volatile("" ::: "memory"); }
        if (tid < 256) NV[tid] = a.in(5)[hidx * 256 + tid];
        if (tid == 0) sMISC[0] = a.in(6)[hidx];
    } else {
#pragma unroll
        for (int blk = 0; blk < 8; ++blk)
#pragma unroll
            for (int r = 0; r < 16; ++r) C[blk][r] = 0.f;
        if (tid < 256) NV[tid] = 0.f;
        if (tid == 0) sMISC[0] = 0.f;
    }
    for (int i = tid; i < 64 * RSP / 4; i += NT) ((LAS unsigned*)(lds + ML_P))[i] = 0u;
    const float fb = a.in(18)[((size_t)l * 2 + dir) * 4 + h];
    u32x4 pq[4], pk[4], pv[4]; float pgi = 0.f, pgf = 0.f;
#define ML_LOAD(t0_) do { \
        _Pragma("unroll") for (int i = 0; i < 4; ++i) { const int idx = tid + NT * i, j = idx >> 5, pc = idx & 31; const int tok = (VAR & 1) ? j : (dir ? T - 1 - ((t0_) + j) : (t0_) + j); const size_t r = (size_t)(row0 + tok); \
            pq[i] = *(const u32x4*)(QKC + r * 2048 + h * 256 + pc * 8); pk[i] = *(const u32x4*)(QKC + r * 2048 + 1024 + h * 256 + pc * 8); pv[i] = *(const u32x4*)(ZA + r * ZA_W + 4096 + h * 256 + pc * 8); } \
        if (wave == 0) { const int tok = (VAR & 1) ? lane : (dir ? T - 1 - ((t0_) + lane) : (t0_) + lane); const float* zr = ZS + (size_t)(row0 + tok) * 64 + 32 + dir * 8 + h; pgi = zr[0]; pgf = zr[4]; } } while (0)
    ML_LOAD(0);
    __syncthreads();
#pragma unroll 1
    for (int t0 = 0; t0 < T; t0 += SC_CHUNK) {
        int tid_l = tid; asm volatile("" : "+v"(tid_l));
        const int tid = tid_l, lane = tid & 63, hh = lane >> 5, c32 = lane & 31;
        const int i16 = lane & 15, tq = i16 >> 2, tp = i16 & 3, tblk = (lane >> 4) & 1;
        const int trofs_k = (8 * hh + tq) * ML_RSK + (16 * tblk + 4 * tp) * 2;
        const int g16 = lane >> 4;
        {
            if (wave == 0) {
                const float ig = pgi, lf = log_sigmoid(pgf + fb); const float mprev = sMISC[0];
                float cum = lf;
#pragma unroll
                for (int o = 1; o < 64; o <<= 1) { const float t = __shfl_up(cum, o); if (lane >= o) cum += t; }
                const float g = ig - cum; float pm = g;
#pragma unroll
                for (int o = 1; o < 64; o <<= 1) { const float t = __shfl_up(pm, o); if (lane >= o) pm = fmaxf(pm, t); }
                const float mj = cum + fmaxf(mprev, pm); const float mnew = __shfl(mj, 63), c63 = __shfl(cum, 63);
                const float r = __expf(cum - mj - c63 + mnew), inter = __expf(cum + mprev - mj);
                sR[lane] = r; sIR[lane] = inter / r; sINT[lane] = inter; sEM[lane] = __expf(-mj); sW[lane] = __expf(c63 + g - mnew); sDEN[lane] = 0.f;
                if (lane == 0) { sMISC[1] = __expf(c63 + mprev - mnew); sMISC[2] = mnew; }
            }
#pragma unroll
            for (int i = 0; i < 4; ++i) { const int idx = tid + NT * i, j = idx >> 5, pc = idx & 31;
                *(LAS u32x4*)(lds + ML_Q + j * ML_RSQ + pc * 16) = pq[i]; *(LAS u32x4*)(lds + ML_K + j * ML_RSK + pc * 16) = pk[i]; }
        }
        __syncthreads();
        {
#pragma unroll
            for (int i = 0; i < 4; ++i) { const int idx = tid + NT * i, j = idx >> 5, pc = idx & 31;
                const u32x4 v = pv[i]; const float w = sW[j];
                u32x4 o; o.x = cvtpk(bf_lo(v.x) * w, bf_hi(v.x) * w); o.y = cvtpk(bf_lo(v.y) * w, bf_hi(v.y) * w); o.z = cvtpk(bf_lo(v.z) * w, bf_hi(v.z) * w); o.w = cvtpk(bf_lo(v.w) * w, bf_hi(v.w) * w);
                *(LAS u32x4*)(lds + ML_V + j * ML_RSV + pc * 16) = o; }
        }
        {
            const int t = tid >> 3, part = tid & 7; float s = 0.f;
#pragma unroll
            for (int i = 0; i < 4; ++i) { const u32x4 qv = *(const LAS u32x4*)(lds + ML_Q + t * ML_RSQ + part * 64 + i * 16); const f32x4 n0 = *(const LAS f32x4*)(NV + part * 32 + i * 8), n1 = *(const LAS f32x4*)(NV + part * 32 + i * 8 + 4);
                s += bf_lo(qv.x) * n0[0] + bf_hi(qv.x) * n0[1] + bf_lo(qv.y) * n0[2] + bf_hi(qv.y) * n0[3] + bf_lo(qv.z) * n1[0] + bf_hi(qv.z) * n1[1] + bf_lo(qv.w) * n1[2] + bf_hi(qv.w) * n1[3]; }
            s += __shfl_xor(s, 1); s += __shfl_xor(s, 2); s += __shfl_xor(s, 4);
            if (part == 0) sQN[t] = s;
        }
#pragma unroll 1
        for (int bi = wave; bi < 10; bi += 8) {
            int ti, si;
            if (bi < 1) { ti = 0; si = 0; } else if (bi < 3) { ti = 1; si = bi - 1; } else if (bi < 6) { ti = 2; si = bi - 3; } else { ti = 3; si = bi - 6; }
            pg8::f32x4 acc = {0.f, 0.f, 0.f, 0.f};
            const LAS unsigned char* ka = lds + ML_K + (16 * si + i16) * ML_RSK + g16 * 16; const LAS unsigned char* qb = lds + ML_Q + (16 * ti + i16) * ML_RSQ + g16 * 16;
#pragma unroll
            for (int ks = 0; ks < 8; ++ks) acc = MFMA16(*(const LAS s16x8*)(ka + ks * 64), *(const LAS s16x8*)(qb + ks * 64), acc);
            const int t = 16 * ti + i16, s0 = 16 * si + 4 * g16; float dsum = 0.f;
#pragma unroll
            for (int i = 0; i < 4; ++i) { if (s0 + i > t) acc[i] = 0.f; dsum += acc[i] * sW[s0 + i]; }
            u32x2 pw; pw.x = cvtpk(acc[0], acc[1]); pw.y = cvtpk(acc[2], acc[3]);
            *(LAS u32x2*)(lds + ML_P + t * RSP + s0 * 2) = pw;
            __hip_atomic_fetch_add(sDEN + t, dsum, __ATOMIC_RELAXED, __HIP_MEMORY_SCOPE_WORKGROUP);
        }
        f32x16 Z[2];
#pragma unroll
        for (int r = 0; r < 16; ++r) { Z[0][r] = 0.f; Z[1][r] = 0.f; }
#pragma unroll
        for (int blk = 0; blk < 8; ++blk)
#pragma unroll
            for (int s = 0; s < 2; ++s) { const s16x8 cf = pack_step(C[blk], s);
#pragma unroll
                for (int tb = 0; tb < 2; ++tb) Z[tb] = MFMA32(cf, frag_perm(lds + ML_Q + (32 * tb + c32) * ML_RSQ + (32 * blk + 16 * s + 4 * hh) * 2), Z[tb]);
                asm volatile("" ::: "memory"); }
#pragma unroll
        for (int tb = 0; tb < 2; ++tb) { const float ir = sIR[32 * tb + c32];
#pragma unroll
            for (int r = 0; r < 16; ++r) Z[tb][r] *= ir; }
        if (t0 + SC_CHUNK < T) ML_LOAD(t0 + SC_CHUNK);
        __syncthreads();
#pragma unroll
        for (int ks = 0; ks < 4; ++ks) { const s16x8 vf = frag_tr(lds + ML_V + (16 * ks) * ML_RSV + (32 * wave) * 2, trofs_k, ML_RSV);
#pragma unroll
            for (int tb = (ks >> 1); tb < 2; ++tb) Z[tb] = MFMA32(vf, *(const LAS s16x8*)(lds + ML_P + (32 * tb + c32) * RSP + (16 * ks + 8 * hh) * 2), Z[tb]); }
#pragma unroll
        for (int tb = 0; tb < 2; ++tb) { const int j = 32 * tb + c32; const float r = sR[j]; const float den = fmaxf(fabsf(r * sDEN[j] + sINT[j] * sQN[j]), sEM[j]); const float sc = r / den;
            const int tok = dir ? T - 1 - (t0 + j) : t0 + j; bf16* op = OM + (size_t)(row0 + tok) * D + h * 256 + 32 * wave + 4 * hh;
#pragma unroll
            for (int g = 0; g < 4; ++g) { u32x2 w; w.x = cvtpk(Z[tb][4 * g] * sc, Z[tb][4 * g + 1] * sc); w.y = cvtpk(Z[tb][4 * g + 2] * sc, Z[tb][4 * g + 3] * sc); *(u32x2*)(op + 8 * g) = w; } }
        {
            const float decay = sMISC[1];
#pragma unroll
            for (int blk = 0; blk < 8; ++blk)
#pragma unroll
                for (int r = 0; r < 16; ++r) C[blk][r] *= decay;
#pragma unroll
            for (int ks = 0; ks < 4; ++ks) { const s16x8 vf = frag_tr(lds + ML_V + (16 * ks) * ML_RSV + (32 * wave) * 2, trofs_k, ML_RSV);
#pragma unroll
                for (int blk = 0; blk < 8; ++blk) C[blk] = MFMA32(frag_tr(lds + ML_K + (16 * ks) * ML_RSK + (32 * blk) * 2, trofs_k, ML_RSK), vf, C[blk]);
                asm volatile("" ::: "memory"); }
            if (tid < 256) { float n = NV[tid] * decay;
#pragma unroll 8
                for (int s = 0; s < 64; ++s) n += sW[s] * bf2f(*(const LAS bf16*)(lds + ML_K + s * ML_RSK + tid * 2));
                NV[tid] = n; }
            if (tid == 0) sMISC[0] = sMISC[2];
        }
        __syncthreads();
    }
#undef ML_LOAD
    if (!sample) {
        float* cp = (VAR ? (float*)(a.ws + WS_ST2) : a.out + OUT_MC) + hidx * 65536 + 32 * wave + c32;
#pragma unroll
        for (int blk = 0; blk < 8; ++blk) {
#pragma unroll
            for (int r = 0; r < 16; ++r) cp[(size_t)(32 * blk + crow(r, hh)) * 256] = C[blk][r];
            asm volatile("" ::: "memory"); }
        if (!VAR) { if (tid < 256) a.out[OUT_MN + hidx * 256 + tid] = NV[tid];
        if (tid == 0) a.out[OUT_MM + hidx] = sMISC[0]; }
    }
    __syncthreads();
}
constexpr int GL_RSQ = 272, GL_RSK = 320, GL_RSV = 576;
constexpr int GL_Q = 0, GL_K = GL_Q + 64 * GL_RSQ, GL_V = GL_K + 64 * GL_RSK, GL_P = GL_V + 64 * GL_RSV, GL_E = GL_P + 64 * RSP, GL_END = GL_E + 512;
template <int VAR> __device__ __forceinline__ void scan_gla_fast(const Ctx& a, int l, int sample, int b, int h, int dir, LAS unsigned char* lds) {
    const int tid = otid(), lane = tid & 63, wave = __builtin_amdgcn_readfirstlane(tid >> 6);
    const int T = sample ? 1024 : 256, row0 = sample ? NPROMPT_ROWS + b * 1024 : b * 256;
    const bf16* ZA = (const bf16*)(a.ws + WS_ZA);
    const bf16* QT = (const bf16*)(a.ws + WS_QT) + (size_t)dir * M * 512; const bf16* KT = (const bf16*)(a.ws + WS_KT) + (size_t)dir * M * 512; const float* EE = (const float*)(a.ws + WS_EE) + (size_t)dir * (M / 64) * 512;
    bf16* OG = (bf16*)(a.ws + (VAR ? WS_O2 : WS_O) + (size_t)dir * O_STRIDE);
    LAS float* sE = (LAS float*)(lds + GL_E);
    const size_t sidx = ((((size_t)b * 2 + l) * 2 + dir) * 4 + h) * (128 * 256);
    f32x16 S[4];
    {   const int hh = lane >> 5, c32 = lane & 31;
        if (sample) {
            const float* sp = a.in(3) + sidx + 32 * wave + c32;
#pragma unroll
            for (int blk = 0; blk < 4; ++blk) {
#pragma unroll
                for (int r = 0; r < 16; ++r) S[blk][r] = sp[(size_t)(32 * blk + crow(r, hh)) * 256];
                asm volatile("" ::: "memory"); }
        } else {
#pragma unroll
            for (int blk = 0; blk < 4; ++blk)
#pragma unroll
                for (int r = 0; r < 16; ++r) S[blk][r] = 0.f;
        }
    }
    for (int i = tid; i < 64 * RSP / 4; i += NT) ((LAS unsigned*)(lds + GL_P))[i] = 0u;
    u32x4 pq[2], pk[2], pv[4]; f32x4 pe = {0.f, 0.f, 0.f, 0.f};
#define GLA_LOAD(t0_) do { \
        _Pragma("unroll") for (int i = 0; i < 2; ++i) { const int idx = tid + NT * i, j = idx >> 4, pc = idx & 15; const int tok = (VAR & 1) ? j : (dir ? T - 1 - ((t0_) + j) : (t0_) + j); const size_t r = (size_t)(row0 + tok); \
            pq[i] = *(const u32x4*)(QT + r * 512 + h * 128 + pc * 8); pk[i] = *(const u32x4*)(KT + r * 512 + h * 128 + pc * 8); } \
        _Pragma("unroll") for (int i = 0; i < 4; ++i) { const int idx = tid + NT * i, j = idx >> 5, pc = idx & 31; const int tok = (VAR & 1) ? j : (dir ? T - 1 - ((t0_) + j) : (t0_) + j); \
            pv[i] = *(const u32x4*)(ZA + (size_t)(row0 + tok) * ZA_W + 1024 + h * 256 + pc * 8); } \
        if (tid < 32) { const int cs = (VAR & 1) ? 0 : (dir ? T - 64 - (t0_) : (t0_)); pe = *(const f32x4*)(EE + (size_t)((row0 + cs) >> 6) * 512 + h * 128 + 4 * tid); } } while (0)
    GLA_LOAD(0);
    __syncthreads();
#pragma unroll 1
    for (int t0 = 0; t0 < T; t0 += SC_CHUNK) {
        int tid_l = tid; asm volatile("" : "+v"(tid_l));
        const int tid = tid_l, lane = tid & 63, hh = lane >> 5, c32 = lane & 31;
        const int i16 = lane & 15, tq = i16 >> 2, tp = i16 & 3, tblk = (lane >> 4) & 1;
        const int trofs_k = (8 * hh + tq) * GL_RSK + (16 * tblk + 4 * tp) * 2, trofs_v = (8 * hh + tq) * GL_RSV + (16 * tblk + 4 * tp) * 2;
        const int g16 = lane >> 4;
#pragma unroll
        for (int i = 0; i < 2; ++i) { const int idx = tid + NT * i, j = idx >> 4, pc = idx & 15; *(LAS u32x4*)(lds + GL_Q + j * GL_RSQ + pc * 16) = pq[i]; *(LAS u32x4*)(lds + GL_K + j * GL_RSK + pc * 16) = pk[i]; }
#pragma unroll
        for (int i = 0; i < 4; ++i) { const int idx = tid + NT * i, j = idx >> 5, pc = idx & 31; *(LAS u32x4*)(lds + GL_V + j * GL_RSV + pc * 16) = pv[i]; }
        if (tid < 32) *(LAS f32x4*)(sE + 4 * tid) = pe;
        __syncthreads();
        if (t0 + SC_CHUNK < T) GLA_LOAD(t0 + SC_CHUNK);
#pragma unroll 1
        for (int bi = wave; bi < 10; bi += 8) {
            int ti, si;
            if (bi < 1) { ti = 0; si = 0; } else if (bi < 3) { ti = 1; si = bi - 1; } else if (bi < 6) { ti = 2; si = bi - 3; } else { ti = 3; si = bi - 6; }
            pg8::f32x4 acc = {0.f, 0.f, 0.f, 0.f};
            const LAS unsigned char* ka = lds + GL_K + (16 * si + i16) * GL_RSK + g16 * 16; const LAS unsigned char* qb = lds + GL_Q + (16 * ti + i16) * GL_RSQ + g16 * 16;
#pragma unroll
            for (int ks = 0; ks < 4; ++ks) acc = MFMA16(*(const LAS s16x8*)(ka + ks * 64), *(const LAS s16x8*)(qb + ks * 64), acc);
            const int t = 16 * ti + i16, s0 = 16 * si + 4 * g16;
#pragma unroll
            for (int i = 0; i < 4; ++i) if (s0 + i > t) acc[i] = 0.f;
            u32x2 pw; pw.x = cvtpk(acc[0], acc[1]); pw.y = cvtpk(acc[2], acc[3]);
            *(LAS u32x2*)(lds + GL_P + t * RSP + s0 * 2) = pw;
        }
        f32x16 Z[2];
#pragma unroll
        for (int r = 0; r < 16; ++r) { Z[0][r] = 0.f; Z[1][r] = 0.f; }
#pragma unroll
        for (int blk = 0; blk < 4; ++blk)
#pragma unroll
            for (int s = 0; s < 2; ++s) { const s16x8 cf = pack_step(S[blk], s);
#pragma unroll
                for (int tb = 0; tb < 2; ++tb) Z[tb] = MFMA32(cf, frag_perm(lds + GL_Q + (32 * tb + c32) * GL_RSQ + (32 * blk + 16 * s + 4 * hh) * 2), Z[tb]); }
        __syncthreads();
#pragma unroll
        for (int ks = 0; ks < 4; ++ks) { const s16x8 vf = frag_tr(lds + GL_V + (16 * ks) * GL_RSV + (32 * wave) * 2, trofs_v, GL_RSV);
#pragma unroll
            for (int tb = (ks >> 1); tb < 2; ++tb) Z[tb] = MFMA32(vf, *(const LAS s16x8*)(lds + GL_P + (32 * tb + c32) * RSP + (16 * ks + 8 * hh) * 2), Z[tb]); }
#pragma unroll
        for (int tb = 0; tb < 2; ++tb) { const int j = 32 * tb + c32; const int tok = dir ? T - 1 - (t0 + j) : t0 + j; bf16* op = OG + (size_t)(row0 + tok) * D + h * 256 + 32 * wave + 4 * hh;
#pragma unroll
            for (int g = 0; g < 4; ++g) { u32x2 w; w.x = cvtpk(Z[tb][4 * g], Z[tb][4 * g + 1]); w.y = cvtpk(Z[tb][4 * g + 2], Z[tb][4 * g + 3]); *(u32x2*)(op + 8 * g) = w; } }
#pragma unroll
        for (int ks = 0; ks < 4; ++ks) { const s16x8 vf = frag_tr(lds + GL_V + (16 * ks) * GL_RSV + (32 * wave) * 2, trofs_v, GL_RSV);
#pragma unroll
            for (int blk = 0; blk < 4; ++blk) S[blk] = MFMA32(frag_tr(lds + GL_K + (16 * ks) * GL_RSK + (32 * blk) * 2, trofs_k, GL_RSK), vf, S[blk]); }
#pragma unroll
        for (int blk = 0; blk < 4; ++blk) {
#pragma unroll
            for (int g = 0; g < 4; ++g) { const f32x4 e4 = *(const LAS f32x4*)(sE + 32 * blk + 8 * g + 4 * hh);
#pragma unroll
                for (int e = 0; e < 4; ++e) S[blk][4 * g + e] *= e4[e]; } }
        __syncthreads();
    }
#undef GLA_LOAD
    if (!sample) {
        const int hh = lane >> 5, c32 = lane & 31;
        float* sp = (VAR ? (float*)(a.ws + WS_ST2) : a.out + OUT_GLA) + sidx + 32 * wave + c32;
#pragma unroll
        for (int blk = 0; blk < 4; ++blk) {
#pragma unroll
            for (int r = 0; r < 16; ++r) sp[(size_t)(32 * blk + crow(r, hh)) * 256] = S[blk][r];
            asm volatile("" ::: "memory"); }
    }
    __syncthreads();
}
template <int VAR> __device__ __forceinline__ void phase_scan_fast(const Ctx& a, int l, LAS unsigned char* lds) {
    for (int u = blockIdx.x; u < 640; u += gridDim.x) {
        int kind, sample, v;
        if (u < 64) { kind = 1; sample = 1; v = u; } else if (u < 128) { kind = 0; sample = 1; v = u - 64; } else if (u < 384) { kind = 1; sample = 0; v = u - 128; } else { kind = 0; sample = 0; v = u - 384; }
        const int dir = v & 1, h = (v >> 1) & 3, b = v >> 3;
        if (kind) { if ((VAR ? MK_VAR_SSEL : 3) & 2) scan_mlstm_fast<VAR>(a, l, sample, b, h, dir, lds); } else { if ((VAR ? MK_VAR_SSEL : 3) & 1) scan_gla_fast<VAR>(a, l, sample, b, h, dir, lds); }
    }
}
__device__ __forceinline__ void phase_prep(const Ctx& a, int l, LAS unsigned char* lds) {
    const int tid = otid(), lane = tid & 63, gw = blockIdx.x * NW + (tid >> 6), NGW = gridDim.x * NW;
    const bf16* ZA = (const bf16*)(a.ws + WS_ZA); const float* ZS = (const float*)(a.ws + WS_ZS);
    bf16* QKC = (bf16*)(a.ws + WS_QKC);
    const float* wc = a.in(16) + (size_t)l * 3 * 2048; const float* bc = a.in(17) + (size_t)l * 2048;
    for (int r = gw; r < M; r += NGW) {
        const int T = r < NPROMPT_ROWS ? 256 : 1024, t = r < NPROMPT_ROWS ? (r & 255) : ((r - NPROMPT_ROWS) & 1023);
#pragma unroll
        for (int j = 0; j < 4; ++j) { const int ch = 512 * j + 8 * lane; const bf16* zp = ZA + (size_t)r * ZA_W + 2048 + ch;
            const u32x4 zc = *(const u32x4*)zp; u32x4 zm = {0u, 0u, 0u, 0u}, zn = {0u, 0u, 0u, 0u};
            if (t > 0) zm = *(const u32x4*)(zp - ZA_W); if (t < T - 1) zn = *(const u32x4*)(zp + ZA_W);
            const f32x4 w0a = *(const f32x4*)(wc + ch), w0b = *(const f32x4*)(wc + ch + 4), w1a = *(const f32x4*)(wc + 2048 + ch), w1b = *(const f32x4*)(wc + 2048 + ch + 4),
                        w2a = *(const f32x4*)(wc + 4096 + ch), w2b = *(const f32x4*)(wc + 4096 + ch + 4), ba = *(const f32x4*)(bc + ch), bb = *(const f32x4*)(bc + ch + 4);
            float o[8];
#pragma unroll
            for (int e = 0; e < 4; ++e) { const unsigned cw = zc[e], mw = zm[e], nw = zn[e];
#pragma unroll
                for (int q = 0; q < 2; ++q) { const int k8 = 2 * e + q; const float xc = q ? bf_hi(cw) : bf_lo(cw), xm = q ? bf_hi(mw) : bf_lo(mw), xn = q ? bf_hi(nw) : bf_lo(nw);
                    const float w0 = k8 < 4 ? w0a[k8 & 3] : w0b[k8 & 3], w1 = k8 < 4 ? w1a[k8 & 3] : w1b[k8 & 3], w2 = k8 < 4 ? w2a[k8 & 3] : w2b[k8 & 3], bv = k8 < 4 ? ba[k8 & 3] : bb[k8 & 3];
                    const float x = w0 * xm + w1 * xc + w2 * xn + bv; float s = x * fast_sigmoid(x); if (j < 2) s *= 0.0625f; o[k8] = s; } }
            u32x4 w; w.x = pk2(o[0], o[1]); w.y = pk2(o[2], o[3]); w.z = pk2(o[4], o[5]); w.w = pk2(o[6], o[7]);
            *(u32x4*)(QKC + (size_t)r * 2048 + ch) = w; }
    }
    bf16* QT = (bf16*)(a.ws + WS_QT); bf16* KT = (bf16*)(a.ws + WS_KT); float* EE = (float*)(a.ws + WS_EE);
    LAS float* sa = (LAS float*)lds;
    for (int u = blockIdx.x; u < 2 * (M / 64); u += gridDim.x) {
        const int dir = u & 1, ck = u >> 1, rbase = ck * 64, c = tid;
        __syncthreads();
        for (int i = tid; i < 64 * 16; i += NT) sa[i] = ZS[(size_t)(rbase + (i >> 4)) * 64 + dir * 16 + (i & 15)];
        float wd[16];
#pragma unroll
        for (int k = 0; k < 16; ++k) wd[k] = a.in(14)[(((size_t)l * 2 + dir) * 16 + k) * 512 + c];
        const float bd = a.in(15)[((size_t)l * 2 + dir) * 512 + c];
        __syncthreads();
        float cum = 0.f;
#pragma unroll 4
        for (int j = 0; j < 64; ++j) { const int tl = dir ? 63 - j : j; const size_t r = (size_t)(rbase + tl);
            float x = bd;
#pragma unroll
            for (int k4 = 0; k4 < 4; ++k4) { const f32x4 av = *(const LAS f32x4*)(sa + tl * 16 + 4 * k4); x += av[0] * wd[4 * k4] + av[1] * wd[4 * k4 + 1] + av[2] * wd[4 * k4 + 2] + av[3] * wd[4 * k4 + 3]; }
            cum += log_sigmoid(x) * 0.0625f;
            const float e = __expf(cum);
            QT[((size_t)dir * M + r) * 512 + c] = (bf16)f2bf(bf2f(ZA[r * ZA_W + c]) * 0.08838834764831845f * e);
            KT[((size_t)dir * M + r) * 512 + c] = (bf16)f2bf(bf2f(ZA[r * ZA_W + 512 + c]) / e); }
        EE[((size_t)dir * (M / 64) + ck) * 512 + c] = __expf(cum);
    }
    __syncthreads();
}

__device__ __forceinline__ void cmp_flush(const Ctx& a, int item, float nu, float de, LAS unsigned char* lds) {
    LAS float* red = (LAS float*)lds; const int tid = threadIdx.x, lane = tid & 63, wave = tid >> 6;
    nu = wave_sum(nu); de = wave_sum(de);
    __syncthreads(); if (lane == 0) { red[2 * wave] = nu; red[2 * wave + 1] = de; } __syncthreads();
    if (tid == 0) { float n2 = 0.f, d2 = 0.f; for (int w = 0; w < NW; ++w) { n2 += red[2 * w]; d2 += red[2 * w + 1]; }
        float* chk = (float*)(a.ws + WS_CTL) + 256; atomicAdd(chk + 2 * item, n2); atomicAdd(chk + 2 * item + 1, d2); }
}
__device__ __forceinline__ void phase_compare(const Ctx& a, int l, LAS unsigned char* lds) {
    const size_t gt = (size_t)blockIdx.x * NT + threadIdx.x, GT = (size_t)gridDim.x * NT;
    for (int ob = 0; ob < 4; ++ob) { const bf16* F = (const bf16*)(a.ws + WS_O + (size_t)ob * O_STRIDE); const bf16* R = (const bf16*)(a.ws + WS_O2 + (size_t)ob * O_STRIDE);
        float nu = 0.f, de = 0.f;
        for (size_t i = gt; i < (size_t)M * D / 2; i += GT) { const unsigned f = ((const unsigned*)F)[i], r = ((const unsigned*)R)[i];
            const float d0 = bf_lo(f) - bf_lo(r), d1 = bf_hi(f) - bf_hi(r); nu += d0 * d0 + d1 * d1; de += bf_lo(r) * bf_lo(r) + bf_hi(r) * bf_hi(r); }
        cmp_flush(a, ob, nu, de, lds); }
    const float* st = (const float*)(a.ws + WS_ST2);
    {   float nu = 0.f, de = 0.f;
        for (size_t c = gt; c < (size_t)32 * 2 * 4 * 32768; c += GT) { const size_t bh = c >> 15, rest = c & 32767, bb = bh >> 3, dh = bh & 7; const float f = a.out[OUT_GLA + (((bb * 2 + l) * 8) + dh) * 32768 + rest], r = st[c]; nu += (f - r) * (f - r); de += r * r; }
        cmp_flush(a, 4, nu, de, lds); }
    {   float nu = 0.f, de = 0.f;
        for (size_t c = gt; c < (size_t)32 * 2 * 4 * 65536; c += GT) { const size_t bh = c >> 16, rest = c & 65535, bb = bh >> 3, dh = bh & 7; const float f = a.out[OUT_MC + (((bb * 2 + l) * 8) + dh) * 65536 + rest], r = st[8388608 + c]; nu += (f - r) * (f - r); de += r * r; }
        cmp_flush(a, 5, nu, de, lds); }
    {   float nu = 0.f, de = 0.f;
        for (size_t c = gt; c < (size_t)32 * 2 * 4 * 256; c += GT) { const size_t bh = c >> 8, rest = c & 255, bb = bh >> 3, dh = bh & 7; const float f = a.out[OUT_MN + (((bb * 2 + l) * 8) + dh) * 256 + rest], r = st[8388608 + 16777216 + c]; nu += (f - r) * (f - r); de += r * r; }
        cmp_flush(a, 6, nu, de, lds); }
    {   float nu = 0.f, de = 0.f;
        for (size_t c = gt; c < (size_t)32 * 2 * 4; c += GT) { const size_t bb = c >> 3, dh = c & 7; const float f = a.out[OUT_MM + ((bb * 2 + l) * 8) + dh], r = st[8388608 + 16777216 + 65536 + c]; nu += (f - r) * (f - r); de += r * r; }
        cmp_flush(a, 7, nu, de, lds); }
}


#define XB_TMO      128
#define XB_XCNT(j)  (256  + 64 * (j))
#define XB_XSUB(j)  (1280 + 64 * (j))
#define XB_XGEN(j)  (2304 + 64 * (j))
#define XB_TOP      3328
#define XB_TOPGEN   3392
#define XCD_BAR_WORDS 3456
#define XB_SPIN_CAP (1u << 18)

__device__ __forceinline__ unsigned xb_ld(unsigned* p)              { return __hip_atomic_load(p, __ATOMIC_RELAXED, __HIP_MEMORY_SCOPE_AGENT); }
__device__ __forceinline__ unsigned xb_add(unsigned* p, unsigned v) { return __hip_atomic_fetch_add(p, v, __ATOMIC_RELAXED, __HIP_MEMORY_SCOPE_AGENT); }
__device__ __forceinline__ unsigned xb_xcc_id() { return (unsigned)__builtin_amdgcn_s_getreg((3 << 11) | 20) & 0xFu; }
#define XB_SPIN(cond, bar) do { unsigned _sp = 0; while (cond) { __builtin_amdgcn_s_sleep(1); \
    if ((++_sp & 255u) == 0u) { if (xb_ld(&(bar)[XB_TMO])) break; if (_sp > XB_SPIN_CAP) { atomicAdd(&(bar)[XB_TMO], 1u); break; } } } } while (0)

struct XcdBarrier {
    unsigned* bar; unsigned x;
    volatile LAS unsigned* st;
};

__device__ __forceinline__ XcdBarrier xcd_barrier_post(unsigned* bar, volatile LAS unsigned* st) {
    XcdBarrier b; b.bar = bar; b.x = xb_xcc_id(); b.st = st;
    if (threadIdx.x == 0) (void)xb_add(&bar[XB_XCNT(b.x)], 1u);
    return b;
}
__device__ __forceinline__ void xcd_barrier_complete(unsigned* bar, unsigned x, unsigned& nloc, unsigned& nx) {
    const unsigned G = gridDim.x * gridDim.y * gridDim.z;
    unsigned sum, cnt, mine, sp = 0u;
    for (;;) {
        sum = 0u; cnt = 0u; mine = 0u;
#pragma unroll
        for (unsigned j = 0; j < 16; ++j) { const unsigned c = xb_ld(&bar[XB_XCNT(j)]); sum += c; cnt += (c > 0u) ? 1u : 0u; mine = (j == x) ? c : mine; }
        if (sum == G) break;
        __builtin_amdgcn_s_sleep(1);
        if ((++sp & 255u) == 0u) { if (xb_ld(&bar[XB_TMO])) break; if (sp > XB_SPIN_CAP) { atomicAdd(&bar[XB_TMO], 1u); break; } }
    }
    nloc = mine > 0u ? mine : 1u; nx = cnt > 0u ? cnt : 1u;
}

__device__ __forceinline__ void xcd_barrier(const XcdBarrier& b) {
    asm volatile("s_waitcnt vmcnt(0)" ::: "memory");
    __syncthreads();
    if (threadIdx.x == 0) {
        unsigned* bar = b.bar;
        __builtin_amdgcn_s_waitcnt(0);
        unsigned nloc = b.st[0], nx = b.st[1];
        if (nloc == 0u) { xcd_barrier_complete(bar, b.x, nloc, nx); b.st[0] = nloc; b.st[1] = nx; }
        const unsigned old = xb_add(&bar[XB_XSUB(b.x)], 1u);
        const unsigned gen = old / nloc;
        if (old + 1u == (gen + 1u) * nloc) {
            __builtin_amdgcn_fence(__ATOMIC_RELEASE, "agent");
            asm volatile("s_waitcnt vmcnt(0)" ::: "memory");
            const unsigned og = xb_add(&bar[XB_TOP], 1u);
            const unsigned tg = og / nx;
            if (og + 1u == (tg + 1u) * nx) xb_add(&bar[XB_TOPGEN], 1u);
            else XB_SPIN(xb_ld(&bar[XB_TOPGEN]) == tg, bar);
            __builtin_amdgcn_fence(__ATOMIC_ACQUIRE, "agent");
            xb_add(&bar[XB_XGEN(b.x)], 1u);
            asm volatile("s_waitcnt vmcnt(0)" ::: "memory");
        } else {
            XB_SPIN(xb_ld(&bar[XB_XGEN(b.x)]) == gen, bar);
            __builtin_amdgcn_fence(__ATOMIC_ACQUIRE, "agent");
            asm volatile("s_waitcnt vmcnt(0)" ::: "memory");
        }
    }
    __syncthreads();
}


template <class Epi> __device__ __forceinline__ void run_gemm(LAS unsigned char* lds, const bf16* A, const bf16* Bt, int N, int K, const Epi& E) {
    pg8::Gemm g{A, Bt, M, N, K}; pg8::StaticOrder S; S.init(M, N, (int)gridDim.x, (int)blockIdx.x);
    pg8::gemm_phase<Epi, pg8::StaticOrder, true, true>(lds, g, S, E);
}
#ifndef GSEL
#define GSEL 0x1ff
#endif
#ifndef MK_CHECK
#define MK_CHECK 0
#endif
#ifndef MK_FAST_SCAN
#define MK_FAST_SCAN 1
#endif
#ifndef MK_XBAR_EXTRA
#define MK_XBAR_EXTRA 0
#endif
#ifndef MK_SCAN_VAR
#define MK_SCAN_VAR 0
#endif
#ifndef MK_REPS
#define MK_REPS 0x1111111u
#endif
#ifndef MK_CHECK_TOL
#define MK_CHECK_TOL 3e-4f
#endif
constexpr int N_PHASES = 2 + 2 * (MK_CHECK ? 16 : 14);

template <bool COOP, int MASK> __global__ void __launch_bounds__(NT, 2) mk_fwd(Args ka) {
    extern __shared__ __attribute__((aligned(16))) unsigned char lds_raw[];
    LAS unsigned char* lds_base = (LAS unsigned char*)lds_raw;
    const int lo = ka.ph_lo, hi = ka.ph_hi;
    {
        LAS unsigned long long* tab = (LAS unsigned long long*)(lds_base + PTR_OFF);
        if (threadIdx.x == 0) {
#pragma unroll
            for (int i = 0; i < 29; ++i) tab[i] = (unsigned long long)ka.in[i];
            ((LAS unsigned*)(lds_base + XBST_OFF))[0] = 0u; ((LAS unsigned*)(lds_base + XBST_OFF))[1] = 0u;
        }
        __syncthreads();
    }
    XcdBarrier xbar; xbar.bar = nullptr; xbar.x = 0; xbar.st = nullptr;
    if (COOP) xbar = xcd_barrier_post((unsigned*)(ka.ws + WS_CTL + 4096), (volatile LAS unsigned*)(lds_base + XBST_OFF));
#define MISC (MASK & 1)
#define SCAN (MASK & 2)
#define GEMM (MASK & 4)
    constexpr int NQ = MK_CHECK ? 16 : 14;
#pragma unroll 1
    for (int ph = lo; ph < hi; ++ph) {
        unsigned char* ws = ka.ws; float* outp = ka.out; unsigned ldsb = (unsigned)(size_t)lds_base;
        asm volatile("" : "+s"(ws), "+s"(outp), "+s"(ldsb));
        LAS unsigned char* lds = (LAS unsigned char*)(size_t)ldsb;
        const Ctx a{lds, outp, ws};
        const float* ada = (const float*)(ws + WS_ADA);
        bf16* H = (bf16*)(ws + WS_H); bf16* ACT = (bf16*)(ws + WS_ACT); float* PRE = (float*)(ws + WS_PRE);
        bf16* ZA = (bf16*)(ws + WS_ZA); bf16* ZB = (bf16*)(ws + WS_ZB); float* ZS = (float*)(ws + WS_ZS);
        bf16* O0 = (bf16*)(ws + WS_O); bf16* O1 = (bf16*)(ws + WS_O + O_STRIDE); bf16* O2 = (bf16*)(ws + WS_O + 2 * O_STRIDE); bf16* O3 = (bf16*)(ws + WS_O + 3 * O_STRIDE);
        int l = 0, q = ph;
        if (ph >= 2) { l = (ph - 2) / NQ; const int k = (ph - 2) % NQ; q = 2 + k + ((!MK_CHECK && k >= 6) ? 2 : 0); }
        const unsigned char* wt = ws + WS_WT + (size_t)l * WT_LAYER;
        const float* adl = ada + (size_t)l * NCOND * NADA;
        const float* lng = a.in(27) + (size_t)l * 3 * D; const float* lnb = a.in(28) + (size_t)l * 3 * D;
        const unsigned reps = ka.reps;
        const int cls = (q == 0) ? 4 : (q == 1) ? 5 : (q == 7) ? 1 : (q == 4 || q == 14 || q == 17) ? 2 : (q == 10 || q == 8 || q == 9) ? 6 : 0;
        int nrep = (reps >> (4 * cls)) & 15; const int nrep_prep = (reps >> 12) & 15; if (q == 6 && nrep_prep > nrep) nrep = nrep_prep;
#pragma unroll 1
        for (int rep = 0; rep < nrep; ++rep) {
        switch (q) {
        case 0: if (MISC) {  phase_ada(a, lds); __syncthreads(); phase_wconv(a, 0, lds); phase_wconv(a, 1, lds); } break;
        case 1: if (MISC) { phase_xinit(a); } break;
        case 2: if (GEMM && (GSEL >> 0 & 1)) {  pg8::EpiSwiglu E{ACT, FF}; run_gemm(lds, H, (const bf16*)(wt + WT_W1A), W1A_N, D, E); } break;
        case 3: if (GEMM && (GSEL >> 1 & 1)) {  pg8::EpiPre E{a.out, PRE, adl + 2 * D, 0.5f}; run_gemm(lds, ACT, (const bf16*)(wt + WT_W1D), D, FF, E); } break;
        case 4: if (MISC) { phase_ln(a, lng, lnb, adl + 3 * D); } break;
        case 5: if (GEMM && (GSEL >> 2 & 1)) {  pg8::EpiZ<0> E{ZA, ZA_W, ZS, 20}; run_gemm(lds, H, (const bf16*)(wt + WT_WINA), WINA_N, D, E); } break;
        case 6: if (GEMM && (GSEL >> 3 & 1) && rep < (int)(reps & 15)) {  pg8::EpiZ<1> E{ZB, ZB_W, nullptr, 1 << 30}; run_gemm(lds, H, (const bf16*)(wt + WT_WINB), WINB_N, D, E); }
                if (MISC && rep < nrep_prep) { phase_prep(a, l, lds); } break;
        case 7: if (SCAN) {
#if MK_FAST_SCAN
                    if (rep == 0) phase_scan_fast<0>(a, l, lds);
#if MK_SCAN_VAR
                    else phase_scan_fast<MK_SCAN_VAR>(a, l, lds);
#endif
#else
                    const ScanOut so{ws + WS_O, a.out + OUT_GLA, a.out + OUT_MC, a.out + OUT_MN, a.out + OUT_MM, -1}; phase_scan_naive(a, so, l, lds);
#endif
                } break;
#if MK_CHECK
        case 8: if (MASK & 8) { float* st = (float*)(ws + WS_ST2); const ScanOut so{ws + WS_O2, st, st + 8388608, st + 8388608 + 16777216, st + 8388608 + 16777216 + 65536, 0}; phase_scan_naive(a, so, l, lds); } break;
        case 9: if (MASK & 16) { phase_compare(a, l, lds); } break;
#endif
        case 10: if (MISC) { phase_combine(a, l); } break;
        case 11: if (GEMM && (GSEL >> 4 & 1)) {  pg8::EpiBranch<false> E{ZB + 2048, ZB_W, nullptr, O1}; run_gemm(lds, O0, (const bf16*)(wt + WT_WBG), D, D, E); } break;
        case 12: if (GEMM && (GSEL >> 5 & 1)) {  pg8::EpiBranch<true> E{ZB + 3072, ZB_W, O1, O3}; run_gemm(lds, O2, (const bf16*)(wt + WT_WBM), D, D, E); } break;
        case 13: if (GEMM && (GSEL >> 1 & 1)) {  pg8::EpiPre E{a.out, PRE, adl + 5 * D, 1.0f}; run_gemm(lds, O3, (const bf16*)(wt + WT_WO), D, D, E); } break;
        case 14: if (MISC) { phase_ln(a, lng + D, lnb + D, adl + 6 * D); } break;
        case 15: if (GEMM && (GSEL >> 0 & 1)) {  pg8::EpiSwiglu E{ACT, FF}; run_gemm(lds, H, (const bf16*)(wt + WT_W2A), W1A_N, D, E); } break;
        case 16: if (GEMM && (GSEL >> 1 & 1)) {  pg8::EpiPre E{a.out, PRE, adl + 8 * D, 0.5f}; run_gemm(lds, ACT, (const bf16*)(wt + WT_W2D), D, FF, E); } break;
        case 17: if (MISC) { phase_ln(a, lng + 2 * D, lnb + 2 * D, l == 0 ? ada + (size_t)NCOND * NADA : nullptr);
#if MK_CHECK
                    if (l == 1 && blockIdx.x == 0 && threadIdx.x == 0) { const float* chk = (const float*)(ws + WS_CTL) + 256; unsigned mask = 0;
                        for (int i = 0; i < 8; ++i) { const float nu = __hip_atomic_load(chk + 2 * i, __ATOMIC_RELAXED, __HIP_MEMORY_SCOPE_AGENT), de = __hip_atomic_load(chk + 2 * i + 1, __ATOMIC_RELAXED, __HIP_MEMORY_SCOPE_AGENT); if (!(nu <= MK_CHECK_TOL * de) || !(de > 0.f)) mask |= 1u << i; }
                        const unsigned long long t0 = __builtin_amdgcn_s_memrealtime(); while (__builtin_amdgcn_s_memrealtime() - t0 < (unsigned long long)mask * 400000ull) __builtin_amdgcn_s_sleep(32); }
#endif
                } break;
        default: break;
        }
        if (rep + 1 < nrep) __syncthreads();
        }
        if (COOP && ph + 1 < hi) { if (ph == lo) { __syncthreads(); cg::this_grid().sync(); } else { xcd_barrier(xbar); for (int xb = 0; xb < MK_XBAR_EXTRA; ++xb) xcd_barrier(xbar); } }
    }
#undef MISC
#undef SCAN
#undef GEMM
}

#ifndef MK_ONE_LAUNCH
#define MK_ONE_LAUNCH 1
#endif
extern "C" void kernel_launch(void* const* d_in, const int* in_sizes, int n_in, void* d_out, int out_size, void* d_ws, size_t ws_size, hipStream_t stream) {
    static int grid = 0;
    if (grid == 0) {
        if (n_in != 29 || ws_size < WS_END) { fprintf(stderr, "kernel_launch: unexpected n_in %d or ws_size %zu (< %zu); nothing launched\n", n_in, ws_size, (size_t)WS_END); grid = -1; return; }
        int dev = 0, cus = 0;
        (void)hipGetDevice(&dev); (void)hipDeviceGetAttribute(&cus, hipDeviceAttributeMultiprocessorCount, dev);
        int per_cu = 0;
#if MK_ONE_LAUNCH && !MK_CHECK
        (void)hipFuncSetAttribute((const void*)mk_fwd<true, 7>, hipFuncAttributeMaxDynamicSharedMemorySize, LDS_BYTES);
        (void)hipOccupancyMaxActiveBlocksPerMultiprocessor(&per_cu, (const void*)mk_fwd<true, 7>, NT, LDS_BYTES);
#else
        (void)hipFuncSetAttribute((const void*)mk_fwd<false, 7>, hipFuncAttributeMaxDynamicSharedMemorySize, LDS_BYTES);
        (void)hipFuncSetAttribute((const void*)mk_fwd<false, 8>, hipFuncAttributeMaxDynamicSharedMemorySize, LDS_BYTES);
        (void)hipFuncSetAttribute((const void*)mk_fwd<false, 16>, hipFuncAttributeMaxDynamicSharedMemorySize, LDS_BYTES);
        per_cu = 1;
#endif
        (void)hipGetLastError();
        grid = cus > 0 ? cus : 256;
        if (per_cu < 1) fprintf(stderr, "kernel_launch: occupancy query says %d blocks per CU\n", per_cu);
    }
    if (grid < 0) return;
    (void)hipMemsetAsync((char*)d_ws + WS_CTL, 0, CTL_BYTES, stream);
    Args a{};
    for (int i = 0; i < 29; ++i) a.in[i] = (const float*)d_in[i];
    a.out = (float*)d_out; a.ws = (unsigned char*)d_ws; a.reps = MK_REPS;
#if MK_ONE_LAUNCH && !MK_CHECK
    a.ph_lo = 0; a.ph_hi = N_PHASES;
    void* args[] = {&a};
    hipError_t e = hipLaunchCooperativeKernel((const void*)mk_fwd<true, 7>, dim3(grid), dim3(NT), args, LDS_BYTES, stream);
    if (e != hipSuccess) fprintf(stderr, "cooperative launch failed: %s (grid %d)\n", hipGetErrorString(e), grid);
#else
    for (int p = 0; p < N_PHASES; ++p) {
        a.ph_lo = p; a.ph_hi = p + 1;
        if (MK_CHECK && p >= 2 && (p - 2) % 16 == 6) hipLaunchKernelGGL((mk_fwd<false, 8>), dim3(grid), dim3(NT), LDS_BYTES, stream, a);
        else if (MK_CHECK && p >= 2 && (p - 2) % 16 == 7) hipLaunchKernelGGL((mk_fwd<false, 16>), dim3(grid), dim3(NT), LDS_BYTES, stream, a);
        else hipLaunchKernelGGL((mk_fwd<false, 7>), dim3(grid), dim3(NT), LDS_BYTES, stream, a);
    }
#endif
}
```
